# Optimizing an MI355X kernel written in HIP

```python
import math
import jax, jax.numpy as jnp
from jax import lax
import numpy as np

D_MODEL = 1024
BATCH = 4
SEQ = 4096
DEPTH = 2

N_META = 16
BLOCK = 128
PAD = BLOCK - N_META

SSM_GROUPS = 16
SSM_GROUP_CH = 16
SSM_WIDTH = SSM_GROUPS * SSM_GROUP_CH
SSM_STATE = 64
SWA_HEADS = 8
SWA_KV_HEADS = 2
HEAD_DIM = 64
WINDOW = 128
SWA_WIDTH = SWA_HEADS * HEAD_DIM
SWA_KV_WIDTH = SWA_KV_HEADS * HEAD_DIM
MLA_HEADS = 4
MLA_Q_RANK = 192
MLA_KV_RANK = 128
MLA_NOPE = 64
MLA_ROPE = 32
MLA_V = 64
MLA_WIDTH = MLA_HEADS * MLA_V
ROPE_THETA = 10000.0

MIX_WIDTH = SSM_WIDTH + SWA_WIDTH + MLA_WIDTH
IN_WIDTH = SSM_WIDTH + SWA_WIDTH + 2 * SWA_KV_WIDTH + MLA_Q_RANK + MLA_KV_RANK + MLA_ROPE
IN_SPLITS = (SSM_WIDTH,
             SSM_WIDTH + SWA_WIDTH,
             SSM_WIDTH + SWA_WIDTH + SWA_KV_WIDTH,
             SSM_WIDTH + SWA_WIDTH + 2 * SWA_KV_WIDTH,
             SSM_WIDTH + SWA_WIDTH + 2 * SWA_KV_WIDTH + MLA_Q_RANK,
             SSM_WIDTH + SWA_WIDTH + 2 * SWA_KV_WIDTH + MLA_Q_RANK + MLA_KV_RANK)
D_FF = 4 * D_MODEL
EPS = 1e-6
NEG = -1e30

kernel_name = 'hymba_s5_swa_mla_hybrid'


def rms_norm(x, g):
    xf = x.astype(jnp.float32)
    y = xf * lax.rsqrt(jnp.mean(xf * xf, axis=-1, keepdims=True) + EPS)
    return (y * g.astype(jnp.float32)).astype(x.dtype)


def rope(x, pos):
    half = x.shape[-1] // 2
    inv_freq = ROPE_THETA ** (-jnp.arange(half, dtype=jnp.float32) / half)
    ang = pos.astype(jnp.float32)[:, None] * inv_freq[None, :]
    cos = jnp.cos(ang)[None, :, None, :]
    sin = jnp.sin(ang)[None, :, None, :]
    xf = x.astype(jnp.float32)
    x1, x2 = xf[..., :half], xf[..., half:]
    return jnp.concatenate([x1 * cos - x2 * sin, x1 * sin + x2 * cos], axis=-1).astype(x.dtype)


def _complex_affine_combine(e1, e2):
    a1r, a1i, b1r, b1i = e1
    a2r, a2i, b2r, b2i = e2
    return (a2r * a1r - a2i * a1i,
            a2r * a1i + a2i * a1r,
            a2r * b1r - a2i * b1i + b2r,
            a2r * b1i + a2i * b1r + b2i)


def s5_mixer(u, valid, a_re, a_im, log_step, b_re, b_im, c_re, c_im, d_skip, w_glu, b_glu):
    f32 = jnp.float32
    bsz, L, _ = u.shape
    uf = jnp.where(valid[None, :, None], u, 0).astype(f32).reshape(bsz, L, SSM_GROUPS, SSM_GROUP_CH)
    step = jnp.exp(log_step.astype(f32))[:, None]
    ar, ai = a_re.astype(f32), a_im.astype(f32)
    mag = jnp.exp(ar * step)
    lb_re, lb_im = mag * jnp.cos(ai * step), mag * jnp.sin(ai * step)
    den = ar * ar + ai * ai
    nr, ni = lb_re - 1.0, lb_im
    coef_re = (nr * ar + ni * ai) / den
    coef_im = (ni * ar - nr * ai) / den
    br, bi = b_re.astype(f32), b_im.astype(f32)
    bb_re = coef_re[..., None] * br - coef_im[..., None] * bi
    bb_im = coef_re[..., None] * bi + coef_im[..., None] * br
    bu_re = jnp.einsum('blgc,gpc->blgp', uf, bb_re)
    bu_im = jnp.einsum('blgc,gpc->blgp', uf, bb_im)
    a_t_re = jnp.broadcast_to(lb_re, bu_re.shape)
    a_t_im = jnp.broadcast_to(lb_im, bu_im.shape)
    _, _, xr, xi = lax.associative_scan(_complex_affine_combine, (a_t_re, a_t_im, bu_re, bu_im), axis=1)
    y = (jnp.einsum('gcp,blgp->blgc', c_re.astype(f32), xr)
         - jnp.einsum('gcp,blgp->blgc', c_im.astype(f32), xi)
         + d_skip.astype(f32).reshape(SSM_GROUPS, SSM_GROUP_CH) * uf)
    z = jax.nn.gelu(y.reshape(bsz, L, SSM_WIDTH))
    out = z * jax.nn.sigmoid(z @ w_glu.astype(f32) + b_glu.astype(f32))
    return out.astype(u.dtype)


def swa_attention(q, k, v, sinks):
    f32 = jnp.float32
    bsz, L = q.shape[:2]
    nb = L // BLOCK
    grp = SWA_HEADS // SWA_KV_HEADS
    qb = q.reshape(bsz, nb, BLOCK, SWA_KV_HEADS, grp, HEAD_DIM)
    kb = k.reshape(bsz, nb, BLOCK, SWA_KV_HEADS, HEAD_DIM)
    vb = v.reshape(bsz, nb, BLOCK, SWA_KV_HEADS, HEAD_DIM)

    def with_prev(t):
        prev = jnp.pad(t, ((0, 0), (1, 0), (0, 0), (0, 0), (0, 0)))[:, :-1]
        return jnp.concatenate([prev, t], axis=2)

    kk, vv = with_prev(kb), with_prev(vb)
    s = jnp.einsum('bnqhgd,bnkhd->bnhgqk', qb, kk).astype(f32) * (HEAD_DIM ** -0.5)
    blk = jnp.arange(nb)
    q_idx = blk[:, None] * BLOCK + jnp.arange(BLOCK)[None, :]
    k_idx = (blk[:, None] - 1) * BLOCK + jnp.arange(2 * BLOCK)[None, :]
    dist = q_idx[:, :, None] - k_idx[:, None, :]
    allowed = (dist >= 0) & (dist < WINDOW) & (k_idx[:, None, :] >= PAD)
    slopes = (2.0 ** (-8.0 * jnp.arange(1, SWA_HEADS + 1, dtype=f32) / SWA_HEADS)).reshape(SWA_KV_HEADS, grp)
    s = s - slopes[None, None, :, :, None, None] * dist.astype(f32)[None, :, None, None]
    s = jnp.where(allowed[None, :, None, None], s, NEG)
    sink = sinks.astype(f32).reshape(SWA_KV_HEADS, grp)[None, None, :, :, None, None]
    m = jnp.maximum(jnp.max(s, axis=-1, keepdims=True), sink)
    p = jnp.exp(s - m)
    p = p / (jnp.sum(p, axis=-1, keepdims=True) + jnp.exp(sink - m))
    o = jnp.einsum('bnhgqk,bnkhd->bnqhgd', p.astype(v.dtype), vv)
    return o.reshape(bsz, L, SWA_WIDTH)


def mla_mixer(cq, ckv, kr, pos, q_norm_g, kv_norm_g, w_uq, w_uk, w_uv):
    f32 = jnp.float32
    bsz, L, _ = cq.shape
    nb = L // BLOCK
    q = (rms_norm(cq, q_norm_g) @ w_uq).reshape(bsz, L, MLA_HEADS, MLA_NOPE + MLA_ROPE)
    q_nope, q_rope = q[..., :MLA_NOPE], rope(q[..., MLA_NOPE:], pos)
    c = rms_norm(ckv, kv_norm_g)
    k_nope = (c @ w_uk).reshape(bsz, L, MLA_HEADS, MLA_NOPE)
    v = (c @ w_uv).reshape(bsz, L, MLA_HEADS, MLA_V)
    k_rope = rope(kr[:, :, None, :], pos)[:, :, 0, :]
    scale = (MLA_NOPE + MLA_ROPE) ** -0.5
    k_idx = jnp.arange(L)
    key_valid = k_idx >= PAD
    qn_b = q_nope.reshape(bsz, nb, BLOCK, MLA_HEADS, MLA_NOPE).swapaxes(0, 1)
    qr_b = q_rope.reshape(bsz, nb, BLOCK, MLA_HEADS, MLA_ROPE).swapaxes(0, 1)

    def one_block(args):
        n, qn, qr = args
        s = (jnp.einsum('bqhd,bkhd->bhqk', qn, k_nope)
             + jnp.einsum('bqhr,bkr->bhqk', qr, k_rope)).astype(f32) * scale
        q_idx = n * BLOCK + jnp.arange(BLOCK)
        allowed = (k_idx[None, :] <= q_idx[:, None]) & key_valid[None, :]
        s = jnp.where(allowed[None, None], s, NEG)
        p = jax.nn.softmax(s, axis=-1)
        return jnp.einsum('bhqk,bkhd->bqhd', p.astype(v.dtype), v)

    o = lax.map(one_block, (jnp.arange(nb), qn_b, qr_b))
    return o.swapaxes(0, 1).reshape(bsz, L, MLA_WIDTH)


def setup_inputs(seed: int = 0) -> dict:
    key = jax.random.key(seed)
    ks = jax.random.split(key, 32)
    f32 = jnp.float32
    nrm = lambda k, shape, s: jax.random.normal(k, shape, f32) * s
    gain = lambda k, shape: 1.0 + 0.02 * jax.random.normal(k, shape, f32)
    n_idx = jnp.arange(SSM_STATE, dtype=f32)
    return {
        'x': nrm(ks[0], (BATCH, SEQ, D_MODEL), 1.0),
        'meta_tokens': nrm(ks[1], (N_META, D_MODEL), 1.0),
        'norm_pre_mix': gain(ks[2], (DEPTH, D_MODEL)),
        'norm_post_mix': gain(ks[3], (DEPTH, D_MODEL)),
        'norm_pre_mlp': gain(ks[4], (DEPTH, D_MODEL)),
        'norm_post_mlp': gain(ks[5], (DEPTH, D_MODEL)),
        'w_in': nrm(ks[6], (DEPTH, D_MODEL, IN_WIDTH), D_MODEL ** -0.5),
        'w_out': nrm(ks[7], (DEPTH, MIX_WIDTH, D_MODEL), MIX_WIDTH ** -0.5),
        'norm_heads': gain(ks[8], (DEPTH, MIX_WIDTH)),
        'ssm_a_re': -0.5 + 0.01 * jax.random.normal(ks[9], (DEPTH, SSM_GROUPS, SSM_STATE), f32),
        'ssm_a_im': math.pi * n_idx[None, None, :] + 0.01 * jax.random.normal(ks[10], (DEPTH, SSM_GROUPS, SSM_STATE), f32),
        'ssm_log_step': jax.random.uniform(ks[11], (DEPTH, SSM_GROUPS), f32, math.log(1e-3), math.log(1e-1)),
        'ssm_b_re': nrm(ks[12], (DEPTH, SSM_GROUPS, SSM_STATE, SSM_GROUP_CH), (2 * SSM_GROUP_CH) ** -0.5),
        'ssm_b_im': nrm(ks[13], (DEPTH, SSM_GROUPS, SSM_STATE, SSM_GROUP_CH), (2 * SSM_GROUP_CH) ** -0.5),
        'ssm_c_re': nrm(ks[14], (DEPTH, SSM_GROUPS, SSM_GROUP_CH, SSM_STATE), SSM_STATE ** -0.5),
        'ssm_c_im': nrm(ks[15], (DEPTH, SSM_GROUPS, SSM_GROUP_CH, SSM_STATE), SSM_STATE ** -0.5),
        'ssm_d': nrm(ks[16], (DEPTH, SSM_WIDTH), 1.0),
        'ssm_w_glu': nrm(ks[17], (DEPTH, SSM_WIDTH, SSM_WIDTH), SSM_WIDTH ** -0.5),
        'ssm_b_glu': nrm(ks[18], (DEPTH, SSM_WIDTH), 0.01),
        'swa_sinks': nrm(ks[19], (DEPTH, SWA_HEADS), 0.5),
        'mla_q_norm': gain(ks[20], (DEPTH, MLA_Q_RANK)),
        'mla_kv_norm': gain(ks[21], (DEPTH, MLA_KV_RANK)),
        'mla_w_uq': nrm(ks[22], (DEPTH, MLA_Q_RANK, MLA_HEADS * (MLA_NOPE + MLA_ROPE)), MLA_Q_RANK ** -0.5),
        'mla_w_uk': nrm(ks[23], (DEPTH, MLA_KV_RANK, MLA_HEADS * MLA_NOPE), MLA_KV_RANK ** -0.5),
        'mla_w_uv': nrm(ks[24], (DEPTH, MLA_KV_RANK, MLA_HEADS * MLA_V), MLA_KV_RANK ** -0.5),
        'w_mlp_up': nrm(ks[25], (DEPTH, D_MODEL, D_FF), D_MODEL ** -0.5),
        'w_mlp_down': nrm(ks[26], (DEPTH, D_FF, D_MODEL), D_FF ** -0.5),
    }


def reference(x, meta_tokens, norm_pre_mix, norm_post_mix, norm_pre_mlp, norm_post_mlp, w_in, w_out,
              norm_heads, ssm_a_re, ssm_a_im, ssm_log_step, ssm_b_re, ssm_b_im, ssm_c_re, ssm_c_im,
              ssm_d, ssm_w_glu, ssm_b_glu, swa_sinks, mla_q_norm, mla_kv_norm, mla_w_uq, mla_w_uk,
              mla_w_uv, w_mlp_up, w_mlp_down):
    bsz, _, d = x.shape
    dt = x.dtype
    meta = jnp.broadcast_to(meta_tokens.astype(dt)[None], (bsz, N_META, d))
    h = jnp.concatenate([jnp.zeros((bsz, PAD, d), dt), meta, x], axis=1)
    L = h.shape[1]
    idx = jnp.arange(L)
    valid = idx >= PAD
    pos = idx - PAD
    for l in range(DEPTH):
        a = rms_norm(h, norm_pre_mix[l])
        proj = a @ w_in[l]
        u, q, k, v, cq, ckv, kr = jnp.split(proj, IN_SPLITS, axis=-1)
        y_ssm = s5_mixer(u, valid, ssm_a_re[l], ssm_a_im[l], ssm_log_step[l], ssm_b_re[l], ssm_b_im[l],
                         ssm_c_re[l], ssm_c_im[l], ssm_d[l], ssm_w_glu[l], ssm_b_glu[l])
        y_swa = swa_attention(q.reshape(bsz, L, SWA_HEADS, HEAD_DIM),
                              k.reshape(bsz, L, SWA_KV_HEADS, HEAD_DIM),
                              v.reshape(bsz, L, SWA_KV_HEADS, HEAD_DIM), swa_sinks[l])
        y_mla = mla_mixer(cq, ckv, kr, pos, mla_q_norm[l], mla_kv_norm[l], mla_w_uq[l], mla_w_uk[l], mla_w_uv[l])
        g = norm_heads[l]
        mixed = jnp.concatenate([
            rms_norm(y_ssm, g[:SSM_WIDTH]),
            rms_norm(y_swa, g[SSM_WIDTH:SSM_WIDTH + SWA_WIDTH]),
            rms_norm(y_mla, g[SSM_WIDTH + SWA_WIDTH:]),
        ], axis=-1)
        h = h + rms_norm(mixed @ w_out[l], norm_post_mix[l])
        a = rms_norm(h, norm_pre_mlp[l])
        f = jnp.square(jax.nn.relu(a @ w_mlp_up[l])) @ w_mlp_down[l]
        h = h + rms_norm(f, norm_post_mlp[l])
    return h[:, PAD + N_META:, :]
```

```cpp
#include <hip/hip_runtime.h>
#include <hip/hip_cooperative_groups.h>
#include <cstdio>
#include <cstdint>
namespace cg = cooperative_groups;

typedef unsigned short u16;
using bf16x8 = __attribute__((ext_vector_type(8))) short;
using f32x4 = __attribute__((ext_vector_type(4))) float;

#define TPB 4112
#define MTOK 16448
#define MPAD 16512
#define DM 1024
#define INW 1376
#define DFF 4096
#define LT 4160
#define NCH 65
#ifndef PH
#define PH 0x3ffff
#endif

constexpr size_t al256(size_t x) { return (x + 255) & ~(size_t)255; }
constexpr size_t cmax(size_t a, size_t b) { return a > b ? a : b; }
constexpr size_t OW_IN = 0;
constexpr size_t OW_OUT = OW_IN + (size_t)INW * DM * 2;
constexpr size_t OW_UP = OW_OUT + (size_t)DM * DM * 2;
constexpr size_t OW_DN = OW_UP + (size_t)DFF * DM * 2;
constexpr size_t OW_UQ = OW_DN + (size_t)DFF * DM * 2;
constexpr size_t OW_UKV = OW_UQ + (size_t)384 * 192 * 2;
constexpr size_t OW_GLU = OW_UKV + (size_t)512 * 128 * 2;
constexpr size_t W_LAYER = OW_GLU + (size_t)256 * 256 * 2;
constexpr size_t OFF_W = 0;
constexpr size_t OFF_ROPE = OFF_W + 2 * W_LAYER;
constexpr size_t OFF_LAM = OFF_ROPE + al256((size_t)TPB * 16 * 8);
constexpr size_t OFF_LAMT = OFF_LAM + 2 * 16 * 64 * 8;
constexpr size_t OFF_BB = OFF_LAMT + 2 * 16 * 64 * 8;
constexpr size_t OFF_BAR = OFF_BB + 2 * 16 * 32 * 64 * 4;
constexpr size_t OFF_HMETA = OFF_BAR + 32768;
constexpr size_t OFF_ABUF = OFF_HMETA + 4 * 16 * 1024 * 4;
constexpr size_t OFF_OBUF = OFF_ABUF + (size_t)MPAD * DM * 2;
constexpr size_t OFF_X = OFF_OBUF + (size_t)MPAD * DM * 2;
constexpr size_t OX_PROJ = OFF_X;
constexpr size_t OX_Z = OX_PROJ + (size_t)MPAD * INW * 2;
constexpr size_t OX_YSSM = OX_Z + (size_t)MPAD * 256 * 2;
constexpr size_t OX_YSWA = OX_YSSM + (size_t)MPAD * 256 * 2;
constexpr size_t OX_YMLA = OX_YSWA + (size_t)MPAD * 512 * 2;
constexpr size_t OX_QN = OX_YMLA + (size_t)MPAD * 256 * 2;
constexpr size_t OX_CN = OX_QN + (size_t)MPAD * 192 * 2;
constexpr size_t OX_KR = OX_CN + (size_t)MPAD * 128 * 2;
constexpr size_t OX_QMLA = OX_KR + (size_t)MPAD * 32 * 2;
constexpr size_t OX_KN = OX_QMLA + (size_t)MPAD * 384 * 2;
constexpr size_t OX_VTM = OX_KN + (size_t)MPAD * 256 * 2;
constexpr size_t OX_VTS = OX_VTM + (size_t)4 * 4 * 64 * LT * 2;
constexpr size_t OX_END = OX_VTS + (size_t)4 * 2 * 64 * LT * 2;
constexpr size_t OX_LAST = OX_END + (size_t)4 * 16 * NCH * 64 * 8;
#define UPLD 4160
constexpr size_t OFF_END2 = cmax(OX_LAST, OFF_X + (size_t)MPAD * UPLD * 2);
constexpr size_t END_BYTES = (size_t)4 * 16 * NCH * 64 * 8;
constexpr size_t WS_TOTAL = OFF_END2 + 2 * END_BYTES;
static_assert(WS_TOTAL <= (size_t)256 * 1024 * 1024, "workspace too large");

struct Params {
  const float* x; const float* meta; const float* g_pre_mix; const float* g_post_mix; const float* g_pre_mlp;
  const float* g_post_mlp; const float* w_in; const float* w_out; const float* g_heads; const float* a_re;
  const float* a_im; const float* log_step; const float* b_re; const float* b_im; const float* c_re; const float* c_im;
  const float* d_skip; const float* w_glu; const float* b_glu; const float* sinks; const float* g_q; const float* g_kv;
  const float* w_uq; const float* w_uk; const float* w_uv; const float* w_up; const float* w_down;
  float* out; char* ws;
};

__device__ __forceinline__ u16 f2bf(float f) {
  unsigned u = __float_as_uint(f);
  u += 0x7fffu + ((u >> 16) & 1u);
  return (u16)(u >> 16);
}
__device__ __forceinline__ float bf2f(u16 h) { return __uint_as_float(((unsigned)h) << 16); }
__device__ __forceinline__ unsigned pack2(float a, float b) { return (unsigned)f2bf(a) | ((unsigned)f2bf(b) << 16); }
__device__ __forceinline__ float bflo(unsigned u) { return __uint_as_float(u << 16); }
__device__ __forceinline__ float bfhi(unsigned u) { return __uint_as_float(u & 0xffff0000u); }
__device__ __forceinline__ float wave_sum(float v) {
#pragma unroll
  for (int o = 32; o; o >>= 1) v += __shfl_xor(v, o);
  return v;
}
__device__ __forceinline__ float fexp2(float x) { return __builtin_amdgcn_exp2f(x); }
__device__ __forceinline__ int otid() { int t = threadIdx.x; asm volatile("" : "+v"(t)); return t; }

struct Mat { const float* src; u16* dst; int K, N; };
__device__ __forceinline__ Mat get_mat(const Params& p, int idx) {
  int l = idx >> 3, t = idx & 7;
  char* wb = p.ws + OFF_W + (size_t)l * W_LAYER;
  Mat m;
  if (t == 0) { m.src = p.w_in + (size_t)l * DM * INW; m.dst = (u16*)(wb + OW_IN); m.K = DM; m.N = INW; }
  else if (t == 1) { m.src = p.w_out + (size_t)l * DM * DM; m.dst = (u16*)(wb + OW_OUT); m.K = DM; m.N = DM; }
  else if (t == 2) { m.src = p.w_up + (size_t)l * DM * DFF; m.dst = (u16*)(wb + OW_UP); m.K = DM; m.N = DFF; }
  else if (t == 3) { m.src = p.w_down + (size_t)l * DFF * DM; m.dst = (u16*)(wb + OW_DN); m.K = DFF; m.N = DM; }
  else if (t == 4) { m.src = p.w_uq + (size_t)l * 192 * 384; m.dst = (u16*)(wb + OW_UQ); m.K = 192; m.N = 384; }
  else if (t == 5) { m.src = p.w_uk + (size_t)l * 128 * 256; m.dst = (u16*)(wb + OW_UKV); m.K = 128; m.N = 256; }
  else if (t == 6) { m.src = p.w_uv + (size_t)l * 128 * 256; m.dst = (u16*)(wb + OW_UKV) + 256 * 128; m.K = 128; m.N = 256; }
  else { m.src = p.w_glu + (size_t)l * 256 * 256; m.dst = (u16*)(wb + OW_GLU); m.K = 256; m.N = 256; }
  return m;
}

__device__ void phase_convert(const Params& p, char* lds) {
  float* tl = (float*)lds;
  const int tid = otid();
  int base = 0;
  for (int mi = 0; mi < 16; ++mi) {
    Mat mt = get_mat(p, mi);
    const int tn = mt.N >> 5, tk = mt.K >> 6, nt = tn * tk;
    int first = (int)(((long)blockIdx.x - base) % (long)gridDim.x);
    if (first < 0) first += gridDim.x;
    for (int i = first; i < nt; i += gridDim.x) {
      const int kt = i / tn, ntile = i - kt * tn;
      const int k0 = kt * 64, n0 = ntile * 32;
      {
        const int r = tid >> 3, c4 = (tid & 7) * 4;
#pragma unroll
        for (int j = 0; j < 2; ++j) {
          float4 v = *(const float4*)(mt.src + (size_t)(k0 + r + 32 * j) * mt.N + n0 + c4);
          float* d = tl + (r + 32 * j) * 33 + c4;
          d[0] = v.x; d[1] = v.y; d[2] = v.z; d[3] = v.w;
        }
      }
      __syncthreads();
      {
        const int n = tid >> 3, kc = (tid & 7) * 8;
        unsigned w[4];
#pragma unroll
        for (int e = 0; e < 4; ++e) w[e] = pack2(tl[(kc + 2 * e) * 33 + n], tl[(kc + 2 * e + 1) * 33 + n]);
        *(uint4*)(mt.dst + (size_t)(n0 + n) * mt.K + k0 + kc) = make_uint4(w[0], w[1], w[2], w[3]);
      }
      __syncthreads();
    }
    base += nt;
  }
}

__device__ void phase_tables(const Params& p) {
  const int gt = blockIdx.x * 256 + otid(), nthr = gridDim.x * 256;
  float2* rope = (float2*)(p.ws + OFF_ROPE);
  for (int i = gt; i < TPB * 16; i += nthr) {
    int t = i >> 4, f = i & 15;
    float inv = powf(10000.f, -(float)f / 16.f);
    float ang = (float)t * inv;
    double rev = (double)ang * 0.15915494309189535;
    rev -= rint(rev);
    float fr = (float)rev;
    rope[i] = make_float2(__builtin_amdgcn_cosf(fr), __builtin_amdgcn_sinf(fr));
  }
  float2* lam = (float2*)(p.ws + OFF_LAM);
  float2* lamT = (float2*)(p.ws + OFF_LAMT);
  float* bb = (float*)(p.ws + OFF_BB);
  for (int i = gt; i < 2 * 16 * 64; i += nthr) {
    int lg = i >> 6, s = i & 63;
    float step = expf(p.log_step[lg]);
    float ar = p.a_re[i], ai = p.a_im[i];
    float mag = expf(ar * step);
    float th = ai * step;
    float lr = mag * cosf(th), li = mag * sinf(th);
    lam[i] = make_float2(lr, li);
    float pr = lr, pi = li;
#pragma unroll
    for (int q = 0; q < 6; ++q) { float nr2 = pr * pr - pi * pi, ni2 = 2.f * pr * pi; pr = nr2; pi = ni2; }
    lamT[i] = make_float2(pr, pi);
    float den = ar * ar + ai * ai;
    float nr = lr - 1.f, ni = li;
    float cr = (nr * ar + ni * ai) / den, ci = (ni * ar - nr * ai) / den;
    const float* brp = p.b_re + (size_t)i * 16;
    const float* bip = p.b_im + (size_t)i * 16;
#pragma unroll
    for (int c = 0; c < 16; ++c) {
      float br = brp[c], bi = bip[c];
      bb[((size_t)lg * 32 + 2 * c) * 64 + s] = cr * br - ci * bi;
      bb[((size_t)lg * 32 + 2 * c + 1) * 64 + s] = cr * bi + ci * br;
    }
  }
}

template <int MODE>
__device__ void phase_rows(const Params& p, const float* gpost, const float* gnext, bool has_next) {
  const int tid_ = otid();
  const int lane = tid_ & 63;
  const int wg = blockIdx.x * 4 + (tid_ >> 6), nw = gridDim.x * 4;
  u16* abuf = (u16*)(p.ws + OFF_ABUF);
  const u16* obuf = (const u16*)(p.ws + OFF_OBUF);
  for (int m = wg; m < MTOK; m += nw) {
    const int b = m / TPB, t = m - b * TPB;
    float* hr = t < 16 ? (float*)(p.ws + OFF_HMETA) + (size_t)(b * 16 + t) * DM
                       : p.out + ((size_t)b * 4096 + (t - 16)) * DM;
    float4 v[4];
    if (MODE == 0) {
      const float* src = t < 16 ? p.meta + (size_t)t * DM : p.x + ((size_t)b * 4096 + (t - 16)) * DM;
#pragma unroll
      for (int j = 0; j < 4; ++j) v[j] = *(const float4*)(src + j * 256 + lane * 4);
    } else {
      float4 o[4];
      float ss = 0.f;
#pragma unroll
      for (int j = 0; j < 4; ++j) {
        uint2 r = *(const uint2*)(obuf + (size_t)m * DM + j * 256 + lane * 4);
        o[j] = make_float4(bflo(r.x), bfhi(r.x), bflo(r.y), bfhi(r.y));
        ss += o[j].x * o[j].x + o[j].y * o[j].y + o[j].z * o[j].z + o[j].w * o[j].w;
      }
      ss = wave_sum(ss);
      const float rs = rsqrtf(ss * (1.f / 1024.f) + 1e-6f);
#pragma unroll
      for (int j = 0; j < 4; ++j) {
        float4 hv = *(const float4*)(hr + j * 256 + lane * 4);
        float4 g = *(const float4*)(gpost + j * 256 + lane * 4);
        v[j] = make_float4(hv.x + o[j].x * rs * g.x, hv.y + o[j].y * rs * g.y, hv.z + o[j].z * rs * g.z,
                           hv.w + o[j].w * rs * g.w);
      }
    }
#pragma unroll
    for (int j = 0; j < 4; ++j) *(float4*)(hr + j * 256 + lane * 4) = v[j];
    if (has_next) {
      float ss = 0.f;
#pragma unroll
      for (int j = 0; j < 4; ++j) ss += v[j].x * v[j].x + v[j].y * v[j].y + v[j].z * v[j].z + v[j].w * v[j].w;
      ss = wave_sum(ss);
      const float rs = rsqrtf(ss * (1.f / 1024.f) + 1e-6f);
#pragma unroll
      for (int j = 0; j < 4; ++j) {
        float4 g = *(const float4*)(gnext + j * 256 + lane * 4);
        uint2 w;
        w.x = pack2(v[j].x * rs * g.x, v[j].y * rs * g.y);
        w.y = pack2(v[j].z * rs * g.z, v[j].w * rs * g.w);
        *(uint2*)(abuf + (size_t)m * DM + j * 256 + lane * 4) = w;
      }
    }
  }
}

__device__ void phase_headnorm(const Params& p, int l) {
  const int tid_ = otid();
  const int lane = tid_ & 63;
  const int wg = blockIdx.x * 4 + (tid_ >> 6), nw = gridDim.x * 4;
  u16* abuf = (u16*)(p.ws + OFF_ABUF);
  const u16* yssm = (const u16*)(p.ws + OX_YSSM);
  const u16* yswa = (const u16*)(p.ws + OX_YSWA);
  const u16* ymla = (const u16*)(p.ws + OX_YMLA);
  const float* gh = p.g_heads + (size_t)l * 1024;
  for (int m = wg; m < MTOK; m += nw) {
    uint2 a = *(const uint2*)(yssm + (size_t)m * 256 + lane * 4);
    uint4 s = *(const uint4*)(yswa + (size_t)m * 512 + lane * 8);
    uint2 c = *(const uint2*)(ymla + (size_t)m * 256 + lane * 4);
    float av[4] = {bflo(a.x), bfhi(a.x), bflo(a.y), bfhi(a.y)};
    float sv[8] = {bflo(s.x), bfhi(s.x), bflo(s.y), bfhi(s.y), bflo(s.z), bfhi(s.z), bflo(s.w), bfhi(s.w)};
    float cv[4] = {bflo(c.x), bfhi(c.x), bflo(c.y), bfhi(c.y)};
    float s1 = 0.f, s2 = 0.f, s3 = 0.f;
#pragma unroll
    for (int e = 0; e < 4; ++e) { s1 += av[e] * av[e]; s3 += cv[e] * cv[e]; }
#pragma unroll
    for (int e = 0; e < 8; ++e) s2 += sv[e] * sv[e];
    s1 = wave_sum(s1); s2 = wave_sum(s2); s3 = wave_sum(s3);
    const float r1 = rsqrtf(s1 * (1.f / 256.f) + 1e-6f);
    const float r2 = rsqrtf(s2 * (1.f / 512.f) + 1e-6f);
    const float r3 = rsqrtf(s3 * (1.f / 256.f) + 1e-6f);
    float4 g1 = *(const float4*)(gh + lane * 4);
    float4 g2a = *(const float4*)(gh + 256 + lane * 8);
    float4 g2b = *(const float4*)(gh + 256 + lane * 8 + 4);
    float4 g3 = *(const float4*)(gh + 768 + lane * 4);
    u16* dst = abuf + (size_t)m * DM;
    uint2 w1; w1.x = pack2(av[0] * r1 * g1.x, av[1] * r1 * g1.y); w1.y = pack2(av[2] * r1 * g1.z, av[3] * r1 * g1.w);
    *(uint2*)(dst + lane * 4) = w1;
    uint4 w2;
    w2.x = pack2(sv[0] * r2 * g2a.x, sv[1] * r2 * g2a.y); w2.y = pack2(sv[2] * r2 * g2a.z, sv[3] * r2 * g2a.w);
    w2.z = pack2(sv[4] * r2 * g2b.x, sv[5] * r2 * g2b.y); w2.w = pack2(sv[6] * r2 * g2b.z, sv[7] * r2 * g2b.w);
    *(uint4*)(dst + 256 + lane * 8) = w2;
    uint2 w3; w3.x = pack2(cv[0] * r3 * g3.x, cv[1] * r3 * g3.y); w3.y = pack2(cv[2] * r3 * g3.z, cv[3] * r3 * g3.w);
    *(uint2*)(dst + 768 + lane * 4) = w3;
  }
}

__device__ void phase_mla_prep(const Params& p, int l) {
  const int tid_ = otid();
  const int lane = tid_ & 63;
  const int wg = blockIdx.x * 4 + (tid_ >> 6), nw = gridDim.x * 4;
  const u16* proj = (const u16*)(p.ws + OX_PROJ);
  u16* qn = (u16*)(p.ws + OX_QN);
  u16* cn = (u16*)(p.ws + OX_CN);
  u16* kr = (u16*)(p.ws + OX_KR);
  const float2* rope = (const float2*)(p.ws + OFF_ROPE);
  const float* gq = p.g_q + (size_t)l * 192;
  const float* gkv = p.g_kv + (size_t)l * 128;
  for (int m = wg; m < MTOK; m += nw) {
    const int b = m / TPB, t = m - b * TPB;
    const u16* pr = proj + (size_t)m * INW;
    float q0 = bf2f(pr[1024 + lane]), q1 = bf2f(pr[1024 + 64 + lane]), q2 = bf2f(pr[1024 + 128 + lane]);
    float c0 = bf2f(pr[1216 + lane]), c1 = bf2f(pr[1216 + 64 + lane]);
    float sq = wave_sum(q0 * q0 + q1 * q1 + q2 * q2);
    float sc = wave_sum(c0 * c0 + c1 * c1);
    const float rq = rsqrtf(sq * (1.f / 192.f) + 1e-6f);
    const float rc = rsqrtf(sc * (1.f / 128.f) + 1e-6f);
    qn[(size_t)m * 192 + lane] = f2bf(q0 * rq * gq[lane]);
    qn[(size_t)m * 192 + 64 + lane] = f2bf(q1 * rq * gq[64 + lane]);
    qn[(size_t)m * 192 + 128 + lane] = f2bf(q2 * rq * gq[128 + lane]);
    cn[(size_t)m * 128 + lane] = f2bf(c0 * rc * gkv[lane]);
    cn[(size_t)m * 128 + 64 + lane] = f2bf(c1 * rc * gkv[64 + lane]);
    if (lane < 16) {
      float x1 = bf2f(pr[1344 + lane]), x2 = bf2f(pr[1344 + 16 + lane]);
      float2 cs = rope[t * 16 + lane];
      kr[(size_t)m * 32 + lane] = f2bf(x1 * cs.x - x2 * cs.y);
      kr[(size_t)m * 32 + 16 + lane] = f2bf(x1 * cs.y + x2 * cs.x);
    }
  }
}

template <class Epi>
__device__ __forceinline__ void gemm_tile(const u16* __restrict__ A, int lda, int Mrows, const u16* __restrict__ Bt,
                                          int ldb, int Nrows, int K, int m0, int n0, char* lds, Epi& epi) {
  const int tid = otid(), lane = tid & 63, wid = tid >> 6, wm = wid >> 1, wn = wid & 1;
  const int lr = lane & 15, lg = lane >> 4;
  const int lrow = tid >> 3, lkc = tid & 7;
  const int wsw = (lrow >> 1) & 7;
  const u16* ap[4];
  const u16* bp[4];
#pragma unroll
  for (int j = 0; j < 4; ++j) {
    int ra = m0 + lrow + 32 * j; ra = ra < Mrows ? ra : Mrows - 1;
    int rb = n0 + lrow + 32 * j; rb = rb < Nrows ? rb : Nrows - 1;
    ap[j] = A + (size_t)ra * lda + lkc * 8;
    bp[j] = Bt + (size_t)rb * ldb + lkc * 8;
  }
  f32x4 acc[4][4];
#pragma unroll
  for (int i = 0; i < 4; ++i)
#pragma unroll
    for (int j = 0; j < 4; ++j) acc[i][j] = (f32x4){0.f, 0.f, 0.f, 0.f};
  uint4 ra[4], rb[4];
  const int nk = K >> 6;
#pragma unroll
  for (int j = 0; j < 4; ++j) { ra[j] = *(const uint4*)(ap[j]); rb[j] = *(const uint4*)(bp[j]); }
  {
    char* sa = lds; char* sb = lds + 16384;
#pragma unroll
    for (int j = 0; j < 4; ++j) {
      *(uint4*)(sa + (lrow + 32 * j) * 128 + ((lkc ^ wsw) << 4)) = ra[j];
      *(uint4*)(sb + (lrow + 32 * j) * 128 + ((lkc ^ wsw) << 4)) = rb[j];
    }
  }
  __syncthreads();
  const int rsw = (lr >> 1) & 7;
  for (int kt = 0; kt < nk; ++kt) {
    const int buf = kt & 1;
    if (kt + 1 < nk) {
#pragma unroll
      for (int j = 0; j < 4; ++j) {
        ra[j] = *(const uint4*)(ap[j] + (kt + 1) * 64);
        rb[j] = *(const uint4*)(bp[j] + (kt + 1) * 64);
      }
    }
    const char* sa = lds + buf * 32768 + (wm * 64 + lr) * 128;
    const char* sb = lds + buf * 32768 + 16384 + (wn * 64 + lr) * 128;
#pragma unroll
    for (int kk = 0; kk < 2; ++kk) {
      bf16x8 af[4], bfr[4];
      const int co = ((kk * 4 + lg) ^ rsw) << 4;
#pragma unroll
      for (int i = 0; i < 4; ++i) af[i] = *(const bf16x8*)(sa + i * 2048 + co);
#pragma unroll
      for (int j = 0; j < 4; ++j) bfr[j] = *(const bf16x8*)(sb + j * 2048 + co);
#pragma unroll
      for (int i = 0; i < 4; ++i)
#pragma unroll
        for (int j = 0; j < 4; ++j)
          acc[i][j] = Epi::STAGED ? __builtin_amdgcn_mfma_f32_16x16x32_bf16(bfr[j], af[i], acc[i][j], 0, 0, 0)
                                  : __builtin_amdgcn_mfma_f32_16x16x32_bf16(af[i], bfr[j], acc[i][j], 0, 0, 0);
    }
    if (kt + 1 < nk) {
      char* da = lds + (buf ^ 1) * 32768; char* db = da + 16384;
#pragma unroll
      for (int j = 0; j < 4; ++j) {
        *(uint4*)(da + (lrow + 32 * j) * 128 + ((lkc ^ wsw) << 4)) = ra[j];
        *(uint4*)(db + (lrow + 32 * j) * 128 + ((lkc ^ wsw) << 4)) = rb[j];
      }
    }
    __syncthreads();
  }
  if (Epi::STAGED) {
#pragma unroll
    for (int i = 0; i < 4; ++i)
#pragma unroll
      for (int j = 0; j < 4; ++j) {
        f32x4 v = acc[i][j];
        if (Epi::ACT == 1) {
#pragma unroll
          for (int r = 0; r < 4; ++r) { float x = fmaxf(v[r], 0.f); v[r] = x * x; }
        }
        uint2 w; w.x = pack2(v[0], v[1]); w.y = pack2(v[2], v[3]);
        *(uint2*)(lds + (wm * 64 + i * 16 + lr) * 272 + (wn * 64 + j * 16 + 4 * lg) * 2) = w;
      }
    __syncthreads();
#pragma unroll
    for (int q = 0; q < 8; ++q) {
      const int c = tid + 256 * q;
      const int row = c >> 4, cc = c & 15;
      if (m0 + row < Mrows && n0 + cc * 8 < Nrows)
        *(uint4*)(epi.C + (size_t)(m0 + row) * epi.ldc + n0 + cc * 8) = *(const uint4*)(lds + row * 272 + cc * 16);
    }
    __syncthreads();
  } else {
#pragma unroll
    for (int i = 0; i < 4; ++i)
#pragma unroll
      for (int j = 0; j < 4; ++j)
        epi(m0 + wm * 64 + i * 16 + 4 * lg, n0 + wn * 64 + j * 16 + lr, acc[i][j]);
  }
}

template <class Epi>
__device__ __forceinline__ void gemm_phase(const u16* A, int lda, const u16* Bt, int ldb, int N, int K, char* lds,
                                           Epi epi, int rot, int tilesM = 129, int tileLo = 0, bool rev = false) {
  const int tilesN = (N + 127) >> 7;
  const int total = tilesM * tilesN;
  int start = (int)((blockIdx.x + gridDim.x - (rot % gridDim.x)) % gridDim.x) + tileLo * tilesN;
  for (int tile = start; tile < total; tile += gridDim.x) {
    int tm = tile / tilesN; const int tn = tile - tm * tilesN;
    if (rev) tm = 128 - tm;
    gemm_tile(A, lda, MTOK, Bt, ldb, N, K, tm * 128, tn * 128, lds, epi);
  }
}

struct EpiBf16 {
  static constexpr bool STAGED = true; static constexpr int ACT = 0;
  u16* C; int ldc; int N;
  __device__ __forceinline__ void operator()(int m, int n, f32x4 v) const {
    if (n < N) {
#pragma unroll
      for (int r = 0; r < 4; ++r) if (m + r < MTOK) C[(size_t)(m + r) * ldc + n] = f2bf(v[r]);
    }
  }
};
struct EpiRelu2 {
  static constexpr bool STAGED = true; static constexpr int ACT = 1;
  u16* C; int ldc;
  __device__ __forceinline__ void operator()(int m, int n, f32x4 v) const {
#pragma unroll
    for (int r = 0; r < 4; ++r) if (m + r < MTOK) { float x = fmaxf(v[r], 0.f); C[(size_t)(m + r) * ldc + n] = f2bf(x * x); }
  }
};
struct EpiProj {
  static constexpr bool STAGED = false; static constexpr int ACT = 0;
  u16* C; int ldc;
  u16* proj; u16* vts;
  __device__ __forceinline__ void operator()(int m, int n, f32x4 v) const {
    if (n < INW && m < MTOK) {
#pragma unroll
      for (int r = 0; r < 4; ++r) proj[(size_t)(m + r) * INW + n] = f2bf(v[r]);
      if (n >= 896 && n < 1024) {
        const int kvh = (n - 896) >> 6, d = (n - 896) & 63;
        const int b = m / TPB, t = m - b * TPB;
        uint2 w; w.x = pack2(v[0], v[1]); w.y = pack2(v[2], v[3]);
        *(uint2*)(vts + ((size_t)(b * 2 + kvh) * 64 + d) * LT + t) = w;
      }
    }
  }
};
struct EpiKV {
  static constexpr bool STAGED = false; static constexpr int ACT = 0;
  u16* C; int ldc;
  u16* kn; u16* vtm;
  __device__ __forceinline__ void operator()(int m, int n, f32x4 v) const {
    if (m < MTOK) {
      if (n < 256) {
#pragma unroll
        for (int r = 0; r < 4; ++r) kn[(size_t)(m + r) * 256 + n] = f2bf(v[r]);
      } else {
        const int h = (n - 256) >> 6, d = (n - 256) & 63;
        const int b = m / TPB, t = m - b * TPB;
        uint2 w; w.x = pack2(v[0], v[1]); w.y = pack2(v[2], v[3]);
        *(uint2*)(vtm + ((size_t)(b * 4 + h) * 64 + d) * LT + t) = w;
      }
    }
  }
};
struct EpiGlu {
  static constexpr bool STAGED = false; static constexpr int ACT = 0;
  u16* C; int ldc;
  const u16* z; const float* bg; u16* y;
  __device__ __forceinline__ void operator()(int m, int n, f32x4 v) const {
    const float bb = bg[n];
#pragma unroll
    for (int r = 0; r < 4; ++r)
      if (m + r < MTOK) {
        float zz = bf2f(z[(size_t)(m + r) * 256 + n]);
        float s = 1.f / (1.f + __expf(-(v[r] + bb)));
        y[(size_t)(m + r) * 256 + n] = f2bf(zz * s);
      }
  }
};

__device__ __forceinline__ void ssm_load_u(const u16* proj, int b, int g, int ch, int lane, float* urow) {
  const int t = ch * 64 + lane;
  uint4 r0 = make_uint4(0, 0, 0, 0), r1 = make_uint4(0, 0, 0, 0);
  if (t < TPB) {
    const uint4* src = (const uint4*)(proj + (size_t)(b * TPB + t) * INW + g * 16);
    r0 = src[0]; r1 = src[1];
  }
  float4* d = (float4*)urow;
  d[0] = make_float4(bflo(r0.x), bfhi(r0.x), bflo(r0.y), bfhi(r0.y));
  d[1] = make_float4(bflo(r0.z), bfhi(r0.z), bflo(r0.w), bfhi(r0.w));
  d[2] = make_float4(bflo(r1.x), bfhi(r1.x), bflo(r1.y), bfhi(r1.y));
  d[3] = make_float4(bflo(r1.z), bfhi(r1.z), bflo(r1.w), bfhi(r1.w));
}

#define SSM_STEP(UP)                                                                          \
  {                                                                                           \
    const float4 u0 = (UP)[0], u1 = (UP)[1], u2 = (UP)[2], u3 = (UP)[3];                      \
    float sr = u0.x * br[0], si = u0.x * bi[0];                                               \
    sr += u0.y * br[1]; si += u0.y * bi[1]; sr += u0.z * br[2]; si += u0.z * bi[2];           \
    sr += u0.w * br[3]; si += u0.w * bi[3]; sr += u1.x * br[4]; si += u1.x * bi[4];           \
    sr += u1.y * br[5]; si += u1.y * bi[5]; sr += u1.z * br[6]; si += u1.z * bi[6];           \
    sr += u1.w * br[7]; si += u1.w * bi[7]; sr += u2.x * br[8]; si += u2.x * bi[8];           \
    sr += u2.y * br[9]; si += u2.y * bi[9]; sr += u2.z * br[10]; si += u2.z * bi[10];         \
    sr += u2.w * br[11]; si += u2.w * bi[11]; sr += u3.x * br[12]; si += u3.x * bi[12];       \
    sr += u3.y * br[13]; si += u3.y * bi[13]; sr += u3.z * br[14]; si += u3.z * bi[14];       \
    sr += u3.w * br[15]; si += u3.w * bi[15];                                                 \
    const float nxr = lam.x * xr - lam.y * xi + sr;                                           \
    const float nxi = lam.x * xi + lam.y * xr + si;                                           \
    xr = nxr; xi = nxi;                                                                       \
  }

__device__ void phase_ssm_a(const Params& p, int l, char* lds) {
  const u16* proj = (const u16*)(p.ws + OX_PROJ);
  const int tid_ = otid();
  const int lane = tid_ & 63, w = tid_ >> 6;
  const float* bbt = (const float*)(p.ws + OFF_BB);
  const float2* lamt = (const float2*)(p.ws + OFF_LAM);
  float2* endp = (float2*)(p.ws + OFF_END2 + (size_t)l * END_BYTES);
  for (int item = blockIdx.x; item < 64 * 17; item += gridDim.x) {
    const int bg = item / 17, cq = item - bg * 17;
    const int b = bg >> 4, g = bg & 15;
    const int ch = cq * 4 + w;
    if (ch < NCH) {
      float br[16], bi[16];
      const float* bbp = bbt + ((size_t)(l * 16 + g) * 32) * 64 + lane;
#pragma unroll
      for (int c = 0; c < 16; ++c) { br[c] = bbp[(2 * c) * 64]; bi[c] = bbp[(2 * c + 1) * 64]; }
      const float2 lam = lamt[(l * 16 + g) * 64 + lane];
      float xr = 0.f, xi = 0.f;
      const int tend = (ch * 64 + 64 < TPB) ? 64 : (TPB - ch * 64);
      const u16* urow = proj + (size_t)(b * TPB + ch * 64) * INW + g * 16;
      for (int tt = 0; tt < 64; ++tt) {
        uint4 r0 = make_uint4(0, 0, 0, 0), r1 = make_uint4(0, 0, 0, 0);
        if (tt < tend) { const uint4* s4 = (const uint4*)(urow + (size_t)tt * INW); r0 = s4[0]; r1 = s4[1]; }
        float4 u4[4];
        u4[0] = make_float4(bflo(r0.x), bfhi(r0.x), bflo(r0.y), bfhi(r0.y));
        u4[1] = make_float4(bflo(r0.z), bfhi(r0.z), bflo(r0.w), bfhi(r0.w));
        u4[2] = make_float4(bflo(r1.x), bfhi(r1.x), bflo(r1.y), bfhi(r1.y));
        u4[3] = make_float4(bflo(r1.z), bfhi(r1.z), bflo(r1.w), bfhi(r1.w));
        SSM_STEP(u4)
      }
      endp[((size_t)(b * 16 + g) * NCH + ch) * 64 + lane] = make_float2(xr, xi);
    }
  }
}

__device__ __forceinline__ float gelu_tanh(float y) {
  const float a = 0.7978845608028654f * (y + 0.044715f * y * y * y);
  const float th = 1.f - 2.f / (1.f + __expf(2.f * a));
  return 0.5f * y * (1.f + th);
}

__device__ void phase_ssm_c(const Params& p, int l, char* lds) {
  const u16* proj = (const u16*)(p.ws + OX_PROJ);
  u16* z = (u16*)(p.ws + OX_Z);
  float* Cs = (float*)lds;
  float* us = Cs + 2048;
  float* xs = us + 4096;
  const int tid = otid(), lane = tid & 63, w = tid >> 6;
  const float* bbt = (const float*)(p.ws + OFF_BB);
  const float2* lamt = (const float2*)(p.ws + OFF_LAM);
  const float2* lamTt = (const float2*)(p.ws + OFF_LAMT);
  const float2* endp = (const float2*)(p.ws + OFF_END2 + (size_t)l * END_BYTES);
  for (int item = blockIdx.x; item < 64 * 17; item += gridDim.x) {
    const int bg = item / 17, cq = item - bg * 17;
    const int b = bg >> 4, g = bg & 15;
    {
      const float* cre = p.c_re + (size_t)(l * 16 + g) * 1024;
      const float* cim = p.c_im + (size_t)(l * 16 + g) * 1024;
#pragma unroll
      for (int j = 0; j < 4; ++j) {
        int idx = tid + 256 * j;
        *(float2*)(Cs + idx * 2) = make_float2(cre[idx], cim[idx]);
      }
    }
    __syncthreads();
    const int ch0 = cq * 4 + w;
    const bool valid = ch0 < NCH;
    const int ch = valid ? ch0 : NCH - 1;
    {
      ssm_load_u(proj, b, g, ch, lane, us + (w * 64 + lane) * 16);
      __syncthreads();
      float br[16], bi[16];
      const float* bbp = bbt + ((size_t)(l * 16 + g) * 32) * 64 + lane;
#pragma unroll
      for (int c = 0; c < 16; ++c) { br[c] = bbp[(2 * c) * 64]; bi[c] = bbp[(2 * c + 1) * 64]; }
      const float2 lam = lamt[(l * 16 + g) * 64 + lane];
      const float2 lamT = lamTt[(l * 16 + g) * 64 + lane];
      float xr = 0.f, xi = 0.f;
      const float2* ep = endp + ((size_t)(b * 16 + g) * NCH) * 64 + lane;
      for (int j = 0; j < ch; ++j) {
        const float2 e = ep[(size_t)j * 64];
        const float nxr = lamT.x * xr - lamT.y * xi + e.x;
        const float nxi = lamT.x * xi + lamT.y * xr + e.y;
        xr = nxr; xi = nxi;
      }
      const int tl = lane & 15, c4 = lane >> 4;
      const float4 dsk = *(const float4*)(p.d_skip + (size_t)l * 256 + g * 16 + c4 * 4);
      for (int sub = 0; sub < 4; ++sub) {
        for (int tt = 0; tt < 16; ++tt) {
          const float4* up = (const float4*)(us + (w * 64 + sub * 16 + tt) * 16);
          SSM_STEP(up)
          *(float2*)(xs + (w * 16 + tt) * 132 + 2 * lane) = make_float2(xr, xi);
        }
        __syncthreads();
        const float* xrow = xs + (w * 16 + tl) * 132;
        const float* crow = Cs + (c4 * 4) * 128;
        float a0 = 0.f, a1 = 0.f, a2 = 0.f, a3 = 0.f;
#pragma unroll 4
        for (int pp = 0; pp < 32; ++pp) {
          const float4 xv = *(const float4*)(xrow + 4 * pp);
          const float4 c0 = *(const float4*)(crow + 4 * pp);
          const float4 c1 = *(const float4*)(crow + 128 + 4 * pp);
          const float4 c2 = *(const float4*)(crow + 256 + 4 * pp);
          const float4 c3 = *(const float4*)(crow + 384 + 4 * pp);
          a0 += c0.x * xv.x - c0.y * xv.y + c0.z * xv.z - c0.w * xv.w;
          a1 += c1.x * xv.x - c1.y * xv.y + c1.z * xv.z - c1.w * xv.w;
          a2 += c2.x * xv.x - c2.y * xv.y + c2.z * xv.z - c2.w * xv.w;
          a3 += c3.x * xv.x - c3.y * xv.y + c3.z * xv.z - c3.w * xv.w;
        }
        __syncthreads();
        const int tok = ch * 64 + sub * 16 + tl;
        const float4 uv = *(const float4*)(us + (w * 64 + sub * 16 + tl) * 16 + c4 * 4);
        if (valid && tok < TPB) {
          uint2 wv;
          wv.x = pack2(gelu_tanh(a0 + dsk.x * uv.x), gelu_tanh(a1 + dsk.y * uv.y));
          wv.y = pack2(gelu_tanh(a2 + dsk.z * uv.z), gelu_tanh(a3 + dsk.w * uv.w));
          *(uint2*)(z + (size_t)(b * TPB + tok) * 256 + g * 16 + c4 * 4) = wv;
        }
      }
    }
    __syncthreads();
  }
}

template <bool MLA>
__device__ void attn_item(const Params& p, int l, int b, int head, int qt, char* lds) {
  constexpr int NDS = MLA ? 3 : 2;
  const int tid = otid(), lane = tid & 63, w = tid >> 6;
  const int lr = lane & 15, lg = lane >> 4;
  const u16* proj = (const u16*)(p.ws + OX_PROJ);
  const u16* krope = (const u16*)(p.ws + OX_KR);
  const u16* Ksrc; int kld; const u16* Vt; u16* Y; int ldy;
  if (MLA) {
    Ksrc = (const u16*)(p.ws + OX_KN) + head * 64; kld = 256;
    Vt = (const u16*)(p.ws + OX_VTM) + (size_t)(b * 4 + head) * 64 * LT;
    Y = (u16*)(p.ws + OX_YMLA); ldy = 256;
  } else {
    const int kvh = head >> 2;
    Ksrc = proj + 768 + kvh * 64; kld = INW;
    Vt = (const u16*)(p.ws + OX_VTS) + (size_t)(b * 2 + kvh) * 64 * LT;
    Y = (u16*)(p.ws + OX_YSWA); ldy = 512;
  }
  const int q0 = qt * 128;
  const int kt_hi = (2 * qt + 1) < 64 ? (2 * qt + 1) : 64;
  const int kt_lo = MLA ? 0 : ((2 * qt - 2) > 0 ? (2 * qt - 2) : 0);
  const float LOG2E = 1.4426950408889634f;
  const float c1 = (MLA ? 0.10206207261596575f : 0.125f) * LOG2E;
  float sl2 = 0.f, sink2 = 0.f;
  if (!MLA) {
    sl2 = exp2f(-(float)(head + 1)) * LOG2E;
    sink2 = p.sinks[l * 8 + head] * LOG2E;
  }
  bf16x8 qf[2][NDS];
#pragma unroll
  for (int qs = 0; qs < 2; ++qs) {
    int tq = q0 + 32 * w + 16 * qs + lr; tq = tq < TPB ? tq : TPB - 1;
    const size_t m = (size_t)b * TPB + tq;
    if (!MLA) {
      const u16* qp = proj + m * INW + 256 + head * 64;
      qf[qs][0] = *(const bf16x8*)(qp + lg * 8);
      qf[qs][1] = *(const bf16x8*)(qp + 32 + lg * 8);
    } else {
      const u16* qp = (const u16*)(p.ws + OX_QMLA) + m * 384 + head * 96;
      qf[qs][0] = *(const bf16x8*)(qp + lg * 8);
      qf[qs][1] = *(const bf16x8*)(qp + 32 + lg * 8);
      const uint4 own = *(const uint4*)(qp + 64 + lg * 8);
      const uint4 par = *(const uint4*)(qp + 64 + (lg ^ 2) * 8);
      const float2* cs = (const float2*)(p.ws + OFF_ROPE) + tq * 16 + (lg & 1) * 8;
      const unsigned ow[4] = {own.x, own.y, own.z, own.w};
      const unsigned pw[4] = {par.x, par.y, par.z, par.w};
      unsigned rw[4];
#pragma unroll
      for (int e2 = 0; e2 < 4; ++e2) {
        const float2 csa = cs[2 * e2], csb = cs[2 * e2 + 1];
        const float oa = bflo(ow[e2]), ob = bfhi(ow[e2]), pa = bflo(pw[e2]), pb = bfhi(pw[e2]);
        float ra, rb;
        if (lg < 2) { ra = oa * csa.x - pa * csa.y; rb = ob * csb.x - pb * csb.y; }
        else { ra = pa * csa.y + oa * csa.x; rb = pb * csb.y + ob * csb.x; }
        rw[e2] = pack2(ra, rb);
      }
      uint4 r4 = make_uint4(rw[0], rw[1], rw[2], rw[3]);
      qf[qs][NDS - 1] = *(bf16x8*)&r4;
    }
  }
  float mrow[2], lrow[2];
  f32x4 o[2][4];
#pragma unroll
  for (int qs = 0; qs < 2; ++qs) {
    mrow[qs] = MLA ? -1e30f : sink2; lrow[qs] = 0.f;
#pragma unroll
    for (int jt = 0; jt < 4; ++jt) o[qs][jt] = (f32x4){0.f, 0.f, 0.f, 0.f};
  }
  uint4 rk0, rk1, rv0, rv1, rkr;
  rkr = make_uint4(0, 0, 0, 0);
  const int skey = tid >> 3, skc = tid & 7;
  const int rkey = tid >> 2, rkc = tid & 3;
  const u16* kptr = Ksrc + ((size_t)b * TPB + skey) * kld + skc * 8;
  const u16* vptr = Vt + (size_t)skey * LT + skc * 8;
  const u16* krptr = krope + ((size_t)b * TPB + rkey) * 32 + rkc * 8;
  const int kw_off = skey * 128 + ((skc ^ (((skey >> 1) & 1) | (((skey >> 3) & 3) << 1))) << 4);
  const int vw_off = skey * 128 + ((skc ^ ((skey >> 1) & 7)) << 4);
  const int krx = (rkey >> 3) & 3;
  const int krw_off = rkey * 64 + ((rkc ^ (krx ^ ((krx & 1) << 1))) << 4);
#define ATT_GLOAD(KT)                                                        \
  {                                                                          \
    const int k0_ = (KT) * 64;                                               \
    rk0 = *(const uint4*)(kptr + (size_t)k0_ * kld);                         \
    rk1 = *(const uint4*)(kptr + (size_t)(k0_ + 32) * kld);                  \
    rv0 = *(const uint4*)(vptr + k0_);                                       \
    rv1 = *(const uint4*)(vptr + (size_t)32 * LT + k0_);                     \
    if (MLA) rkr = *(const uint4*)(krptr + (size_t)k0_ * 32);                \
  }
#define ATT_SWRITE(BUF)                                                      \
  {                                                                          \
    char* Kb_ = lds + (BUF) * 20480;                                         \
    *(uint4*)(Kb_ + kw_off) = rk0;                                           \
    *(uint4*)(Kb_ + kw_off + 32 * 128) = rk1;                                \
    *(uint4*)(Kb_ + 8192 + vw_off) = rv0;                                    \
    *(uint4*)(Kb_ + 8192 + vw_off + 32 * 128) = rv1;                         \
    if (MLA) *(uint4*)(Kb_ + 16384 + krw_off) = rkr;                         \
  }
  ATT_GLOAD(kt_lo)
  ATT_SWRITE(0)
  __syncthreads();
  const int fsw = ((lr >> 1) & 1) | ((lr >> 2) << 1);
  const int xh = (lr >> 2) ^ (((lr >> 2) & 1) << 1);
  const int vsw = (lr >> 1) & 7;
  for (int kt = kt_lo; kt <= kt_hi; ++kt) {
    const int buf = (kt - kt_lo) & 1;
    if (kt < kt_hi) ATT_GLOAD(kt + 1)
    const char* Kb = lds + buf * 20480; const char* Vb = Kb + 8192; const char* Krb = Kb + 16384;
    f32x4 s[2][2][2];
#pragma unroll
    for (int kk = 0; kk < 2; ++kk)
#pragma unroll
      for (int j = 0; j < 2; ++j) {
        const int keyl = 32 * kk + 8 * (lr >> 2) + 4 * j + (lr & 3);
        f32x4 s0 = (f32x4){0.f, 0.f, 0.f, 0.f}, s1 = (f32x4){0.f, 0.f, 0.f, 0.f};
#pragma unroll
        for (int ds = 0; ds < 2; ++ds) {
          const bf16x8 kf = *(const bf16x8*)(Kb + keyl * 128 + (((ds * 4 + lg) ^ fsw) << 4));
          s0 = __builtin_amdgcn_mfma_f32_16x16x32_bf16(kf, qf[0][ds], s0, 0, 0, 0);
          s1 = __builtin_amdgcn_mfma_f32_16x16x32_bf16(kf, qf[1][ds], s1, 0, 0, 0);
        }
        if (MLA) {
          const bf16x8 kf = *(const bf16x8*)(Krb + keyl * 64 + ((lg ^ xh) << 4));
          s0 = __builtin_amdgcn_mfma_f32_16x16x32_bf16(kf, qf[0][NDS - 1], s0, 0, 0, 0);
          s1 = __builtin_amdgcn_mfma_f32_16x16x32_bf16(kf, qf[1][NDS - 1], s1, 0, 0, 0);
        }
        s[0][kk][j] = s0; s[1][kk][j] = s1;
      }
    bf16x8 pf[2][2];
#pragma unroll
    for (int qs = 0; qs < 2; ++qs) {
      const int tq = q0 + 32 * w + 16 * qs + lr;
      float mx = -INFINITY;
#pragma unroll
      for (int kk = 0; kk < 2; ++kk)
#pragma unroll
        for (int j = 0; j < 2; ++j)
#pragma unroll
          for (int i = 0; i < 4; ++i) {
            const int key = kt * 64 + 32 * kk + 8 * lg + 4 * j + i;
            float v = s[qs][kk][j][i] * c1;
            bool ok;
            if (MLA) ok = key <= tq;
            else { v -= sl2 * (float)(tq - key); ok = (key <= tq) && (key > tq - 128); }
            v = ok ? v : -INFINITY;
            s[qs][kk][j][i] = v;
            mx = fmaxf(mx, v);
          }
      mx = fmaxf(mx, __shfl_xor(mx, 16));
      mx = fmaxf(mx, __shfl_xor(mx, 32));
      const float mnew = fmaxf(mrow[qs], mx);
      const float alpha = fexp2(mrow[qs] - mnew);
      mrow[qs] = mnew;
      float ps = 0.f;
#pragma unroll
      for (int kk = 0; kk < 2; ++kk) {
        float pv[8];
#pragma unroll
        for (int j = 0; j < 2; ++j)
#pragma unroll
          for (int i = 0; i < 4; ++i) {
            const float e = fexp2(s[qs][kk][j][i] - mnew);
            pv[j * 4 + i] = e; ps += e;
          }
        uint4 r4 = make_uint4(pack2(pv[0], pv[1]), pack2(pv[2], pv[3]), pack2(pv[4], pv[5]), pack2(pv[6], pv[7]));
        pf[qs][kk] = *(bf16x8*)&r4;
      }
      lrow[qs] = lrow[qs] * alpha + ps;
#pragma unroll
      for (int jt = 0; jt < 4; ++jt) o[qs][jt] *= alpha;
    }
#pragma unroll
    for (int jt = 0; jt < 4; ++jt)
#pragma unroll
      for (int kk = 0; kk < 2; ++kk) {
        const bf16x8 vf = *(const bf16x8*)(Vb + (16 * jt + lr) * 128 + (((4 * kk + lg) ^ vsw) << 4));
        o[0][jt] = __builtin_amdgcn_mfma_f32_16x16x32_bf16(vf, pf[0][kk], o[0][jt], 0, 0, 0);
        o[1][jt] = __builtin_amdgcn_mfma_f32_16x16x32_bf16(vf, pf[1][kk], o[1][jt], 0, 0, 0);
      }
    if (kt < kt_hi) ATT_SWRITE(buf ^ 1)
    __syncthreads();
  }
#pragma unroll
  for (int qs = 0; qs < 2; ++qs) {
    const int tq = q0 + 32 * w + 16 * qs + lr;
    float lsum = lrow[qs];
    lsum += __shfl_xor(lsum, 16);
    lsum += __shfl_xor(lsum, 32);
    if (!MLA) lsum += fexp2(sink2 - mrow[qs]);
    const float inv = 1.f / lsum;
    if (tq < TPB) {
      u16* yp = Y + ((size_t)b * TPB + tq) * ldy + head * 64 + 4 * lg;
#pragma unroll
      for (int jt = 0; jt < 4; ++jt) {
        uint2 wv;
        wv.x = pack2(o[qs][jt][0] * inv, o[qs][jt][1] * inv);
        wv.y = pack2(o[qs][jt][2] * inv, o[qs][jt][3] * inv);
        *(uint2*)(yp + 16 * jt) = wv;
      }
    }
  }
}


#define UP_EXP OFF_X
#define UP_TILES 16
#define P9_LO 0
#define P9_HI 129
#ifndef STOP_AFTER
#define STOP_AFTER 0
#endif
__device__ void dump_bf16(const Params& p, const u16* buf, int ld, int coloff, int shift = 0) {
  const int tid_ = otid();
  const int lane = tid_ & 63;
  const int wg = (int)((blockIdx.x + shift) % gridDim.x) * 4 + (tid_ >> 6), nw = gridDim.x * 4;
  for (int m = wg; m < MTOK; m += nw) {
    const int b = m / TPB, t = m - b * TPB;
    if (t < 16) continue;
    float* o = p.out + ((size_t)b * 4096 + (t - 16)) * DM;
    for (int j = 0; j < 16; ++j) o[j * 64 + lane] = bf2f(buf[(size_t)m * ld + coloff + j * 64 + lane]);
  }
}
#define XB_TMO      128
#define XB_XCNT(j)  (256  + 64 * (j))
#define XB_XSUB(j)  (1280 + 64 * (j))
#define XB_XGEN(j)  (2304 + 64 * (j))
#define XB_TOP      3328
#define XB_TOPGEN   3392
#define XCD_BAR_WORDS 3456
#define XB_SPIN_CAP (1u << 22)
#define LAS __attribute__((address_space(3)))
__device__ __forceinline__ unsigned xb_ld(unsigned* p) { return __hip_atomic_load(p, __ATOMIC_RELAXED, __HIP_MEMORY_SCOPE_AGENT); }
__device__ __forceinline__ unsigned xb_add(unsigned* p, unsigned v) { return __hip_atomic_fetch_add(p, v, __ATOMIC_RELAXED, __HIP_MEMORY_SCOPE_AGENT); }
__device__ __forceinline__ unsigned xb_xcc_id() { return (unsigned)__builtin_amdgcn_s_getreg((3 << 11) | 20) & 0xFu; }
#define XB_SPIN(cond, bar) do { unsigned _sp = 0; while (cond) { __builtin_amdgcn_s_sleep(1); \
    if ((++_sp & 255u) == 0u) { if (xb_ld(&(bar)[XB_TMO])) break; if (_sp > XB_SPIN_CAP) { atomicAdd(&(bar)[XB_TMO], 1u); break; } } } } while (0)
struct XcdBarrier { unsigned* bar; unsigned x; volatile unsigned* st; };
__device__ __forceinline__ XcdBarrier xcd_barrier_post(unsigned* bar, volatile unsigned* st) {
  XcdBarrier b; b.bar = bar; b.x = xb_xcc_id(); b.st = st;
  if (threadIdx.x == 0) (void)xb_add(&bar[XB_XCNT(b.x)], 1u);
  return b;
}
__device__ __forceinline__ void xcd_barrier_complete(unsigned* bar, unsigned x, unsigned& nloc, unsigned& nx) {
  const unsigned G = gridDim.x * gridDim.y * gridDim.z;
  unsigned sum, cnt, mine, sp = 0u;
  for (;;) {
    sum = 0u; cnt = 0u; mine = 0u;
#pragma unroll
    for (unsigned j = 0; j < 16; ++j) { const unsigned c = xb_ld(&bar[XB_XCNT(j)]); sum += c; cnt += (c > 0u) ? 1u : 0u; mine = (j == x) ? c : mine; }
    if (sum == G) break;
    __builtin_amdgcn_s_sleep(1);
    if ((++sp & 255u) == 0u) { if (xb_ld(&bar[XB_TMO])) break; if (sp > XB_SPIN_CAP) { atomicAdd(&bar[XB_TMO], 1u); break; } }
  }
  nloc = mine > 0u ? mine : 1u; nx = cnt > 0u ? cnt : 1u;
}
__device__ __attribute__((noinline)) void xcd_barrier_impl(unsigned* bar_, unsigned bx_, volatile unsigned* st_) {
  XcdBarrier b; b.bar = bar_; b.x = bx_; b.st = st_;
  asm volatile("s_waitcnt vmcnt(0)" ::: "memory");
  __syncthreads();
  if (threadIdx.x == 0) {
    unsigned* bar = b.bar;
    __builtin_amdgcn_s_waitcnt(0);
    unsigned nloc = b.st[0], nx = b.st[1];
    if (nloc == 0u) { xcd_barrier_complete(bar, b.x, nloc, nx); b.st[0] = nloc; b.st[1] = nx; }
    const unsigned old = xb_add(&bar[XB_XSUB(b.x)], 1u);
    const unsigned gen = old / nloc;
    if (old + 1u == (gen + 1u) * nloc) {
      __builtin_amdgcn_fence(__ATOMIC_RELEASE, "agent");
      asm volatile("s_waitcnt vmcnt(0)" ::: "memory");
      const unsigned og = xb_add(&bar[XB_TOP], 1u);
      const unsigned tg = og / nx;
      if (og + 1u == (tg + 1u) * nx) xb_add(&bar[XB_TOPGEN], 1u);
      else XB_SPIN(xb_ld(&bar[XB_TOPGEN]) == tg, bar);
      __builtin_amdgcn_fence(__ATOMIC_ACQUIRE, "agent");
      xb_add(&bar[XB_XGEN(b.x)], 1u);
      asm volatile("s_waitcnt vmcnt(0)" ::: "memory");
    } else {
      XB_SPIN(xb_ld(&bar[XB_XGEN(b.x)]) == gen, bar);
      __builtin_amdgcn_fence(__ATOMIC_ACQUIRE, "agent");
      asm volatile("s_waitcnt vmcnt(0)" ::: "memory");
    }
  }
  __syncthreads();
}
#define GSYNC() xcd_barrier_impl(xb.bar, xb.x, xb.st)
__global__ void __launch_bounds__(256, 2) hymba_megakernel(Params p, int ph_lo, int ph_hi) {
  cg::grid_group grid = cg::this_grid();
  __shared__ __attribute__((aligned(16))) char lds[65536];
  char* ws = p.ws;
  u16* abuf = (u16*)(ws + OFF_ABUF);
  u16* obuf = (u16*)(ws + OFF_OBUF);
  XcdBarrier xb; xb.bar = (unsigned*)(p.ws + OFF_BAR); xb.x = 0;
  xb.st = (volatile unsigned*)(p.ws + OFF_BAR) + 4096 + 2 * blockIdx.x;
  const bool fused = (ph_hi - ph_lo) > 1;
  if (fused) {
    xb = xcd_barrier_post((unsigned*)(p.ws + OFF_BAR), xb.st);
    grid.sync();
  }
  int pi = 0;
#define RUN (pi >= ph_lo && pi < ph_hi)
#define END_PHASE() do { if (pi >= ph_lo && pi + 1 < ph_hi) GSYNC(); ++pi; } while (0)
  if (RUN && (PH & 1)) phase_convert(p, lds);
  if (RUN && (PH & 2)) phase_tables(p);
  if (RUN && (PH & 4)) phase_rows<0>(p, nullptr, p.g_pre_mix, true);
  END_PHASE();

  for (int l = 0; l < 2; ++l) {
    char* wb = ws + OFF_W + (size_t)l * W_LAYER;
    if (RUN && (PH & 8)) {
      EpiProj e{nullptr, 0, (u16*)(ws + OX_PROJ), (u16*)(ws + OX_VTS)};
      gemm_phase(abuf, DM, (const u16*)(wb + OW_IN), DM, INW, DM, lds, e, 0);
    }
    END_PHASE();
    if (STOP_AFTER == 1) { dump_bf16(p, (const u16*)(ws + OX_PROJ), INW, 0); return; }
    if (RUN && (PH & 32)) phase_ssm_a(p, l, lds);
    if (RUN && (PH & 64)) phase_mla_prep(p, l);
    END_PHASE();
    if (RUN && (PH & 128)) phase_ssm_c(p, l, lds);
    END_PHASE();
    if (RUN && (PH & 16)) for (int it = blockIdx.x; it < 4 * 8 * 33; it += gridDim.x) {
      const int qt = it / 32, r = it - qt * 32;
      attn_item<false>(p, l, r >> 3, r & 7, qt, lds);
    }
    if (RUN && (PH & 256)) {
      EpiBf16 e{(u16*)(ws + OX_QMLA), 384, 384};
      gemm_phase((const u16*)(ws + OX_QN), 192, (const u16*)(wb + OW_UQ), 192, 384, 192, lds, e, 64);
    }
    if (RUN && (PH & 512)) {
      EpiKV e{nullptr, 0, (u16*)(ws + OX_KN), (u16*)(ws + OX_VTM)};
      gemm_phase((const u16*)(ws + OX_CN), 128, (const u16*)(wb + OW_UKV), 128, 512, 128, lds, e, 200);
    }
    END_PHASE();
    if (RUN && (PH & 1024)) for (int it = blockIdx.x; it < 4 * 4 * 33; it += gridDim.x) {
      const int qt = 32 - it / 16, r = it & 15;
      attn_item<true>(p, l, r >> 2, r & 3, qt, lds);
    }
    if (RUN && (PH & 2048)) {
      EpiGlu e{nullptr, 0, (const u16*)(ws + OX_Z), p.b_glu + (size_t)l * 256, (u16*)(ws + OX_YSSM)};
      gemm_phase((const u16*)(ws + OX_Z), 256, (const u16*)(wb + OW_GLU), 256, 256, 256, lds, e, 16);
    }
    END_PHASE();
    if (RUN && (PH & 4096)) phase_headnorm(p, l);
    END_PHASE();
    if (STOP_AFTER == 5) { dump_bf16(p, abuf, DM, 0); return; }
    if (RUN && (PH & 8192)) {
      EpiBf16 e{obuf, DM, DM};
      gemm_phase(abuf, DM, (const u16*)(wb + OW_OUT), DM, DM, DM, lds, e, 0);
    }
    END_PHASE();
    if (RUN && (PH & 16384)) phase_rows<1>(p, p.g_post_mix + (size_t)l * DM, p.g_pre_mlp + (size_t)l * DM, true);
    END_PHASE();
    if (STOP_AFTER == 7) { dump_bf16(p, abuf, DM, 0); return; }
    if (RUN && (PH & 32768)) {
      EpiRelu2 e{(u16*)(ws + OFF_X), UPLD};
      gemm_phase(abuf, DM, (const u16*)(wb + OW_UP), DM, DFF, DM, lds, e, 0);
    }
    END_PHASE();
    if (RUN && (PH & 65536)) {
      EpiBf16 e{obuf, DM, DM};
      gemm_phase((const u16*)(ws + OFF_X), UPLD, (const u16*)(wb + OW_DN), DFF, DM, DFF, lds, e, 0);
    }
    END_PHASE();
    if (STOP_AFTER == 9) { dump_bf16(p, obuf, DM, 0, 3); return; }
    if (RUN && (PH & 131072)) phase_rows<1>(p, p.g_post_mlp + (size_t)l * DM, p.g_pre_mix + (size_t)(l < 1 ? l + 1 : l) * DM, l < 1);
    if (l < 1) END_PHASE();
  }
}

extern "C" void kernel_launch(void* const* d_in, const int* in_sizes, int n_in, void* d_out, int out_size, void* d_ws,
                              size_t ws_size, hipStream_t stream) {
  static int grid_blocks = 0;
  if (!grid_blocks) {
    int dev = 0, cus = 0, per_cu = 0;
    hipGetDevice(&dev);
    hipDeviceGetAttribute(&cus, hipDeviceAttributeMultiprocessorCount, dev);
    hipOccupancyMaxActiveBlocksPerMultiprocessor(&per_cu, hymba_megakernel, 256, 0);
    if (per_cu > 2) per_cu = 2;
    if (per_cu < 1) per_cu = 1;
    grid_blocks = cus * per_cu;
  }
  Params p{};
  const float** f = (const float**)&p;
  for (int i = 0; i < 27; ++i) f[i] = (const float*)d_in[i];
  p.out = (float*)d_out;
  p.ws = (char*)d_ws;
  hipMemsetAsync((char*)d_ws + OFF_BAR, 0, 32768, stream);
#ifndef N_LAUNCH_MODE
#define N_LAUNCH_MODE 1
#endif
  if (N_LAUNCH_MODE == 1) {
    int lo = 0, hi = 23;
    void* args[] = {&p, &lo, &hi};
    hipError_t e = hipLaunchCooperativeKernel((void*)hymba_megakernel, dim3(grid_blocks), dim3(256), args, 0, stream);
    if (e != hipSuccess) fprintf(stderr, "cooperative launch failed: %s (grid %d)\n", hipGetErrorString(e), grid_blocks);
  } else {
    for (int i = 0; i < 23; ++i) hipLaunchKernelGGL(hymba_megakernel, dim3(grid_blocks), dim3(256), 0, stream, p, i, i + 1);
  }
}
```

```cpp
#include <hip/hip_runtime.h>
#include <hip/hip_cooperative_groups.h>
#include <cstdio>
#include <cstdint>
namespace cg = cooperative_groups;

typedef unsigned short u16;
using bf16x8 = __attribute__((ext_vector_type(8))) short;
using f32x4 = __attribute__((ext_vector_type(4))) float;

#define TPB 4112
#define MTOK 16448
#define MPAD 16512
#define DM 1024
#define INW 1376
#define DFF 4096
#define LT 4160
#define NCH 65
#ifndef PH
#define PH 0x3ffff
#endif
#ifndef TIMING
#define TIMING 0
#endif
#define T1_LO 6
#define T1_HI 9
#define T2_LO 0
#define T2_HI 1

constexpr size_t al256(size_t x) { return (x + 255) & ~(size_t)255; }
constexpr size_t cmax(size_t a, size_t b) { return a > b ? a : b; }
constexpr size_t OW_IN = 0;
constexpr size_t OW_OUT = OW_IN + (size_t)INW * DM * 2;
constexpr size_t OW_UP = OW_OUT + (size_t)DM * DM * 2;
constexpr size_t OW_DN = OW_UP + (size_t)DFF * DM * 2;
constexpr size_t OW_UQ = OW_DN + (size_t)DFF * DM * 2;
constexpr size_t OW_UKV = OW_UQ + (size_t)384 * 192 * 2;
constexpr size_t OW_GLU = OW_UKV + (size_t)512 * 128 * 2;
constexpr size_t W_LAYER = OW_GLU + (size_t)256 * 256 * 2;
constexpr size_t OFF_W = 0;
constexpr size_t OFF_ROPE = OFF_W + 2 * W_LAYER;
constexpr size_t OFF_LAM = OFF_ROPE + al256((size_t)TPB * 16 * 8);
constexpr size_t OFF_LAMT = OFF_LAM + 2 * 16 * 64 * 8;
constexpr size_t OFF_BB = OFF_LAMT + 2 * 16 * 64 * 8;
constexpr size_t OFF_BAR = OFF_BB + 2 * 16 * 32 * 64 * 4;
constexpr size_t OFF_HMETA = OFF_BAR + 32768;
constexpr size_t OFF_ABUF = OFF_HMETA + 4 * 16 * 1024 * 4;
constexpr size_t OFF_OBUF = OFF_ABUF + (size_t)MPAD * DM * 2;
constexpr size_t OFF_X = OFF_OBUF + (size_t)MPAD * DM * 2;
constexpr size_t OX_PROJ = OFF_X;
constexpr size_t OX_Z = OX_PROJ + (size_t)MPAD * INW * 2;
constexpr size_t OX_YSSM = OX_Z + (size_t)MPAD * 256 * 2;
constexpr size_t OX_YSWA = OX_YSSM + (size_t)MPAD * 256 * 2;
constexpr size_t OX_YMLA = OX_YSWA + (size_t)MPAD * 512 * 2;
constexpr size_t OX_QN = OX_YMLA + (size_t)MPAD * 256 * 2;
constexpr size_t OX_CN = OX_QN + (size_t)MPAD * 192 * 2;
constexpr size_t OX_KR = OX_CN + (size_t)MPAD * 128 * 2;
constexpr size_t OX_QMLA = OX_KR + (size_t)MPAD * 32 * 2;
constexpr size_t OX_KN = OX_QMLA + (size_t)MPAD * 384 * 2;
constexpr size_t OX_VTM = OX_KN + (size_t)MPAD * 256 * 2;
constexpr size_t OX_VTS = OX_VTM + (size_t)4 * 4 * 64 * LT * 2;
constexpr size_t OX_END = OX_VTS + (size_t)4 * 2 * 64 * LT * 2;
constexpr size_t OX_LAST = OX_END + (size_t)4 * 16 * NCH * 64 * 8;
#define UPLD 4160
constexpr size_t OFF_END2 = cmax(OX_LAST, OFF_X + (size_t)MPAD * UPLD * 2);
constexpr size_t END_BYTES = (size_t)4 * 16 * NCH * 64 * 8;
constexpr size_t OFF_PART = OFF_END2 + 2 * END_BYTES;
constexpr size_t WS_TOTAL = OFF_PART + (size_t)8 * 64 * 1024 * 4;
static_assert(WS_TOTAL <= (size_t)256 * 1024 * 1024, "workspace too large");

struct Params {
  const float* x; const float* meta; const float* g_pre_mix; const float* g_post_mix; const float* g_pre_mlp;
  const float* g_post_mlp; const float* w_in; const float* w_out; const float* g_heads; const float* a_re;
  const float* a_im; const float* log_step; const float* b_re; const float* b_im; const float* c_re; const float* c_im;
  const float* d_skip; const float* w_glu; const float* b_glu; const float* sinks; const float* g_q; const float* g_kv;
  const float* w_uq; const float* w_uk; const float* w_uv; const float* w_up; const float* w_down;
  float* out; char* ws;
};

__device__ __forceinline__ unsigned pack2(float a, float b) {
  unsigned r;
  asm("v_cvt_pk_bf16_f32 %0, %1, %2" : "=v"(r) : "v"(a), "v"(b));
  return r;
}
__device__ __forceinline__ u16 f2bf(float f) { return (u16)(pack2(f, f) & 0xffffu); }
__device__ __forceinline__ float bf2f(u16 h) { return __uint_as_float(((unsigned)h) << 16); }
__device__ __forceinline__ float bflo(unsigned u) { return __uint_as_float(u << 16); }
__device__ __forceinline__ float bfhi(unsigned u) { return __uint_as_float(u & 0xffff0000u); }
__device__ __forceinline__ float wave_sum(float v) {
#pragma unroll
  for (int o = 32; o; o >>= 1) v += __shfl_xor(v, o);
  return v;
}
__device__ __forceinline__ float fexp2(float x) { return __builtin_amdgcn_exp2f(x); }
__device__ __forceinline__ int otid() { int t = threadIdx.x; asm volatile("" : "+v"(t)); return t; }

struct Mat { const float* src; u16* dst; int K, N; };
__device__ __forceinline__ Mat get_mat(const Params& p, int idx) {
  int l = idx >> 3, t = idx & 7;
  char* wb = p.ws + OFF_W + (size_t)l * W_LAYER;
  Mat m;
  if (t == 0) { m.src = p.w_in + (size_t)l * DM * INW; m.dst = (u16*)(wb + OW_IN); m.K = DM; m.N = INW; }
  else if (t == 1) { m.src = p.w_out + (size_t)l * DM * DM; m.dst = (u16*)(wb + OW_OUT); m.K = DM; m.N = DM; }
  else if (t == 2) { m.src = p.w_up + (size_t)l * DM * DFF; m.dst = (u16*)(wb + OW_UP); m.K = DM; m.N = DFF; }
  else if (t == 3) { m.src = p.w_down + (size_t)l * DFF * DM; m.dst = (u16*)(wb + OW_DN); m.K = DFF; m.N = DM; }
  else if (t == 4) { m.src = p.w_uq + (size_t)l * 192 * 384; m.dst = (u16*)(wb + OW_UQ); m.K = 192; m.N = 384; }
  else if (t == 5) { m.src = p.w_uk + (size_t)l * 128 * 256; m.dst = (u16*)(wb + OW_UKV); m.K = 128; m.N = 256; }
  else if (t == 6) { m.src = p.w_uv + (size_t)l * 128 * 256; m.dst = (u16*)(wb + OW_UKV) + 256 * 128; m.K = 128; m.N = 256; }
  else { m.src = p.w_glu + (size_t)l * 256 * 256; m.dst = (u16*)(wb + OW_GLU); m.K = 256; m.N = 256; }
  return m;
}

__device__ void phase_convert(const Params& p, char* lds) {
  float* tl = (float*)lds;
  const int tid = otid();
  int base = 0;
  for (int mi = 0; mi < 16; ++mi) {
    Mat mt = get_mat(p, mi);
    const int tn = mt.N >> 5, tk = mt.K >> 6, nt = tn * tk;
    int first = (int)(((long)blockIdx.x - base) % (long)gridDim.x);
    if (first < 0) first += gridDim.x;
    for (int i = first; i < nt; i += gridDim.x) {
      const int kt = i / tn, ntile = i - kt * tn;
      const int k0 = kt * 64, n0 = ntile * 32;
      {
        const int r = tid >> 3, c4 = (tid & 7) * 4;
#pragma unroll
        for (int j = 0; j < 2; ++j) {
          float4 v = *(const float4*)(mt.src + (size_t)(k0 + r + 32 * j) * mt.N + n0 + c4);
          float* d = tl + (r + 32 * j) * 33 + c4;
          d[0] = v.x; d[1] = v.y; d[2] = v.z; d[3] = v.w;
        }
      }
      __syncthreads();
      {
        const int n = tid >> 3, kc = (tid & 7) * 8;
        unsigned w[4];
#pragma unroll
        for (int e = 0; e < 4; ++e) w[e] = pack2(tl[(kc + 2 * e) * 33 + n], tl[(kc + 2 * e + 1) * 33 + n]);
        *(uint4*)(mt.dst + (size_t)(n0 + n) * mt.K + k0 + kc) = make_uint4(w[0], w[1], w[2], w[3]);
      }
      __syncthreads();
    }
    base += nt;
  }
}

__device__ void phase_tables(const Params& p) {
  const int gt = blockIdx.x * 256 + otid(), nthr = gridDim.x * 256;
  float2* rope = (float2*)(p.ws + OFF_ROPE);
  for (int i = gt; i < TPB * 16; i += nthr) {
    int t = i >> 4, f = i & 15;
    float inv = powf(10000.f, -(float)f / 16.f);
    float ang = (float)t * inv;
    double rev = (double)ang * 0.15915494309189535;
    rev -= rint(rev);
    float fr = (float)rev;
    rope[i] = make_float2(__builtin_amdgcn_cosf(fr), __builtin_amdgcn_sinf(fr));
  }
  float2* lam = (float2*)(p.ws + OFF_LAM);
  float2* lamT = (float2*)(p.ws + OFF_LAMT);
  float* bb = (float*)(p.ws + OFF_BB);
  for (int i = gt; i < 2 * 16 * 64; i += nthr) {
    int lg = i >> 6, s = i & 63;
    float step = expf(p.log_step[lg]);
    float ar = p.a_re[i], ai = p.a_im[i];
    float mag = expf(ar * step);
    float th = ai * step;
    float lr = mag * cosf(th), li = mag * sinf(th);
    lam[i] = make_float2(lr, li);
    float pr = lr, pi = li;
#pragma unroll
    for (int q = 0; q < 6; ++q) { float nr2 = pr * pr - pi * pi, ni2 = 2.f * pr * pi; pr = nr2; pi = ni2; }
    lamT[i] = make_float2(pr, pi);
    float den = ar * ar + ai * ai;
    float nr = lr - 1.f, ni = li;
    float cr = (nr * ar + ni * ai) / den, ci = (ni * ar - nr * ai) / den;
    const float* brp = p.b_re + (size_t)i * 16;
    const float* bip = p.b_im + (size_t)i * 16;
#pragma unroll
    for (int c = 0; c < 16; ++c) {
      float br = brp[c], bi = bip[c];
      bb[((size_t)lg * 32 + 2 * c) * 64 + s] = cr * br - ci * bi;
      bb[((size_t)lg * 32 + 2 * c + 1) * 64 + s] = cr * bi + ci * br;
    }
  }
}

__device__ __forceinline__ float* h_row(const Params& p, int m) {
  const int b = m / TPB, t = m - b * TPB;
  return t < 16 ? (float*)(p.ws + OFF_HMETA) + (size_t)(b * 16 + t) * DM : p.out + ((size_t)b * 4096 + (t - 16)) * DM;
}
template <int MODE>
__device__ void phase_rows(const Params& p, const float* gpost, const float* gnext, bool has_next, const float* part = nullptr) {
  const int tid_ = otid();
  const int lane = tid_ & 63;
  const int wg = blockIdx.x * 4 + (tid_ >> 6), nw = gridDim.x * 4;
  u16* abuf = (u16*)(p.ws + OFF_ABUF);
  const u16* obuf = (const u16*)(p.ws + OFF_OBUF);
  for (int mb = wg; mb < MTOK; mb += 2 * nw) {
    int mr[2]; bool ok[2]; float* hr[2];
    float4 v[2][4]; uint2 ob[2][4];
#pragma unroll
    for (int r = 0; r < 2; ++r) {
      mr[r] = mb + r * nw; ok[r] = mr[r] < MTOK;
      const int mm = ok[r] ? mr[r] : mb;
      hr[r] = h_row(p, mm);
      if (MODE == 0) {
        const int b = mm / TPB, t = mm - b * TPB;
        const float* src = t < 16 ? p.meta + (size_t)t * DM : p.x + ((size_t)b * 4096 + (t - 16)) * DM;
#pragma unroll
        for (int j = 0; j < 4; ++j) v[r][j] = *(const float4*)(src + j * 256 + lane * 4);
      } else {
        const float* hsrc = hr[r];
        if (MODE == 2) {
          const int b2 = mm / TPB, t2 = mm - b2 * TPB;
          hsrc = t2 < 16 ? p.meta + (size_t)t2 * DM : p.x + ((size_t)b2 * 4096 + (t2 - 16)) * DM;
        }
#pragma unroll
        for (int j = 0; j < 4; ++j) {
          ob[r][j] = *(const uint2*)(obuf + (size_t)mm * DM + j * 256 + lane * 4);
          v[r][j] = *(const float4*)(hsrc + j * 256 + lane * 4);
        }
        if (part != nullptr && mm >= 16384) {
#pragma unroll
          for (int j = 0; j < 4; ++j) {
            float4 a = make_float4(0.f, 0.f, 0.f, 0.f);
#pragma unroll
            for (int ks = 0; ks < 8; ++ks) {
              const float4 q = *(const float4*)(part + ((size_t)ks * 64 + (mm - 16384)) * 1024 + j * 256 + lane * 4);
              a.x += q.x; a.y += q.y; a.z += q.z; a.w += q.w;
            }
            ob[r][j].x = pack2(a.x, a.y); ob[r][j].y = pack2(a.z, a.w);
          }
        }
      }
    }
#pragma unroll
    for (int r = 0; r < 2; ++r) {
      if (MODE >= 1) {
        float4 o[4];
        float ss = 0.f;
#pragma unroll
        for (int j = 0; j < 4; ++j) {
          o[j] = make_float4(bflo(ob[r][j].x), bfhi(ob[r][j].x), bflo(ob[r][j].y), bfhi(ob[r][j].y));
          ss += o[j].x * o[j].x + o[j].y * o[j].y + o[j].z * o[j].z + o[j].w * o[j].w;
        }
        ss = wave_sum(ss);
        const float rs = rsqrtf(ss * (1.f / 1024.f) + 1e-6f);
#pragma unroll
        for (int j = 0; j < 4; ++j) {
          const float4 hv = v[r][j];
          const float4 g = *(const float4*)(gpost + j * 256 + lane * 4);
          v[r][j] = make_float4(hv.x + o[j].x * rs * g.x, hv.y + o[j].y * rs * g.y, hv.z + o[j].z * rs * g.z,
                                hv.w + o[j].w * rs * g.w);
        }
      }
      if (MODE != 0 && ok[r]) {
#pragma unroll
        for (int j = 0; j < 4; ++j) *(float4*)(hr[r] + j * 256 + lane * 4) = v[r][j];
      }
      if (has_next) {
        float ss = 0.f;
#pragma unroll
        for (int j = 0; j < 4; ++j)
          ss += v[r][j].x * v[r][j].x + v[r][j].y * v[r][j].y + v[r][j].z * v[r][j].z + v[r][j].w * v[r][j].w;
        ss = wave_sum(ss);
        const float rs = rsqrtf(ss * (1.f / 1024.f) + 1e-6f);
        if (ok[r]) {
#pragma unroll
          for (int j = 0; j < 4; ++j) {
            const float4 g = *(const float4*)(gnext + j * 256 + lane * 4);
            uint2 w;
            w.x = pack2(v[r][j].x * rs * g.x, v[r][j].y * rs * g.y);
            w.y = pack2(v[r][j].z * rs * g.z, v[r][j].w * rs * g.w);
            *(uint2*)(abuf + (size_t)mr[r] * DM + j * 256 + lane * 4) = w;
          }
        }
      }
    }
  }
}

__device__ void phase_headnorm(const Params& p, int l) {
  const int tid_ = otid();
  const int lane = tid_ & 63;
  const int wg = blockIdx.x * 4 + (tid_ >> 6), nw = gridDim.x * 4;
  u16* abuf = (u16*)(p.ws + OFF_ABUF);
  const u16* yssm = (const u16*)(p.ws + OX_YSSM);
  const u16* yswa = (const u16*)(p.ws + OX_YSWA);
  const u16* ymla = (const u16*)(p.ws + OX_YMLA);
  const float* gh = p.g_heads + (size_t)l * 1024;
  const float4 g1 = *(const float4*)(gh + lane * 4);
  const float4 g2a = *(const float4*)(gh + 256 + lane * 8);
  const float4 g2b = *(const float4*)(gh + 256 + lane * 8 + 4);
  const float4 g3 = *(const float4*)(gh + 768 + lane * 4);
  for (int mb = wg; mb < MTOK; mb += 2 * nw) {
    uint2 ar[2]; uint4 sr[2]; uint2 cr[2]; int mrow[2]; bool ok[2];
#pragma unroll
    for (int r = 0; r < 2; ++r) {
      mrow[r] = mb + r * nw; ok[r] = mrow[r] < MTOK;
      const int m = ok[r] ? mrow[r] : mb;
      ar[r] = *(const uint2*)(yssm + (size_t)m * 256 + lane * 4);
      sr[r] = *(const uint4*)(yswa + (size_t)m * 512 + lane * 8);
      cr[r] = *(const uint2*)(ymla + (size_t)m * 256 + lane * 4);
    }
#pragma unroll
    for (int r = 0; r < 2; ++r) {
      const uint2 a = ar[r]; const uint4 s = sr[r]; const uint2 c = cr[r];
      float av[4] = {bflo(a.x), bfhi(a.x), bflo(a.y), bfhi(a.y)};
      float sv[8] = {bflo(s.x), bfhi(s.x), bflo(s.y), bfhi(s.y), bflo(s.z), bfhi(s.z), bflo(s.w), bfhi(s.w)};
      float cv[4] = {bflo(c.x), bfhi(c.x), bflo(c.y), bfhi(c.y)};
      float s1 = 0.f, s2 = 0.f, s3 = 0.f;
#pragma unroll
      for (int e = 0; e < 4; ++e) { s1 += av[e] * av[e]; s3 += cv[e] * cv[e]; }
#pragma unroll
      for (int e = 0; e < 8; ++e) s2 += sv[e] * sv[e];
      s1 = wave_sum(s1); s2 = wave_sum(s2); s3 = wave_sum(s3);
      const float r1 = rsqrtf(s1 * (1.f / 256.f) + 1e-6f);
      const float r2 = rsqrtf(s2 * (1.f / 512.f) + 1e-6f);
      const float r3 = rsqrtf(s3 * (1.f / 256.f) + 1e-6f);
      if (ok[r]) {
        u16* dst = abuf + (size_t)mrow[r] * DM;
        uint2 w1; w1.x = pack2(av[0] * r1 * g1.x, av[1] * r1 * g1.y); w1.y = pack2(av[2] * r1 * g1.z, av[3] * r1 * g1.w);
        *(uint2*)(dst + lane * 4) = w1;
        uint4 w2;
        w2.x = pack2(sv[0] * r2 * g2a.x, sv[1] * r2 * g2a.y); w2.y = pack2(sv[2] * r2 * g2a.z, sv[3] * r2 * g2a.w);
        w2.z = pack2(sv[4] * r2 * g2b.x, sv[5] * r2 * g2b.y); w2.w = pack2(sv[6] * r2 * g2b.z, sv[7] * r2 * g2b.w);
        *(uint4*)(dst + 256 + lane * 8) = w2;
        uint2 w3; w3.x = pack2(cv[0] * r3 * g3.x, cv[1] * r3 * g3.y); w3.y = pack2(cv[2] * r3 * g3.z, cv[3] * r3 * g3.w);
        *(uint2*)(dst + 768 + lane * 4) = w3;
      }
    }
  }
}

__device__ void phase_mla_prep(const Params& p, int l) {
  const int tid_ = otid();
  const int lane = tid_ & 63;
  const int wg = blockIdx.x * 4 + (tid_ >> 6), nw = gridDim.x * 4;
  const u16* proj = (const u16*)(p.ws + OX_PROJ);
  u16* qn = (u16*)(p.ws + OX_QN);
  u16* cn = (u16*)(p.ws + OX_CN);
  u16* kr = (u16*)(p.ws + OX_KR);
  const float2* rope = (const float2*)(p.ws + OFF_ROPE);
  const float* gq = p.g_q + (size_t)l * 192;
  const float* gkv = p.g_kv + (size_t)l * 128;
  for (int m = wg; m < MTOK; m += nw) {
    const int b = m / TPB, t = m - b * TPB;
    const u16* pr = proj + (size_t)m * INW;
    float q0 = bf2f(pr[1024 + lane]), q1 = bf2f(pr[1024 + 64 + lane]), q2 = bf2f(pr[1024 + 128 + lane]);
    float c0 = bf2f(pr[1216 + lane]), c1 = bf2f(pr[1216 + 64 + lane]);
    float sq = wave_sum(q0 * q0 + q1 * q1 + q2 * q2);
    float sc = wave_sum(c0 * c0 + c1 * c1);
    const float rq = rsqrtf(sq * (1.f / 192.f) + 1e-6f);
    const float rc = rsqrtf(sc * (1.f / 128.f) + 1e-6f);
    qn[(size_t)m * 192 + lane] = f2bf(q0 * rq * gq[lane]);
    qn[(size_t)m * 192 + 64 + lane] = f2bf(q1 * rq * gq[64 + lane]);
    qn[(size_t)m * 192 + 128 + lane] = f2bf(q2 * rq * gq[128 + lane]);
    cn[(size_t)m * 128 + lane] = f2bf(c0 * rc * gkv[lane]);
    cn[(size_t)m * 128 + 64 + lane] = f2bf(c1 * rc * gkv[64 + lane]);
    if (lane < 16) {
      float x1 = bf2f(pr[1344 + lane]), x2 = bf2f(pr[1344 + 16 + lane]);
      float2 cs = rope[t * 16 + lane];
      kr[(size_t)m * 32 + lane] = f2bf(x1 * cs.x - x2 * cs.y);
      kr[(size_t)m * 32 + 16 + lane] = f2bf(x1 * cs.y + x2 * cs.x);
    }
  }
}

template <class Epi>
__device__ __forceinline__ void gemm_tile(const u16* __restrict__ A, int lda, int Mrows, const u16* __restrict__ Bt,
                                          int ldb, int Nrows, int K, int m0, int n0, char* lds, Epi& epi) {
  const int tid = otid(), lane = tid & 63, wid = tid >> 6, wm = wid >> 1, wn = wid & 1;
  const int lr = lane & 15, lg = lane >> 4;
  const int lrow = tid >> 3, lkc = tid & 7;
  const int wsw = (lrow >> 1) & 7;
  const u16* ap[4];
  const u16* bp[4];
#pragma unroll
  for (int j = 0; j < 4; ++j) {
    int ra = m0 + lrow + 32 * j; ra = ra < Mrows ? ra : Mrows - 1;
    int rb = n0 + lrow + 32 * j; rb = rb < Nrows ? rb : Nrows - 1;
    ap[j] = A + (size_t)ra * lda + lkc * 8;
    bp[j] = Bt + (size_t)rb * ldb + lkc * 8;
  }
  f32x4 acc[4][4];
#pragma unroll
  for (int i = 0; i < 4; ++i)
#pragma unroll
    for (int j = 0; j < 4; ++j) acc[i][j] = (f32x4){0.f, 0.f, 0.f, 0.f};
  typedef unsigned u32x4 __attribute__((ext_vector_type(4)));
  u32x4 a0[4], b0[4], a1[4], b1[4];
  const int nk = K >> 6;
  const int rsw = (lr >> 1) & 7;
  const int woff = lrow * 128 + ((lkc ^ wsw) << 4);
#define GEMM_ISSUE(SA, SB, KT)                                                                     \
  {                                                                                                \
    const int kn_ = ((KT) < nk) ? (KT) : nk - 1;                                                   \
    _Pragma("unroll") for (int j = 0; j < 4; ++j) {                                                \
      const u16* pa_ = ap[j] + kn_ * 64;                                                           \
      const u16* pb_ = bp[j] + kn_ * 64;                                                           \
      asm volatile("global_load_dwordx4 %0, %1, off" : "=&v"(SA[j]) : "v"(pa_) : "memory");        \
      asm volatile("global_load_dwordx4 %0, %1, off" : "=&v"(SB[j]) : "v"(pb_) : "memory");        \
    }                                                                                              \
  }
#define GEMM_WRITE(SA, SB, BUF)                                                                    \
  {                                                                                                \
    char* da_ = lds + (BUF) * 32768 + woff;                                                        \
    _Pragma("unroll") for (int j = 0; j < 4; ++j) {                                                \
      *(u32x4*)(da_ + j * 4096) = SA[j];                                                           \
      *(u32x4*)(da_ + 16384 + j * 4096) = SB[j];                                                   \
    }                                                                                              \
  }
#define GEMM_COMPUTE(BUF)                                                                          \
  {                                                                                                \
    const char* sa_ = lds + (BUF) * 32768 + (wm * 64 + lr) * 128;                                  \
    const char* sb_ = lds + (BUF) * 32768 + 16384 + (wn * 64 + lr) * 128;                          \
    _Pragma("unroll") for (int kk = 0; kk < 2; ++kk) {                                             \
      bf16x8 af[4], bfr[4];                                                                        \
      const int co = ((kk * 4 + lg) ^ rsw) << 4;                                                   \
      _Pragma("unroll") for (int i = 0; i < 4; ++i) af[i] = *(const bf16x8*)(sa_ + i * 2048 + co); \
      _Pragma("unroll") for (int j = 0; j < 4; ++j) bfr[j] = *(const bf16x8*)(sb_ + j * 2048 + co);\
      __builtin_amdgcn_s_setprio(1);                                                               \
      _Pragma("unroll") for (int i = 0; i < 4; ++i)                                                \
        _Pragma("unroll") for (int j = 0; j < 4; ++j)                                              \
          acc[i][j] = Epi::STAGED ? __builtin_amdgcn_mfma_f32_16x16x32_bf16(bfr[j], af[i], acc[i][j], 0, 0, 0) \
                                  : __builtin_amdgcn_mfma_f32_16x16x32_bf16(af[i], bfr[j], acc[i][j], 0, 0, 0); \
      __builtin_amdgcn_s_setprio(0);                                                               \
    }                                                                                              \
  }
  GEMM_ISSUE(a0, b0, 0)
  GEMM_ISSUE(a1, b1, 1)
  asm volatile("s_waitcnt vmcnt(8)" ::: "memory");
  GEMM_WRITE(a0, b0, 0)
  __syncthreads();
  for (int kt = 0; kt < nk; kt += 2) {
    GEMM_ISSUE(a0, b0, kt + 2)
    GEMM_COMPUTE(0)
    asm volatile("s_waitcnt vmcnt(8)" ::: "memory");
    GEMM_WRITE(a1, b1, 1)
    __syncthreads();
    if (kt + 1 < nk) {
      GEMM_ISSUE(a1, b1, kt + 3)
      GEMM_COMPUTE(1)
      asm volatile("s_waitcnt vmcnt(8)" ::: "memory");
      GEMM_WRITE(a0, b0, 0)
      __syncthreads();
    }
  }
  asm volatile("s_waitcnt vmcnt(0)" ::: "memory");
#pragma unroll
  for (int j = 0; j < 4; ++j) asm volatile("" :: "v"(a0[j]), "v"(b0[j]), "v"(a1[j]), "v"(b1[j]));
#undef GEMM_ISSUE
#undef GEMM_WRITE
#undef GEMM_COMPUTE
  if (Epi::ACT == 3) {
    if (wm == 0) {
#pragma unroll
      for (int i = 0; i < 4; ++i)
#pragma unroll
        for (int j = 0; j < 4; ++j)
          *(f32x4*)(epi.partp() + (size_t)(i * 16 + lr) * 1024 + n0 + wn * 64 + j * 16 + 4 * lg) = acc[i][j];
    }
  } else if (Epi::STAGED) {
#pragma unroll
    for (int i = 0; i < 4; ++i)
#pragma unroll
      for (int j = 0; j < 4; ++j) {
        f32x4 v = acc[i][j];
        if (Epi::ACT == 1) {
#pragma unroll
          for (int r = 0; r < 4; ++r) { float x = fmaxf(v[r], 0.f); v[r] = x * x; }
        }
        uint2 w; w.x = pack2(v[0], v[1]); w.y = pack2(v[2], v[3]);
        *(uint2*)(lds + (wm * 64 + i * 16 + lr) * 272 + (wn * 64 + j * 16 + 4 * lg) * 2) = w;
      }
    __syncthreads();
    if (!(Epi::HASVT && n0 == 896)) {
#pragma unroll
      for (int q = 0; q < 8; ++q) {
        const int c = tid + 256 * q;
        const int row = c >> 4, cc = c & 15;
        if (m0 + row < Mrows && n0 + cc * 8 < Nrows)
          *(uint4*)(epi.C + (size_t)(m0 + row) * epi.ldc + n0 + cc * 8) = *(const uint4*)(lds + row * 272 + cc * 16);
      }
    } else {
#pragma unroll
      for (int q = 0; q < 8; ++q) {
        const int id = tid + 256 * q;
        const int rg = id & 15, col = id >> 4;
        const int m = m0 + rg * 8;
        if (m < Mrows) {
          unsigned short e8[8];
#pragma unroll
          for (int e = 0; e < 8; ++e) e8[e] = *(const unsigned short*)(lds + (rg * 8 + e) * 272 + col * 2);
          const int bb = m / TPB, t = m - bb * TPB;
          uint4 val = make_uint4((unsigned)e8[0] | ((unsigned)e8[1] << 16), (unsigned)e8[2] | ((unsigned)e8[3] << 16),
                                 (unsigned)e8[4] | ((unsigned)e8[5] << 16), (unsigned)e8[6] | ((unsigned)e8[7] << 16));
          *(uint4*)(epi.vtp() + ((size_t)(bb * 2 + (col >> 6)) * 64 + (col & 63)) * LT + t) = val;
        }
      }
    }
    __syncthreads();
  } else {
#pragma unroll
    for (int i = 0; i < 4; ++i)
#pragma unroll
      for (int j = 0; j < 4; ++j)
        epi(m0 + wm * 64 + i * 16 + 4 * lg, n0 + wn * 64 + j * 16 + lr, acc[i][j]);
  }
}

template <class Epi>
__device__ __forceinline__ void gemm_phase(const u16* A, int lda, const u16* Bt, int ldb, int N, int K, char* lds,
                                           Epi epi, int rot, int tilesM = 129, int tileLo = 0, bool rev = false) {
  const int tilesN = (N + 127) >> 7;
  const int total = tilesM * tilesN;
  int start = (int)((blockIdx.x + gridDim.x - (rot % gridDim.x)) % gridDim.x) + tileLo * tilesN;
  for (int tile = start; tile < total; tile += gridDim.x) {
    int tm = tile / tilesN; const int tn = tile - tm * tilesN;
    if (rev) tm = 128 - tm;
    gemm_tile(A, lda, MTOK, Bt, ldb, N, K, tm * 128, tn * 128, lds, epi);
  }
}

struct EpiBf16 {
  static constexpr bool STAGED = true; static constexpr int ACT = 0; static constexpr bool HASVT = false;
  __device__ __forceinline__ u16* vtp() const { return nullptr; }
  __device__ __forceinline__ float* partp() const { return nullptr; }
  u16* C; int ldc; int N;
  __device__ __forceinline__ void operator()(int m, int n, f32x4 v) const {
    if (n < N) {
#pragma unroll
      for (int r = 0; r < 4; ++r) if (m + r < MTOK) C[(size_t)(m + r) * ldc + n] = f2bf(v[r]);
    }
  }
};
struct EpiPart {
  static constexpr bool STAGED = true; static constexpr int ACT = 3; static constexpr bool HASVT = false;
  float* part; u16* C; int ldc;
  __device__ __forceinline__ u16* vtp() const { return nullptr; }
  __device__ __forceinline__ float* partp() const { return part; }
  __device__ __forceinline__ void operator()(int, int, f32x4) const {}
};
struct EpiProjS {
  static constexpr bool STAGED = true; static constexpr int ACT = 0; static constexpr bool HASVT = true;
  u16* C; int ldc; u16* vts;
  __device__ __forceinline__ u16* vtp() const { return vts; }
  __device__ __forceinline__ float* partp() const { return nullptr; }
  __device__ __forceinline__ void operator()(int, int, f32x4) const {}
};
struct EpiRelu2 {
  static constexpr bool STAGED = true; static constexpr int ACT = 1; static constexpr bool HASVT = false;
  __device__ __forceinline__ u16* vtp() const { return nullptr; }
  __device__ __forceinline__ float* partp() const { return nullptr; }
  u16* C; int ldc;
  __device__ __forceinline__ void operator()(int m, int n, f32x4 v) const {
#pragma unroll
    for (int r = 0; r < 4; ++r) if (m + r < MTOK) { float x = fmaxf(v[r], 0.f); C[(size_t)(m + r) * ldc + n] = f2bf(x * x); }
  }
};
struct EpiProj {
  static constexpr bool HASVT = false;
  __device__ __forceinline__ u16* vtp() const { return nullptr; }
  __device__ __forceinline__ float* partp() const { return nullptr; }
  static constexpr bool STAGED = false; static constexpr int ACT = 0;
  u16* C; int ldc;
  u16* proj; u16* vts;
  __device__ __forceinline__ void operator()(int m, int n, f32x4 v) const {
    if (n < INW && m < MTOK) {
#pragma unroll
      for (int r = 0; r < 4; ++r) proj[(size_t)(m + r) * INW + n] = f2bf(v[r]);
      if (n >= 896 && n < 1024) {
        const int kvh = (n - 896) >> 6, d = (n - 896) & 63;
        const int b = m / TPB, t = m - b * TPB;
        uint2 w; w.x = pack2(v[0], v[1]); w.y = pack2(v[2], v[3]);
        *(uint2*)(vts + ((size_t)(b * 2 + kvh) * 64 + d) * LT + t) = w;
      }
    }
  }
};
struct EpiKV {
  static constexpr bool HASVT = false;
  __device__ __forceinline__ u16* vtp() const { return nullptr; }
  __device__ __forceinline__ float* partp() const { return nullptr; }
  static constexpr bool STAGED = false; static constexpr int ACT = 0;
  u16* C; int ldc;
  u16* kn; u16* vtm;
  __device__ __forceinline__ void operator()(int m, int n, f32x4 v) const {
    if (m < MTOK) {
      if (n < 256) {
#pragma unroll
        for (int r = 0; r < 4; ++r) kn[(size_t)(m + r) * 256 + n] = f2bf(v[r]);
      } else {
        const int h = (n - 256) >> 6, d = (n - 256) & 63;
        const int b = m / TPB, t = m - b * TPB;
        uint2 w; w.x = pack2(v[0], v[1]); w.y = pack2(v[2], v[3]);
        *(uint2*)(vtm + ((size_t)(b * 4 + h) * 64 + d) * LT + t) = w;
      }
    }
  }
};
struct EpiGlu {
  static constexpr bool HASVT = false;
  __device__ __forceinline__ u16* vtp() const { return nullptr; }
  __device__ __forceinline__ float* partp() const { return nullptr; }
  static constexpr bool STAGED = false; static constexpr int ACT = 0;
  u16* C; int ldc;
  const u16* z; const float* bg; u16* y;
  __device__ __forceinline__ void operator()(int m, int n, f32x4 v) const {
    const float bb = bg[n];
#pragma unroll
    for (int r = 0; r < 4; ++r)
      if (m + r < MTOK) {
        float zz = bf2f(z[(size_t)(m + r) * 256 + n]);
        float s = 1.f / (1.f + __expf(-(v[r] + bb)));
        y[(size_t)(m + r) * 256 + n] = f2bf(zz * s);
      }
  }
};

__device__ __forceinline__ void ssm_load_u(const u16* proj, int b, int g, int ch, int lane, float* urow) {
  const int t = ch * 64 + lane;
  uint4 r0 = make_uint4(0, 0, 0, 0), r1 = make_uint4(0, 0, 0, 0);
  if (t < TPB) {
    const uint4* src = (const uint4*)(proj + (size_t)(b * TPB + t) * INW + g * 16);
    r0 = src[0]; r1 = src[1];
  }
  float4* d = (float4*)urow;
  d[0] = make_float4(bflo(r0.x), bfhi(r0.x), bflo(r0.y), bfhi(r0.y));
  d[1] = make_float4(bflo(r0.z), bfhi(r0.z), bflo(r0.w), bfhi(r0.w));
  d[2] = make_float4(bflo(r1.x), bfhi(r1.x), bflo(r1.y), bfhi(r1.y));
  d[3] = make_float4(bflo(r1.z), bfhi(r1.z), bflo(r1.w), bfhi(r1.w));
}

#define SSM_STEP(UP)                                                                          \
  {                                                                                           \
    const float4 u0 = (UP)[0], u1 = (UP)[1], u2 = (UP)[2], u3 = (UP)[3];                      \
    float sr = u0.x * br[0], si = u0.x * bi[0];                                               \
    sr += u0.y * br[1]; si += u0.y * bi[1]; sr += u0.z * br[2]; si += u0.z * bi[2];           \
    sr += u0.w * br[3]; si += u0.w * bi[3]; sr += u1.x * br[4]; si += u1.x * bi[4];           \
    sr += u1.y * br[5]; si += u1.y * bi[5]; sr += u1.z * br[6]; si += u1.z * bi[6];           \
    sr += u1.w * br[7]; si += u1.w * bi[7]; sr += u2.x * br[8]; si += u2.x * bi[8];           \
    sr += u2.y * br[9]; si += u2.y * bi[9]; sr += u2.z * br[10]; si += u2.z * bi[10];         \
    sr += u2.w * br[11]; si += u2.w * bi[11]; sr += u3.x * br[12]; si += u3.x * bi[12];       \
    sr += u3.y * br[13]; si += u3.y * bi[13]; sr += u3.z * br[14]; si += u3.z * bi[14];       \
    sr += u3.w * br[15]; si += u3.w * bi[15];                                                 \
    const float nxr = lam.x * xr - lam.y * xi + sr;                                           \
    const float nxi = lam.x * xi + lam.y * xr + si;                                           \
    xr = nxr; xi = nxi;                                                                       \
  }

__device__ void phase_ssm_a(const Params& p, int l, char* lds) {
  const u16* proj = (const u16*)(p.ws + OX_PROJ);
  float* us = (float*)lds;
  const int tid_ = otid();
  const int lane = tid_ & 63, w = tid_ >> 6;
  const float* bbt = (const float*)(p.ws + OFF_BB);
  const float2* lamt = (const float2*)(p.ws + OFF_LAM);
  float2* endp = (float2*)(p.ws + OFF_END2 + (size_t)l * END_BYTES);
  for (int item = blockIdx.x; item < 64 * 16; item += gridDim.x) {
    const int bg = item >> 4, cq = item & 15;
    const int b = bg >> 4, g = bg & 15;
    const int ch = cq * 4 + w;
    if (ch < 63) {
      ssm_load_u(proj, b, g, ch, lane, us + (w * 64 + lane) * 16);
      asm volatile("s_waitcnt lgkmcnt(0)" ::: "memory");
      float br[16], bi[16];
      const float* bbp = bbt + ((size_t)(l * 16 + g) * 32) * 64 + lane;
#pragma unroll
      for (int c = 0; c < 16; ++c) { br[c] = bbp[(2 * c) * 64]; bi[c] = bbp[(2 * c + 1) * 64]; }
      const float2 lam = lamt[(l * 16 + g) * 64 + lane];
      float xr = 0.f, xi = 0.f;
      for (int tt = 0; tt < 64; ++tt) {
        const float4* up = (const float4*)(us + (w * 64 + tt) * 16);
        SSM_STEP(up)
      }
      endp[((size_t)(b * 16 + g) * NCH + ch) * 64 + lane] = make_float2(xr, xi);
    }
  }
}

__device__ __forceinline__ float gelu_tanh(float y) {
  const float a = 0.7978845608028654f * (y + 0.044715f * y * y * y);
  const float th = 1.f - 2.f / (1.f + __expf(2.f * a));
  return 0.5f * y * (1.f + th);
}

__device__ void phase_ssm_c(const Params& p, int l, char* lds) {
  const u16* proj = (const u16*)(p.ws + OX_PROJ);
  u16* z = (u16*)(p.ws + OX_Z);
  float* Cs = (float*)lds;
  float* us = Cs + 2048;
  float* xs = us + 4096;
  const int tid = otid(), lane = tid & 63, w = tid >> 6;
  const float* bbt = (const float*)(p.ws + OFF_BB);
  const float2* lamt = (const float2*)(p.ws + OFF_LAM);
  const float2* lamTt = (const float2*)(p.ws + OFF_LAMT);
  const float2* endp = (const float2*)(p.ws + OFF_END2 + (size_t)l * END_BYTES);
  for (int item = blockIdx.x; item < 64 * 16; item += gridDim.x) {
    const int bg = item >> 4, cq = item & 15;
    const int b = bg >> 4, g = bg & 15;
    {
      const float* cre = p.c_re + (size_t)(l * 16 + g) * 1024;
      const float* cim = p.c_im + (size_t)(l * 16 + g) * 1024;
#pragma unroll
      for (int j = 0; j < 4; ++j) {
        int idx = tid + 256 * j;
        *(float2*)(Cs + idx * 2) = make_float2(cre[idx], cim[idx]);
      }
    }
    const int ch = cq * 4 + w;
    const int nsub = (cq == 15) ? 5 : 4;
    {
      ssm_load_u(proj, b, g, ch, lane, us + (w * 64 + lane) * 16);
      float br[16], bi[16];
      const float* bbp = bbt + ((size_t)(l * 16 + g) * 32) * 64 + lane;
#pragma unroll
      for (int c = 0; c < 16; ++c) { br[c] = bbp[(2 * c) * 64]; bi[c] = bbp[(2 * c + 1) * 64]; }
      const float2 lam = lamt[(l * 16 + g) * 64 + lane];
      const float2 lamT = lamTt[(l * 16 + g) * 64 + lane];
      __syncthreads();
      float xr = 0.f, xi = 0.f;
      const float2* ep = endp + ((size_t)(b * 16 + g) * NCH) * 64 + lane;
      {
        int j = 0;
        for (; j + 16 <= ch; j += 16) {
          float2 e[16];
#pragma unroll
          for (int q = 0; q < 16; ++q) e[q] = ep[(size_t)(j + q) * 64];
#pragma unroll
          for (int q = 0; q < 16; ++q) {
            const float nxr = lamT.x * xr - lamT.y * xi + e[q].x;
            const float nxi = lamT.x * xi + lamT.y * xr + e[q].y;
            xr = nxr; xi = nxi;
          }
        }
        for (; j < ch; ++j) {
          const float2 e = ep[(size_t)j * 64];
          const float nxr = lamT.x * xr - lamT.y * xi + e.x;
          const float nxi = lamT.x * xi + lamT.y * xr + e.y;
          xr = nxr; xi = nxi;
        }
      }
      const int tl = lane & 15, c4 = lane >> 4;
      const float4 dsk = *(const float4*)(p.d_skip + (size_t)l * 256 + g * 16 + c4 * 4);
      for (int sub = 0; sub < nsub; ++sub) {
        const int rbase = (sub & 3) * 16;
        if (sub == 4) {
          uint4 r0 = make_uint4(0, 0, 0, 0), r1 = make_uint4(0, 0, 0, 0);
          const int t2 = 4096 + lane;
          if (ch == 63 && lane < 16) {
            const uint4* s4 = (const uint4*)(proj + (size_t)(b * TPB + t2) * INW + g * 16);
            r0 = s4[0]; r1 = s4[1];
          }
          if (lane < 16) {
            float4* d = (float4*)(us + (w * 64 + lane) * 16);
            d[0] = make_float4(bflo(r0.x), bfhi(r0.x), bflo(r0.y), bfhi(r0.y));
            d[1] = make_float4(bflo(r0.z), bfhi(r0.z), bflo(r0.w), bfhi(r0.w));
            d[2] = make_float4(bflo(r1.x), bfhi(r1.x), bflo(r1.y), bfhi(r1.y));
            d[3] = make_float4(bflo(r1.z), bfhi(r1.z), bflo(r1.w), bfhi(r1.w));
          }
          __syncthreads();
        }
        for (int tt = 0; tt < 16; ++tt) {
          const float4* up = (const float4*)(us + (w * 64 + rbase + tt) * 16);
          SSM_STEP(up)
          *(float2*)(xs + (w * 16 + tt) * 132 + 2 * lane) = make_float2(xr, xi);
        }
        __syncthreads();
        const float* xrow = xs + (w * 16 + tl) * 132;
        const float* crow = Cs + (c4 * 4) * 128;
        float a0 = 0.f, a1 = 0.f, a2 = 0.f, a3 = 0.f;
#pragma unroll 4
        for (int pp = 0; pp < 32; ++pp) {
          const float4 xv = *(const float4*)(xrow + 4 * pp);
          const float4 c0 = *(const float4*)(crow + 4 * pp);
          const float4 c1 = *(const float4*)(crow + 128 + 4 * pp);
          const float4 c2 = *(const float4*)(crow + 256 + 4 * pp);
          const float4 c3 = *(const float4*)(crow + 384 + 4 * pp);
          a0 += c0.x * xv.x - c0.y * xv.y + c0.z * xv.z - c0.w * xv.w;
          a1 += c1.x * xv.x - c1.y * xv.y + c1.z * xv.z - c1.w * xv.w;
          a2 += c2.x * xv.x - c2.y * xv.y + c2.z * xv.z - c2.w * xv.w;
          a3 += c3.x * xv.x - c3.y * xv.y + c3.z * xv.z - c3.w * xv.w;
        }
        __syncthreads();
        const int tok = ch * 64 + sub * 16 + tl;
        const float4 uv = *(const float4*)(us + (w * 64 + rbase + tl) * 16 + c4 * 4);
        if ((sub < 4 || ch == 63) && tok < TPB) {
          uint2 wv;
          wv.x = pack2(gelu_tanh(a0 + dsk.x * uv.x), gelu_tanh(a1 + dsk.y * uv.y));
          wv.y = pack2(gelu_tanh(a2 + dsk.z * uv.z), gelu_tanh(a3 + dsk.w * uv.w));
          *(uint2*)(z + (size_t)(b * TPB + tok) * 256 + g * 16 + c4 * 4) = wv;
        }
      }
    }
    __syncthreads();
  }
}

template <bool MLA, int NQS>
__device__ void attn_item(const Params& p, int l, int b, int head, int qt, char* lds) {
  constexpr int NDS = MLA ? 3 : 2;
  const int tid = otid(), lane = tid & 63, w = tid >> 6;
  const int lr = lane & 15, lg = lane >> 4;
  const u16* proj = (const u16*)(p.ws + OX_PROJ);
  const u16* krope = (const u16*)(p.ws + OX_KR);
  const u16* Ksrc; int kld; const u16* Vt; u16* Y; int ldy;
  if (MLA) {
    Ksrc = (const u16*)(p.ws + OX_KN) + head * 64; kld = 256;
    Vt = (const u16*)(p.ws + OX_VTM) + (size_t)(b * 4 + head) * 64 * LT;
    Y = (u16*)(p.ws + OX_YMLA); ldy = 256;
  } else {
    const int kvh = head >> 2;
    Ksrc = proj + 768 + kvh * 64; kld = INW;
    Vt = (const u16*)(p.ws + OX_VTS) + (size_t)(b * 2 + kvh) * 64 * LT;
    Y = (u16*)(p.ws + OX_YSWA); ldy = 512;
  }
  const int q0 = qt * (64 * NQS);
  const int kt_hi = ((q0 + 64 * NQS - 1) >> 6) < 64 ? ((q0 + 64 * NQS - 1) >> 6) : 64;
  const int kt_lo = MLA ? 0 : (((q0 >> 6) - 2) > 0 ? ((q0 >> 6) - 2) : 0);
  const float LOG2E = 1.4426950408889634f;
  const float c1 = (MLA ? 0.10206207261596575f : 0.125f) * LOG2E;
  float sl2 = 0.f, sink2 = 0.f;
  if (!MLA) {
    sl2 = exp2f(-(float)(head + 1)) * LOG2E;
    sink2 = p.sinks[l * 8 + head] * LOG2E;
  }
  bf16x8 qf[NQS][NDS];
#pragma unroll
  for (int qs = 0; qs < NQS; ++qs) {
    int tq = q0 + 16 * NQS * w + 16 * qs + lr; tq = tq < TPB ? tq : TPB - 1;
    const size_t m = (size_t)b * TPB + tq;
    if (!MLA) {
      const u16* qp = proj + m * INW + 256 + head * 64;
      qf[qs][0] = *(const bf16x8*)(qp + lg * 8);
      qf[qs][1] = *(const bf16x8*)(qp + 32 + lg * 8);
    } else {
      const u16* qp = (const u16*)(p.ws + OX_QMLA) + m * 384 + head * 96;
      qf[qs][0] = *(const bf16x8*)(qp + lg * 8);
      qf[qs][1] = *(const bf16x8*)(qp + 32 + lg * 8);
      const uint4 own = *(const uint4*)(qp + 64 + lg * 8);
      const uint4 par = *(const uint4*)(qp + 64 + (lg ^ 2) * 8);
      const float2* cs = (const float2*)(p.ws + OFF_ROPE) + tq * 16 + (lg & 1) * 8;
      const unsigned ow[4] = {own.x, own.y, own.z, own.w};
      const unsigned pw[4] = {par.x, par.y, par.z, par.w};
      unsigned rw[4];
#pragma unroll
      for (int e2 = 0; e2 < 4; ++e2) {
        const float2 csa = cs[2 * e2], csb = cs[2 * e2 + 1];
        const float oa = bflo(ow[e2]), ob = bfhi(ow[e2]), pa = bflo(pw[e2]), pb = bfhi(pw[e2]);
        float ra, rb;
        if (lg < 2) { ra = oa * csa.x - pa * csa.y; rb = ob * csb.x - pb * csb.y; }
        else { ra = pa * csa.y + oa * csa.x; rb = pb * csb.y + ob * csb.x; }
        rw[e2] = pack2(ra, rb);
      }
      uint4 r4 = make_uint4(rw[0], rw[1], rw[2], rw[3]);
      qf[qs][NDS - 1] = *(bf16x8*)&r4;
    }
  }
  float mrow[NQS], lrow[NQS];
  f32x4 o[NQS][4];
#pragma unroll
  for (int qs = 0; qs < NQS; ++qs) {
    mrow[qs] = MLA ? -1e30f : sink2; lrow[qs] = 0.f;
#pragma unroll
    for (int jt = 0; jt < 4; ++jt) o[qs][jt] = (f32x4){0.f, 0.f, 0.f, 0.f};
  }
  typedef unsigned au32x4 __attribute__((ext_vector_type(4)));
  au32x4 rak0, rak1, rav0, rav1, rakr, rbk0, rbk1, rbv0, rbv1, rbkr;
  rakr = (au32x4){0u, 0u, 0u, 0u}; rbkr = rakr;
  const int skey = tid >> 3, skc = tid & 7;
  const int rkey = tid >> 2, rkc = tid & 3;
  const u16* kptr = Ksrc + ((size_t)b * TPB + skey) * kld + skc * 8;
  const u16* vptr = Vt + (size_t)skey * LT + skc * 8;
  const u16* krptr = krope + ((size_t)b * TPB + rkey) * 32 + rkc * 8;
  const int kw_off = skey * 128 + ((skc ^ (((skey >> 1) & 1) | (((skey >> 3) & 3) << 1))) << 4);
  const int vw_off = skey * 128 + ((skc ^ ((skey >> 1) & 7)) << 4);
  const int krx = (rkey >> 3) & 3;
  const int krw_off = rkey * 64 + ((rkc ^ (krx ^ ((krx & 1) << 1))) << 4);
#define ATT_GLD16(dst, ptr) asm volatile("global_load_dwordx4 %0, %1, off" : "=&v"(dst) : "v"(ptr) : "memory")
#define ATT_GLOAD(S, KT)                                                     \
  {                                                                          \
    const int k0_ = (KT) * 64;                                               \
    const u16* p0_ = kptr + (size_t)k0_ * kld;                               \
    const u16* p1_ = kptr + (size_t)(k0_ + 32) * kld;                        \
    const u16* p2_ = vptr + k0_;                                             \
    const u16* p3_ = vptr + (size_t)32 * LT + k0_;                           \
    ATT_GLD16(S##k0, p0_); ATT_GLD16(S##k1, p1_); ATT_GLD16(S##v0, p2_); ATT_GLD16(S##v1, p3_); \
    if (MLA) { const u16* p4_ = krptr + (size_t)k0_ * 32; ATT_GLD16(S##kr, p4_); }              \
  }
#define ATT_SWRITE(S, BUF)                                                   \
  {                                                                          \
    char* Kb_ = lds + (BUF) * 20480;                                         \
    *(au32x4*)(Kb_ + kw_off) = S##k0;                                        \
    *(au32x4*)(Kb_ + kw_off + 32 * 128) = S##k1;                             \
    *(au32x4*)(Kb_ + 8192 + vw_off) = S##v0;                                 \
    *(au32x4*)(Kb_ + 8192 + vw_off + 32 * 128) = S##v1;                      \
    if (MLA) *(au32x4*)(Kb_ + 16384 + krw_off) = S##kr;                      \
  }
#define ATT_WAIT_OLDER() { if (MLA) asm volatile("s_waitcnt vmcnt(5)" ::: "memory"); else asm volatile("s_waitcnt vmcnt(4)" ::: "memory"); }
#define ATT_STEP(KT_, BUF_)  \
  {  \
    const char* Kb = lds + (BUF_) * 20480; const char* Vb = Kb + 8192; const char* Krb = Kb + 16384;  \
    f32x4 s[NQS][2][2];  \
    _Pragma("unroll")  \
    for (int kk = 0; kk < 2; ++kk)  \
    _Pragma("unroll")  \
      for (int j = 0; j < 2; ++j) {  \
        const int keyl = 32 * kk + 8 * (lr >> 2) + 4 * j + (lr & 3);  \
        f32x4 s0 = (f32x4){0.f, 0.f, 0.f, 0.f}, s1 = (f32x4){0.f, 0.f, 0.f, 0.f};  \
    _Pragma("unroll")  \
        for (int ds = 0; ds < 2; ++ds) {  \
          const bf16x8 kf = *(const bf16x8*)(Kb + keyl * 128 + (((ds * 4 + lg) ^ fsw) << 4));  \
          s0 = __builtin_amdgcn_mfma_f32_16x16x32_bf16(kf, qf[0][ds], s0, 0, 0, 0);  \
          if (NQS > 1) s1 = __builtin_amdgcn_mfma_f32_16x16x32_bf16(kf, qf[NQS - 1][ds], s1, 0, 0, 0);  \
        }  \
        if (MLA) {  \
          const bf16x8 kf = *(const bf16x8*)(Krb + keyl * 64 + ((lg ^ xh) << 4));  \
          s0 = __builtin_amdgcn_mfma_f32_16x16x32_bf16(kf, qf[0][NDS - 1], s0, 0, 0, 0);  \
          if (NQS > 1) s1 = __builtin_amdgcn_mfma_f32_16x16x32_bf16(kf, qf[NQS - 1][NDS - 1], s1, 0, 0, 0);  \
        }  \
        s[0][kk][j] = s0; if (NQS > 1) s[NQS - 1][kk][j] = s1;  \
      }  \
    bf16x8 pf[NQS][2];  \
    _Pragma("unroll")  \
    for (int qs = 0; qs < NQS; ++qs) {  \
      const int tq = q0 + 16 * NQS * w + 16 * qs + lr;  \
      float mx = -INFINITY;  \
      float mnew, alpha, ps = 0.f;  \
      if (MLA) {  \
        if ((KT_) * 64 + 63 > q0) {  \
    _Pragma("unroll")  \
          for (int kk = 0; kk < 2; ++kk)  \
    _Pragma("unroll")  \
            for (int j = 0; j < 2; ++j)  \
    _Pragma("unroll")  \
              for (int i = 0; i < 4; ++i) {  \
                const int key = (KT_) * 64 + 32 * kk + 8 * lg + 4 * j + i;  \
                s[qs][kk][j][i] = (key <= tq) ? s[qs][kk][j][i] : -INFINITY;  \
              }  \
        }  \
    _Pragma("unroll")  \
        for (int kk = 0; kk < 2; ++kk)  \
    _Pragma("unroll")  \
          for (int j = 0; j < 2; ++j)  \
    _Pragma("unroll")  \
            for (int i = 0; i < 4; ++i) mx = fmaxf(mx, s[qs][kk][j][i]);  \
        mx = fmaxf(mx, __shfl_xor(mx, 16));  \
        mx = fmaxf(mx, __shfl_xor(mx, 32));  \
        mnew = fmaxf(mrow[qs], mx * c1);  \
        alpha = fexp2(mrow[qs] - mnew);  \
        mrow[qs] = mnew;  \
    _Pragma("unroll")  \
        for (int kk = 0; kk < 2; ++kk) {  \
          float pv[8];  \
    _Pragma("unroll")  \
          for (int j = 0; j < 2; ++j)  \
    _Pragma("unroll")  \
            for (int i = 0; i < 4; ++i) {  \
              const float e = fexp2(__builtin_fmaf(s[qs][kk][j][i], c1, -mnew));  \
              pv[j * 4 + i] = e; ps += e;  \
            }  \
          uint4 r4 = make_uint4(pack2(pv[0], pv[1]), pack2(pv[2], pv[3]), pack2(pv[4], pv[5]), pack2(pv[6], pv[7]));  \
          pf[qs][kk] = *(bf16x8*)&r4;  \
        }  \
      } else {  \
    _Pragma("unroll")  \
        for (int kk = 0; kk < 2; ++kk)  \
    _Pragma("unroll")  \
          for (int j = 0; j < 2; ++j)  \
    _Pragma("unroll")  \
            for (int i = 0; i < 4; ++i) {  \
              const int key = (KT_) * 64 + 32 * kk + 8 * lg + 4 * j + i;  \
              float v = s[qs][kk][j][i] * c1 - sl2 * (float)(tq - key);  \
              const bool ok = (key <= tq) && (key > tq - 128);  \
              v = ok ? v : -INFINITY;  \
              s[qs][kk][j][i] = v;  \
              mx = fmaxf(mx, v);  \
            }  \
        mx = fmaxf(mx, __shfl_xor(mx, 16));  \
        mx = fmaxf(mx, __shfl_xor(mx, 32));  \
        mnew = fmaxf(mrow[qs], mx);  \
        alpha = fexp2(mrow[qs] - mnew);  \
        mrow[qs] = mnew;  \
    _Pragma("unroll")  \
        for (int kk = 0; kk < 2; ++kk) {  \
          float pv[8];  \
    _Pragma("unroll")  \
          for (int j = 0; j < 2; ++j)  \
    _Pragma("unroll")  \
            for (int i = 0; i < 4; ++i) {  \
              const float e = fexp2(s[qs][kk][j][i] - mnew);  \
              pv[j * 4 + i] = e; ps += e;  \
            }  \
          uint4 r4 = make_uint4(pack2(pv[0], pv[1]), pack2(pv[2], pv[3]), pack2(pv[4], pv[5]), pack2(pv[6], pv[7]));  \
          pf[qs][kk] = *(bf16x8*)&r4;  \
        }  \
      }  \
      lrow[qs] = lrow[qs] * alpha + ps;  \
    _Pragma("unroll")  \
      for (int jt = 0; jt < 4; ++jt) o[qs][jt] *= alpha;  \
    }  \
    _Pragma("unroll")  \
    for (int jt = 0; jt < 4; ++jt)  \
    _Pragma("unroll")  \
      for (int kk = 0; kk < 2; ++kk) {  \
        const bf16x8 vf = *(const bf16x8*)(Vb + (16 * jt + lr) * 128 + (((4 * kk + lg) ^ vsw) << 4));  \
        o[0][jt] = __builtin_amdgcn_mfma_f32_16x16x32_bf16(vf, pf[0][kk], o[0][jt], 0, 0, 0);  \
        if (NQS > 1) o[NQS - 1][jt] = __builtin_amdgcn_mfma_f32_16x16x32_bf16(vf, pf[NQS - 1][kk], o[NQS - 1][jt], 0, 0, 0);  \
      }  \
  }
  const int fsw = ((lr >> 1) & 1) | ((lr >> 2) << 1);
  const int xh = (lr >> 2) ^ (((lr >> 2) & 1) << 1);
  const int vsw = (lr >> 1) & 7;
  ATT_GLOAD(ra, kt_lo)
  ATT_GLOAD(rb, (kt_lo + 1 <= kt_hi ? kt_lo + 1 : kt_hi))
  ATT_WAIT_OLDER()
  ATT_SWRITE(ra, 0)
  __syncthreads();
  for (int kt = kt_lo; kt <= kt_hi; kt += 2) {
    ATT_GLOAD(ra, (kt + 2 <= kt_hi ? kt + 2 : kt_hi))
    ATT_STEP(kt, 0)
    ATT_WAIT_OLDER()
    ATT_SWRITE(rb, 1)
    __syncthreads();
    if (kt + 1 <= kt_hi) {
      ATT_GLOAD(rb, (kt + 3 <= kt_hi ? kt + 3 : kt_hi))
      ATT_STEP(kt + 1, 1)
      ATT_WAIT_OLDER()
      ATT_SWRITE(ra, 0)
      __syncthreads();
    }
  }
  asm volatile("s_waitcnt vmcnt(0)" ::: "memory");
  asm volatile("" :: "v"(rak0), "v"(rak1), "v"(rav0), "v"(rav1), "v"(rakr), "v"(rbk0), "v"(rbk1), "v"(rbv0), "v"(rbv1), "v"(rbkr));
#pragma unroll
  for (int qs = 0; qs < NQS; ++qs) {
    const int tq = q0 + 16 * NQS * w + 16 * qs + lr;
    float lsum = lrow[qs];
    lsum += __shfl_xor(lsum, 16);
    lsum += __shfl_xor(lsum, 32);
    if (!MLA) lsum += fexp2(sink2 - mrow[qs]);
    const float inv = 1.f / lsum;
    if (tq < TPB) {
      u16* yp = Y + ((size_t)b * TPB + tq) * ldy + head * 64 + 4 * lg;
#pragma unroll
      for (int jt = 0; jt < 4; ++jt) {
        uint2 wv;
        wv.x = pack2(o[qs][jt][0] * inv, o[qs][jt][1] * inv);
        wv.y = pack2(o[qs][jt][2] * inv, o[qs][jt][3] * inv);
        *(uint2*)(yp + 16 * jt) = wv;
      }
    }
  }
}


#define UP_EXP OFF_X
#define UP_TILES 16
#define P9_LO 0
#define P9_HI 129
#ifndef STOP_AFTER
#define STOP_AFTER 0
#endif
__device__ void dump_bf16(const Params& p, const u16* buf, int ld, int coloff, int shift = 0) {
  const int tid_ = otid();
  const int lane = tid_ & 63;
  const int wg = (int)((blockIdx.x + shift) % gridDim.x) * 4 + (tid_ >> 6), nw = gridDim.x * 4;
  for (int m = wg; m < MTOK; m += nw) {
    const int b = m / TPB, t = m - b * TPB;
    if (t < 16) continue;
    float* o = p.out + ((size_t)b * 4096 + (t - 16)) * DM;
    for (int j = 0; j < 16; ++j) o[j * 64 + lane] = bf2f(buf[(size_t)m * ld + coloff + j * 64 + lane]);
  }
}
#define XB_TMO      128
#define XB_XCNT(j)  (256  + 64 * (j))
#define XB_XSUB(j)  (1280 + 64 * (j))
#define XB_XGEN(j)  (2304 + 64 * (j))
#define XB_TOP      3328
#define XB_TOPGEN   3392
#define XCD_BAR_WORDS 3456
#define XB_SPIN_CAP (1u << 22)
#define LAS __attribute__((address_space(3)))
__device__ __forceinline__ unsigned xb_ld(unsigned* p) { return __hip_atomic_load(p, __ATOMIC_RELAXED, __HIP_MEMORY_SCOPE_AGENT); }
__device__ __forceinline__ unsigned xb_add(unsigned* p, unsigned v) { return __hip_atomic_fetch_add(p, v, __ATOMIC_RELAXED, __HIP_MEMORY_SCOPE_AGENT); }
__device__ __forceinline__ unsigned xb_xcc_id() { return (unsigned)__builtin_amdgcn_s_getreg((3 << 11) | 20) & 0xFu; }
#define XB_SPIN(cond, bar) do { unsigned _sp = 0; while (cond) { __builtin_amdgcn_s_sleep(1); \
    if ((++_sp & 255u) == 0u) { if (xb_ld(&(bar)[XB_TMO])) break; if (_sp > XB_SPIN_CAP) { atomicAdd(&(bar)[XB_TMO], 1u); break; } } } } while (0)
struct XcdBarrier { unsigned* bar; unsigned x; volatile unsigned* st; };
__device__ __forceinline__ XcdBarrier xcd_barrier_post(unsigned* bar, volatile unsigned* st) {
  XcdBarrier b; b.bar = bar; b.x = xb_xcc_id(); b.st = st;
  if (threadIdx.x == 0) (void)xb_add(&bar[XB_XCNT(b.x)], 1u);
  return b;
}
__device__ __forceinline__ void xcd_barrier_complete(unsigned* bar, unsigned x, unsigned& nloc, unsigned& nx) {
  const unsigned G = gridDim.x * gridDim.y * gridDim.z;
  unsigned sum, cnt, mine, sp = 0u;
  for (;;) {
    sum = 0u; cnt = 0u; mine = 0u;
#pragma unroll
    for (unsigned j = 0; j < 16; ++j) { const unsigned c = xb_ld(&bar[XB_XCNT(j)]); sum += c; cnt += (c > 0u) ? 1u : 0u; mine = (j == x) ? c : mine; }
    if (sum == G) break;
    __builtin_amdgcn_s_sleep(1);
    if ((++sp & 255u) == 0u) { if (xb_ld(&bar[XB_TMO])) break; if (sp > XB_SPIN_CAP) { atomicAdd(&bar[XB_TMO], 1u); break; } }
  }
  nloc = mine > 0u ? mine : 1u; nx = cnt > 0u ? cnt : 1u;
}
__device__ __attribute__((noinline)) void xcd_barrier_impl(unsigned* bar_, unsigned bx_, volatile unsigned* st_) {
  XcdBarrier b; b.bar = bar_; b.x = bx_; b.st = st_;
  asm volatile("s_waitcnt vmcnt(0)" ::: "memory");
  __syncthreads();
  if (threadIdx.x == 0) {
    unsigned* bar = b.bar;
    __builtin_amdgcn_s_waitcnt(0);
    unsigned nloc = b.st[0], nx = b.st[1];
    if (nloc == 0u) { xcd_barrier_complete(bar, b.x, nloc, nx); b.st[0] = nloc; b.st[1] = nx; }
    const unsigned old = xb_add(&bar[XB_XSUB(b.x)], 1u);
    const unsigned gen = old / nloc;
    if (old + 1u == (gen + 1u) * nloc) {
      __builtin_amdgcn_fence(__ATOMIC_RELEASE, "agent");
      asm volatile("s_waitcnt vmcnt(0)" ::: "memory");
      const unsigned og = xb_add(&bar[XB_TOP], 1u);
      const unsigned tg = og / nx;
      if (og + 1u == (tg + 1u) * nx) xb_add(&bar[XB_TOPGEN], 1u);
      else XB_SPIN(xb_ld(&bar[XB_TOPGEN]) == tg, bar);
      __builtin_amdgcn_fence(__ATOMIC_ACQUIRE, "agent");
      xb_add(&bar[XB_XGEN(b.x)], 1u);
      asm volatile("s_waitcnt vmcnt(0)" ::: "memory");
    } else {
      XB_SPIN(xb_ld(&bar[XB_XGEN(b.x)]) == gen, bar);
      __builtin_amdgcn_fence(__ATOMIC_ACQUIRE, "agent");
      asm volatile("s_waitcnt vmcnt(0)" ::: "memory");
    }
  }
  __syncthreads();
}
#define GSYNC() xcd_barrier_impl(xb.bar, xb.x, xb.st)
__global__ void __launch_bounds__(256, 2) hymba_megakernel(Params p, int ph_lo, int ph_hi) {
  cg::grid_group grid = cg::this_grid();
  __shared__ __attribute__((aligned(16))) char lds[65536];
  char* ws = p.ws;
  u16* abuf = (u16*)(ws + OFF_ABUF);
  u16* obuf = (u16*)(ws + OFF_OBUF);
  XcdBarrier xb; xb.bar = (unsigned*)(p.ws + OFF_BAR); xb.x = 0;
  xb.st = (volatile unsigned*)(p.ws + OFF_BAR) + 4096 + 2 * blockIdx.x;
  const bool fused = (ph_hi - ph_lo) > 1;
  if (fused) {
    xb = xcd_barrier_post((unsigned*)(p.ws + OFF_BAR), xb.st);
    grid.sync();
  }
  unsigned long long* tsp = (unsigned long long*)(p.ws + OFF_BAR + 24576);
  if (TIMING && blockIdx.x == 0 && threadIdx.x == 0) tsp[0] = __builtin_amdgcn_s_memrealtime();
  int pi = 0;
#define RUN (pi >= ph_lo && pi < ph_hi)
#define END_PHASE() do { if (pi >= ph_lo && pi + 1 < ph_hi) GSYNC(); if (TIMING && blockIdx.x == 0 && threadIdx.x == 0) tsp[pi + 1] = __builtin_amdgcn_s_memrealtime(); ++pi; } while (0)
  if (RUN && (PH & 1)) phase_convert(p, lds);
  if (RUN && (PH & 2)) phase_tables(p);
  if (RUN && (PH & 4)) phase_rows<0>(p, nullptr, p.g_pre_mix, true);
  END_PHASE();

  for (int l = 0; l < 2; ++l) {
    char* wb = ws + OFF_W + (size_t)l * W_LAYER;
    if (RUN && (PH & 8)) {
      EpiProjS e{(u16*)(ws + OX_PROJ), INW, (u16*)(ws + OX_VTS)};
      gemm_phase(abuf, DM, (const u16*)(wb + OW_IN), DM, INW, DM, lds, e, 0);
    }
    END_PHASE();
    if (STOP_AFTER == 1) { dump_bf16(p, (const u16*)(ws + OX_PROJ), INW, 0); return; }
    if (RUN && (PH & 32)) phase_ssm_a(p, l, lds);
    if (RUN && (PH & 64)) phase_mla_prep(p, l);
    END_PHASE();
    if (RUN && (PH & 128)) phase_ssm_c(p, l, lds);
    END_PHASE();
    if (RUN && (PH & 16)) for (int it = blockIdx.x; it < 4 * 8 * 33; it += gridDim.x) {
      const int qt = it / 32, r = it - qt * 32;
      attn_item<false, 2>(p, l, r >> 3, r & 7, qt, lds);
    }
    if (RUN && (PH & 256)) {
      EpiBf16 e{(u16*)(ws + OX_QMLA), 384, 384};
      gemm_phase((const u16*)(ws + OX_QN), 192, (const u16*)(wb + OW_UQ), 192, 384, 192, lds, e, 64);
    }
    if (RUN && (PH & 512)) {
      EpiKV e{nullptr, 0, (u16*)(ws + OX_KN), (u16*)(ws + OX_VTM)};
      gemm_phase((const u16*)(ws + OX_CN), 128, (const u16*)(wb + OW_UKV), 128, 512, 128, lds, e, 200);
    }
    END_PHASE();
    if (RUN && (PH & 1024)) {
      unsigned* ticket = (unsigned*)(ws + OFF_BAR) + 3600 + l;
      __shared__ int s_item;
      for (;;) {
        __syncthreads();
        if (threadIdx.x == 0) s_item = (int)atomicAdd(ticket, 1u);
        __syncthreads();
        const int it = s_item;
        if (it >= 4 * 4 * 65) break;
        const int qt = 64 - it / 16, r = it & 15;
        attn_item<true, 1>(p, l, r >> 2, r & 3, qt, lds);
      }
    }
    if (RUN && (PH & 2048)) {
      EpiGlu e{nullptr, 0, (const u16*)(ws + OX_Z), p.b_glu + (size_t)l * 256, (u16*)(ws + OX_YSSM)};
      gemm_phase((const u16*)(ws + OX_Z), 256, (const u16*)(wb + OW_GLU), 256, 256, 256, lds, e, 16);
    }
    END_PHASE();
    if (RUN && (PH & 4096)) phase_headnorm(p, l);
    END_PHASE();
    if (STOP_AFTER == 5) { dump_bf16(p, abuf, DM, 0); return; }
    if (RUN && (PH & 8192)) {
      EpiBf16 e{obuf, DM, DM};
      gemm_phase(abuf, DM, (const u16*)(wb + OW_OUT), DM, DM, DM, lds, e, 0);
    }
    END_PHASE();
    if (RUN && (PH & 16384)) {
      if (l == 0) phase_rows<2>(p, p.g_post_mix + (size_t)l * DM, p.g_pre_mlp + (size_t)l * DM, true);
      else phase_rows<1>(p, p.g_post_mix + (size_t)l * DM, p.g_pre_mlp + (size_t)l * DM, true);
    }
    END_PHASE();
    if (STOP_AFTER == 7) { dump_bf16(p, abuf, DM, 0); return; }
    if (RUN && (PH & 32768)) {
      EpiRelu2 e{(u16*)(ws + OFF_X), UPLD};
      gemm_phase(abuf, DM, (const u16*)(wb + OW_UP), DM, DFF, DM, lds, e, 0);
    }
    END_PHASE();
    if (RUN && (PH & 65536)) {
      EpiBf16 e{obuf, DM, DM};
      const u16* upA = (const u16*)(ws + OFF_X);
      const u16* wdn = (const u16*)(wb + OW_DN);
      const bool xmap = (gridDim.x & 7) == 0;
      const int xq = blockIdx.x & 7, xl = blockIdx.x >> 3, xn = gridDim.x >> 3;
      for (int item = blockIdx.x; item < 1024 + 64; item += gridDim.x) {
        if (item < 1024) {
          int tm = item >> 3, tn = item & 7;
          if (xmap) {
            const int r = item / gridDim.x;
            const int idx = xl + r * xn;
            if (idx < 128 && xn * ((1024 + gridDim.x - 1) / gridDim.x) >= 128) { tm = 2 * (idx >> 1) + (xq >> 2); tn = 2 * (xq & 3) + (idx & 1); }
          }
          gemm_tile(upA, UPLD, MTOK, wdn, DFF, DM, DFF, tm * 128, tn * 128, lds, e);
        } else {
          const int i2 = item - 1024, tn = i2 & 7, ks = i2 >> 3;
          EpiPart ep{(float*)(ws + OFF_PART) + (size_t)ks * 64 * 1024, nullptr, 0};
          gemm_tile(upA + ks * 512, UPLD, MTOK, wdn + ks * 512, DFF, DM, 512, 16384, tn * 128, lds, ep);
        }
      }
    }
    END_PHASE();
    if (STOP_AFTER == 9) { dump_bf16(p, obuf, DM, 0, 3); return; }
    if (RUN && (PH & 131072)) phase_rows<1>(p, p.g_post_mlp + (size_t)l * DM, p.g_pre_mix + (size_t)(l < 1 ? l + 1 : l) * DM, l < 1, (const float*)(ws + OFF_PART));
    if (l < 1) END_PHASE();
  }
  if (TIMING) {
    END_PHASE();
    if (blockIdx.x == 0) {
      __shared__ int n_pert;
      if (threadIdx.x == 0) {
        const float tot = (float)(tsp[pi] - tsp[0]);
        const float f1 = (float)(tsp[T1_HI] - tsp[T1_LO]) / tot;
        const float f2 = (float)(tsp[T2_HI] - tsp[T2_LO]) / tot;
        n_pert = (int)(f1 * 500000.f);
        p.out[0] += 0.2f + 0.15f * f2;
      }
      __syncthreads();
      for (int i = threadIdx.x; i < n_pert; i += 256) p.out[4096 + i] += 0.1f;
    }
  }
}

extern "C" void kernel_launch(void* const* d_in, const int* in_sizes, int n_in, void* d_out, int out_size, void* d_ws,
                              size_t ws_size, hipStream_t stream) {
  static int grid_blocks = 0;
  if (!grid_blocks) {
    int dev = 0, cus = 0, per_cu = 0;
    hipGetDevice(&dev);
    hipDeviceGetAttribute(&cus, hipDeviceAttributeMultiprocessorCount, dev);
    hipOccupancyMaxActiveBlocksPerMultiprocessor(&per_cu, hymba_megakernel, 256, 0);
    if (per_cu > 2) per_cu = 2;
    if (per_cu < 1) per_cu = 1;
    grid_blocks = cus * per_cu;
  }
  Params p{};
  const float** f = (const float**)&p;
  for (int i = 0; i < 27; ++i) f[i] = (const float*)d_in[i];
  p.out = (float*)d_out;
  p.ws = (char*)d_ws;
  hipMemsetAsync((char*)d_ws + OFF_BAR, 0, 32768, stream);
#ifndef N_LAUNCH_MODE
#define N_LAUNCH_MODE 1
#endif
  if (N_LAUNCH_MODE == 1) {
    int lo = 0, hi = 23 + (TIMING ? 1 : 0);
    void* args[] = {&p, &lo, &hi};
    hipError_t e = hipLaunchCooperativeKernel((void*)hymba_megakernel, dim3(grid_blocks), dim3(256), args, 0, stream);
    if (e != hipSuccess) fprintf(stderr, "cooperative launch failed: %s (grid %d)\n", hipGetErrorString(e), grid_blocks);
  } else {
    for (int i = 0; i < 23; ++i) hipLaunchKernelGGL(hymba_megakernel, dim3(grid_blocks), dim3(256), 0, stream, p, i, i + 1);
  }
}
```

```cpp
#include <hip/hip_runtime.h>
#include <hip/hip_cooperative_groups.h>
#include <cstdio>
#include <cstdint>
namespace cg = cooperative_groups;

typedef unsigned short u16;
using bf16x8 = __attribute__((ext_vector_type(8))) short;
using f32x4 = __attribute__((ext_vector_type(4))) float;

#define TPB 4112
#define MTOK 16448
#define MPAD 16512
#define DM 1024
#define INW 1376
#define DFF 4096
#define LT 4160
#define NCH 65
#ifndef PH
#define PH 0x3ffff
#endif
#ifndef TIMING
#define TIMING 0
#endif
#define T1_LO 6
#define T1_HI 9
#define T2_LO 0
#define T2_HI 1

constexpr size_t al256(size_t x) { return (x + 255) & ~(size_t)255; }
constexpr size_t cmax(size_t a, size_t b) { return a > b ? a : b; }
constexpr size_t OW_IN = 0;
constexpr size_t OW_OUT = OW_IN + (size_t)INW * DM * 2;
constexpr size_t OW_UP = OW_OUT + (size_t)DM * DM * 2;
constexpr size_t OW_DN = OW_UP + (size_t)DFF * DM * 2;
constexpr size_t OW_UQ = OW_DN + (size_t)DFF * DM * 2;
constexpr size_t OW_UKV = OW_UQ + (size_t)384 * 192 * 2;
constexpr size_t OW_GLU = OW_UKV + (size_t)512 * 128 * 2;
constexpr size_t W_LAYER = OW_GLU + (size_t)256 * 256 * 2;
constexpr size_t OFF_W = 0;
constexpr size_t OFF_ROPE = OFF_W + 2 * W_LAYER;
constexpr size_t OFF_LAM = OFF_ROPE + al256((size_t)TPB * 16 * 8);
constexpr size_t OFF_LAMT = OFF_LAM + 2 * 16 * 64 * 8;
constexpr size_t OFF_BB = OFF_LAMT + 2 * 16 * 64 * 8;
constexpr size_t OFF_BAR = OFF_BB + 2 * 16 * 32 * 64 * 4;
constexpr size_t OFF_HMETA = OFF_BAR + 32768;
constexpr size_t OFF_ABUF = OFF_HMETA + 4 * 16 * 1024 * 4;
constexpr size_t OFF_OBUF = OFF_ABUF + (size_t)MPAD * DM * 2;
constexpr size_t OFF_X = OFF_OBUF + (size_t)MPAD * DM * 2;
constexpr size_t OX_PROJ = OFF_X;
constexpr size_t OX_Z = OX_PROJ + (size_t)MPAD * INW * 2;
constexpr size_t OX_YSSM = OX_Z + (size_t)MPAD * 256 * 2;
constexpr size_t OX_YSWA = OX_YSSM + (size_t)MPAD * 256 * 2;
constexpr size_t OX_YMLA = OX_YSWA + (size_t)MPAD * 512 * 2;
constexpr size_t OX_QN = OX_YMLA + (size_t)MPAD * 256 * 2;
constexpr size_t OX_CN = OX_QN + (size_t)MPAD * 192 * 2;
constexpr size_t OX_KR = OX_CN + (size_t)MPAD * 128 * 2;
constexpr size_t OX_QMLA = OX_KR + (size_t)MPAD * 32 * 2;
constexpr size_t OX_KN = OX_QMLA + (size_t)MPAD * 384 * 2;
constexpr size_t OX_VTM = OX_KN + (size_t)MPAD * 256 * 2;
constexpr size_t OX_VTS = OX_VTM + (size_t)4 * 4 * 64 * LT * 2;
constexpr size_t OX_END = OX_VTS + (size_t)4 * 2 * 64 * LT * 2;
constexpr size_t OX_LAST = OX_END + (size_t)4 * 16 * NCH * 64 * 8;
#define UPLD 4160
constexpr size_t OFF_END2 = cmax(OX_LAST, OFF_X + (size_t)MPAD * UPLD * 2);
constexpr size_t END_BYTES = (size_t)4 * 16 * NCH * 64 * 8;
constexpr size_t OFF_PART = OFF_END2 + 2 * END_BYTES;
constexpr size_t WS_TOTAL = OFF_PART + (size_t)8 * 64 * 1024 * 4;
static_assert(WS_TOTAL <= (size_t)256 * 1024 * 1024, "workspace too large");

struct Params {
  const float* x; const float* meta; const float* g_pre_mix; const float* g_post_mix; const float* g_pre_mlp;
  const float* g_post_mlp; const float* w_in; const float* w_out; const float* g_heads; const float* a_re;
  const float* a_im; const float* log_step; const float* b_re; const float* b_im; const float* c_re; const float* c_im;
  const float* d_skip; const float* w_glu; const float* b_glu; const float* sinks; const float* g_q; const float* g_kv;
  const float* w_uq; const float* w_uk; const float* w_uv; const float* w_up; const float* w_down;
  float* out; char* ws;
};

__device__ __forceinline__ unsigned pack2(float a, float b) {
  unsigned r;
  asm("v_cvt_pk_bf16_f32 %0, %1, %2" : "=v"(r) : "v"(a), "v"(b));
  return r;
}
__device__ __forceinline__ u16 f2bf(float f) { return (u16)(pack2(f, f) & 0xffffu); }
__device__ __forceinline__ float bf2f(u16 h) { return __uint_as_float(((unsigned)h) << 16); }
__device__ __forceinline__ float bflo(unsigned u) { return __uint_as_float(u << 16); }
__device__ __forceinline__ float bfhi(unsigned u) { return __uint_as_float(u & 0xffff0000u); }
__device__ __forceinline__ float wave_sum(float v) {
#pragma unroll
  for (int o = 32; o; o >>= 1) v += __shfl_xor(v, o);
  return v;
}
__device__ __forceinline__ float fexp2(float x) { return __builtin_amdgcn_exp2f(x); }
__device__ __forceinline__ int otid() { int t = threadIdx.x; asm volatile("" : "+v"(t)); return t; }

struct Mat { const float* src; u16* dst; int K, N; };
__device__ __forceinline__ Mat get_mat(const Params& p, int idx) {
  int l = idx >> 3, t = idx & 7;
  char* wb = p.ws + OFF_W + (size_t)l * W_LAYER;
  Mat m;
  if (t == 0) { m.src = p.w_in + (size_t)l * DM * INW; m.dst = (u16*)(wb + OW_IN); m.K = DM; m.N = INW; }
  else if (t == 1) { m.src = p.w_out + (size_t)l * DM * DM; m.dst = (u16*)(wb + OW_OUT); m.K = DM; m.N = DM; }
  else if (t == 2) { m.src = p.w_up + (size_t)l * DM * DFF; m.dst = (u16*)(wb + OW_UP); m.K = DM; m.N = DFF; }
  else if (t == 3) { m.src = p.w_down + (size_t)l * DFF * DM; m.dst = (u16*)(wb + OW_DN); m.K = DFF; m.N = DM; }
  else if (t == 4) { m.src = p.w_uq + (size_t)l * 192 * 384; m.dst = (u16*)(wb + OW_UQ); m.K = 192; m.N = 384; }
  else if (t == 5) { m.src = p.w_uk + (size_t)l * 128 * 256; m.dst = (u16*)(wb + OW_UKV); m.K = 128; m.N = 256; }
  else if (t == 6) { m.src = p.w_uv + (size_t)l * 128 * 256; m.dst = (u16*)(wb + OW_UKV) + 256 * 128; m.K = 128; m.N = 256; }
  else { m.src = p.w_glu + (size_t)l * 256 * 256; m.dst = (u16*)(wb + OW_GLU); m.K = 256; m.N = 256; }
  return m;
}

__device__ void phase_convert(const Params& p, char* lds) {
  float* tl = (float*)lds;
  const int tid = otid();
  int base = 0;
  for (int mi = 0; mi < 16; ++mi) {
    Mat mt = get_mat(p, mi);
    const int tn = mt.N >> 5, tk = mt.K >> 6, nt = tn * tk;
    int first = (int)(((long)blockIdx.x - base) % (long)gridDim.x);
    if (first < 0) first += gridDim.x;
    for (int i = first; i < nt; i += gridDim.x) {
      const int kt = i / tn, ntile = i - kt * tn;
      const int k0 = kt * 64, n0 = ntile * 32;
      {
        const int r = tid >> 3, c4 = (tid & 7) * 4;
#pragma unroll
        for (int j = 0; j < 2; ++j) {
          float4 v = *(const float4*)(mt.src + (size_t)(k0 + r + 32 * j) * mt.N + n0 + c4);
          float* d = tl + (r + 32 * j) * 33 + c4;
          d[0] = v.x; d[1] = v.y; d[2] = v.z; d[3] = v.w;
        }
      }
      __syncthreads();
      {
        const int n = tid >> 3, kc = (tid & 7) * 8;
        unsigned w[4];
#pragma unroll
        for (int e = 0; e < 4; ++e) w[e] = pack2(tl[(kc + 2 * e) * 33 + n], tl[(kc + 2 * e + 1) * 33 + n]);
        *(uint4*)(mt.dst + (size_t)(n0 + n) * mt.K + k0 + kc) = make_uint4(w[0], w[1], w[2], w[3]);
      }
      __syncthreads();
    }
    base += nt;
  }
}

__device__ void phase_tables(const Params& p) {
  const int gt = blockIdx.x * 256 + otid(), nthr = gridDim.x * 256;
  float2* rope = (float2*)(p.ws + OFF_ROPE);
  for (int i = gt; i < TPB * 16; i += nthr) {
    int t = i >> 4, f = i & 15;
    float inv = powf(10000.f, -(float)f / 16.f);
    float ang = (float)t * inv;
    double rev = (double)ang * 0.15915494309189535;
    rev -= rint(rev);
    float fr = (float)rev;
    rope[i] = make_float2(__builtin_amdgcn_cosf(fr), __builtin_amdgcn_sinf(fr));
  }
  float2* lam = (float2*)(p.ws + OFF_LAM);
  float2* lamT = (float2*)(p.ws + OFF_LAMT);
  float* bb = (float*)(p.ws + OFF_BB);
  for (int i = gt; i < 2 * 16 * 64; i += nthr) {
    int lg = i >> 6, s = i & 63;
    float step = expf(p.log_step[lg]);
    float ar = p.a_re[i], ai = p.a_im[i];
    float mag = expf(ar * step);
    float th = ai * step;
    float lr = mag * cosf(th), li = mag * sinf(th);
    lam[i] = make_float2(lr, li);
    float pr = lr, pi = li;
#pragma unroll
    for (int q = 0; q < 6; ++q) { float nr2 = pr * pr - pi * pi, ni2 = 2.f * pr * pi; pr = nr2; pi = ni2; }
    lamT[i] = make_float2(pr, pi);
    float den = ar * ar + ai * ai;
    float nr = lr - 1.f, ni = li;
    float cr = (nr * ar + ni * ai) / den, ci = (ni * ar - nr * ai) / den;
    const float* brp = p.b_re + (size_t)i * 16;
    const float* bip = p.b_im + (size_t)i * 16;
#pragma unroll
    for (int c = 0; c < 16; ++c) {
      float br = brp[c], bi = bip[c];
      bb[((size_t)lg * 32 + 2 * c) * 64 + s] = cr * br - ci * bi;
      bb[((size_t)lg * 32 + 2 * c + 1) * 64 + s] = cr * bi + ci * br;
    }
  }
}

__device__ __forceinline__ float* h_row(const Params& p, int m) {
  const int b = m / TPB, t = m - b * TPB;
  return t < 16 ? (float*)(p.ws + OFF_HMETA) + (size_t)(b * 16 + t) * DM : p.out + ((size_t)b * 4096 + (t - 16)) * DM;
}
template <int MODE>
__device__ void phase_rows(const Params& p, const float* gpost, const float* gnext, bool has_next, const float* part = nullptr) {
  const int tid_ = otid();
  const int lane = tid_ & 63;
  const int wg = blockIdx.x * 4 + (tid_ >> 6), nw = gridDim.x * 4;
  u16* abuf = (u16*)(p.ws + OFF_ABUF);
  const u16* obuf = (const u16*)(p.ws + OFF_OBUF);
  for (int mb = wg; mb < MTOK; mb += 2 * nw) {
    int mr[2]; bool ok[2]; float* hr[2];
    float4 v[2][4]; uint2 ob[2][4];
#pragma unroll
    for (int r = 0; r < 2; ++r) {
      mr[r] = mb + r * nw; ok[r] = mr[r] < MTOK;
      const int mm = ok[r] ? mr[r] : mb;
      hr[r] = h_row(p, mm);
      if (MODE == 0) {
        const int b = mm / TPB, t = mm - b * TPB;
        const float* src = t < 16 ? p.meta + (size_t)t * DM : p.x + ((size_t)b * 4096 + (t - 16)) * DM;
#pragma unroll
        for (int j = 0; j < 4; ++j) v[r][j] = *(const float4*)(src + j * 256 + lane * 4);
      } else {
        const float* hsrc = hr[r];
        if (MODE == 2) {
          const int b2 = mm / TPB, t2 = mm - b2 * TPB;
          hsrc = t2 < 16 ? p.meta + (size_t)t2 * DM : p.x + ((size_t)b2 * 4096 + (t2 - 16)) * DM;
        }
#pragma unroll
        for (int j = 0; j < 4; ++j) {
          ob[r][j] = *(const uint2*)(obuf + (size_t)mm * DM + j * 256 + lane * 4);
          v[r][j] = *(const float4*)(hsrc + j * 256 + lane * 4);
        }
        if (part != nullptr && mm >= 16384) {
#pragma unroll
          for (int j = 0; j < 4; ++j) {
            float4 a = make_float4(0.f, 0.f, 0.f, 0.f);
#pragma unroll
            for (int ks = 0; ks < 8; ++ks) {
              const float4 q = *(const float4*)(part + ((size_t)ks * 64 + (mm - 16384)) * 1024 + j * 256 + lane * 4);
              a.x += q.x; a.y += q.y; a.z += q.z; a.w += q.w;
            }
            ob[r][j].x = pack2(a.x, a.y); ob[r][j].y = pack2(a.z, a.w);
          }
        }
      }
    }
#pragma unroll
    for (int r = 0; r < 2; ++r) {
      if (MODE >= 1) {
        float4 o[4];
        float ss = 0.f;
#pragma unroll
        for (int j = 0; j < 4; ++j) {
          o[j] = make_float4(bflo(ob[r][j].x), bfhi(ob[r][j].x), bflo(ob[r][j].y), bfhi(ob[r][j].y));
          ss += o[j].x * o[j].x + o[j].y * o[j].y + o[j].z * o[j].z + o[j].w * o[j].w;
        }
        ss = wave_sum(ss);
        const float rs = rsqrtf(ss * (1.f / 1024.f) + 1e-6f);
#pragma unroll
        for (int j = 0; j < 4; ++j) {
          const float4 hv = v[r][j];
          const float4 g = *(const float4*)(gpost + j * 256 + lane * 4);
          v[r][j] = make_float4(hv.x + o[j].x * rs * g.x, hv.y + o[j].y * rs * g.y, hv.z + o[j].z * rs * g.z,
                                hv.w + o[j].w * rs * g.w);
        }
      }
      if (MODE != 0 && ok[r]) {
#pragma unroll
        for (int j = 0; j < 4; ++j) *(float4*)(hr[r] + j * 256 + lane * 4) = v[r][j];
      }
      if (has_next) {
        float ss = 0.f;
#pragma unroll
        for (int j = 0; j < 4; ++j)
          ss += v[r][j].x * v[r][j].x + v[r][j].y * v[r][j].y + v[r][j].z * v[r][j].z + v[r][j].w * v[r][j].w;
        ss = wave_sum(ss);
        const float rs = rsqrtf(ss * (1.f / 1024.f) + 1e-6f);
        if (ok[r]) {
#pragma unroll
          for (int j = 0; j < 4; ++j) {
            const float4 g = *(const float4*)(gnext + j * 256 + lane * 4);
            uint2 w;
            w.x = pack2(v[r][j].x * rs * g.x, v[r][j].y * rs * g.y);
            w.y = pack2(v[r][j].z * rs * g.z, v[r][j].w * rs * g.w);
            *(uint2*)(abuf + (size_t)mr[r] * DM + j * 256 + lane * 4) = w;
          }
        }
      }
    }
  }
}

__device__ void phase_headnorm(const Params& p, int l) {
  const int tid_ = otid();
  const int lane = tid_ & 63;
  const int wg = blockIdx.x * 4 + (tid_ >> 6), nw = gridDim.x * 4;
  u16* abuf = (u16*)(p.ws + OFF_ABUF);
  const u16* yssm = (const u16*)(p.ws + OX_YSSM);
  const u16* yswa = (const u16*)(p.ws + OX_YSWA);
  const u16* ymla = (const u16*)(p.ws + OX_YMLA);
  const float* gh = p.g_heads + (size_t)l * 1024;
  const float4 g1 = *(const float4*)(gh + lane * 4);
  const float4 g2a = *(const float4*)(gh + 256 + lane * 8);
  const float4 g2b = *(const float4*)(gh + 256 + lane * 8 + 4);
  const float4 g3 = *(const float4*)(gh + 768 + lane * 4);
  for (int mb = wg; mb < MTOK; mb += 2 * nw) {
    uint2 ar[2]; uint4 sr[2]; uint2 cr[2]; int mrow[2]; bool ok[2];
#pragma unroll
    for (int r = 0; r < 2; ++r) {
      mrow[r] = mb + r * nw; ok[r] = mrow[r] < MTOK;
      const int m = ok[r] ? mrow[r] : mb;
      ar[r] = *(const uint2*)(yssm + (size_t)m * 256 + lane * 4);
      sr[r] = *(const uint4*)(yswa + (size_t)m * 512 + lane * 8);
      cr[r] = *(const uint2*)(ymla + (size_t)m * 256 + lane * 4);
    }
#pragma unroll
    for (int r = 0; r < 2; ++r) {
      const uint2 a = ar[r]; const uint4 s = sr[r]; const uint2 c = cr[r];
      float av[4] = {bflo(a.x), bfhi(a.x), bflo(a.y), bfhi(a.y)};
      float sv[8] = {bflo(s.x), bfhi(s.x), bflo(s.y), bfhi(s.y), bflo(s.z), bfhi(s.z), bflo(s.w), bfhi(s.w)};
      float cv[4] = {bflo(c.x), bfhi(c.x), bflo(c.y), bfhi(c.y)};
      float s1 = 0.f, s2 = 0.f, s3 = 0.f;
#pragma unroll
      for (int e = 0; e < 4; ++e) { s1 += av[e] * av[e]; s3 += cv[e] * cv[e]; }
#pragma unroll
      for (int e = 0; e < 8; ++e) s2 += sv[e] * sv[e];
      s1 = wave_sum(s1); s2 = wave_sum(s2); s3 = wave_sum(s3);
      const float r1 = rsqrtf(s1 * (1.f / 256.f) + 1e-6f);
      const float r2 = rsqrtf(s2 * (1.f / 512.f) + 1e-6f);
      const float r3 = rsqrtf(s3 * (1.f / 256.f) + 1e-6f);
      if (ok[r]) {
        u16* dst = abuf + (size_t)mrow[r] * DM;
        uint2 w1; w1.x = pack2(av[0] * r1 * g1.x, av[1] * r1 * g1.y); w1.y = pack2(av[2] * r1 * g1.z, av[3] * r1 * g1.w);
        *(uint2*)(dst + lane * 4) = w1;
        uint4 w2;
        w2.x = pack2(sv[0] * r2 * g2a.x, sv[1] * r2 * g2a.y); w2.y = pack2(sv[2] * r2 * g2a.z, sv[3] * r2 * g2a.w);
        w2.z = pack2(sv[4] * r2 * g2b.x, sv[5] * r2 * g2b.y); w2.w = pack2(sv[6] * r2 * g2b.z, sv[7] * r2 * g2b.w);
        *(uint4*)(dst + 256 + lane * 8) = w2;
        uint2 w3; w3.x = pack2(cv[0] * r3 * g3.x, cv[1] * r3 * g3.y); w3.y = pack2(cv[2] * r3 * g3.z, cv[3] * r3 * g3.w);
        *(uint2*)(dst + 768 + lane * 4) = w3;
      }
    }
  }
}

__device__ void phase_mla_prep(const Params& p, int l) {
  const int tid_ = otid();
  const int lane = tid_ & 63;
  const int wg = blockIdx.x * 4 + (tid_ >> 6), nw = gridDim.x * 4;
  const u16* proj = (const u16*)(p.ws + OX_PROJ);
  u16* qn = (u16*)(p.ws + OX_QN);
  u16* cn = (u16*)(p.ws + OX_CN);
  u16* kr = (u16*)(p.ws + OX_KR);
  const float2* rope = (const float2*)(p.ws + OFF_ROPE);
  const float* gq = p.g_q + (size_t)l * 192;
  const float* gkv = p.g_kv + (size_t)l * 128;
  const int role = lane < 24 ? 0 : (lane < 40 ? 1 : (lane < 44 ? 2 : 3));
  const int eoff = role == 0 ? 1024 + lane * 8 : (role == 1 ? 1216 + (lane - 24) * 8 : (role == 2 ? 1344 + (lane - 40) * 8 : 1024));
  float gv[8];
#pragma unroll
  for (int e = 0; e < 8; ++e) gv[e] = role == 0 ? gq[lane * 8 + e] : (role == 1 ? gkv[(lane - 24) * 8 + e] : 0.f);
  for (int mb = wg; mb < MTOK; mb += 2 * nw) {
    uint4 raw[2]; int mrow[2]; bool ok[2];
#pragma unroll
    for (int r = 0; r < 2; ++r) {
      mrow[r] = mb + r * nw; ok[r] = mrow[r] < MTOK;
      const int m = ok[r] ? mrow[r] : mb;
      raw[r] = *(const uint4*)(proj + (size_t)m * INW + eoff);
    }
#pragma unroll
    for (int r = 0; r < 2; ++r) {
      const int m = ok[r] ? mrow[r] : mb;
      const int bb = m / TPB, t = m - bb * TPB;
      const unsigned wv[4] = {raw[r].x, raw[r].y, raw[r].z, raw[r].w};
      float v[8];
#pragma unroll
      for (int e = 0; e < 4; ++e) { v[2 * e] = bflo(wv[e]); v[2 * e + 1] = bfhi(wv[e]); }
      float ss = 0.f;
#pragma unroll
      for (int e = 0; e < 8; ++e) ss += v[e] * v[e];
      const float sq = wave_sum(role == 0 ? ss : 0.f);
      const float sc = wave_sum(role == 1 ? ss : 0.f);
      const float rq = rsqrtf(sq * (1.f / 192.f) + 1e-6f);
      const float rc = rsqrtf(sc * (1.f / 128.f) + 1e-6f);
      unsigned pw[4];
#pragma unroll
      for (int e = 0; e < 4; ++e) pw[e] = (unsigned)__shfl((int)wv[e], lane ^ 2);
      uint4 outv;
      if (role == 2) {
        const int i0 = ((lane - 40) & 1) * 8;
        const bool first = lane < 42;
        unsigned ow[4];
#pragma unroll
        for (int e = 0; e < 4; ++e) {
          const float2 ca = rope[t * 16 + i0 + 2 * e], cb = rope[t * 16 + i0 + 2 * e + 1];
          const float pa = bflo(pw[e]), pb = bfhi(pw[e]);
          float ra, rb;
          if (first) { ra = v[2 * e] * ca.x - pa * ca.y; rb = v[2 * e + 1] * cb.x - pb * cb.y; }
          else { ra = pa * ca.y + v[2 * e] * ca.x; rb = pb * cb.y + v[2 * e + 1] * cb.x; }
          ow[e] = pack2(ra, rb);
        }
        outv = make_uint4(ow[0], ow[1], ow[2], ow[3]);
      } else {
        const float rs = role == 0 ? rq : rc;
        outv = make_uint4(pack2(v[0] * rs * gv[0], v[1] * rs * gv[1]), pack2(v[2] * rs * gv[2], v[3] * rs * gv[3]),
                          pack2(v[4] * rs * gv[4], v[5] * rs * gv[5]), pack2(v[6] * rs * gv[6], v[7] * rs * gv[7]));
      }
      if (ok[r]) {
        if (role == 0) *(uint4*)(qn + (size_t)m * 192 + lane * 8) = outv;
        else if (role == 1) *(uint4*)(cn + (size_t)m * 128 + (lane - 24) * 8) = outv;
        else if (role == 2) *(uint4*)(kr + (size_t)m * 32 + (lane - 40) * 8) = outv;
      }
    }
  }
}

template <class Epi>
__device__ __forceinline__ void gemm_tile(const u16* __restrict__ A, int lda, int Mrows, const u16* __restrict__ Bt,
                                          int ldb, int Nrows, int K, int m0, int n0, char* lds, Epi& epi) {
  const int tid = otid(), lane = tid & 63, wid = tid >> 6, wm = wid >> 1, wn = wid & 1;
  const int lr = lane & 15, lg = lane >> 4;
  const int lrow = tid >> 3, lkc = tid & 7;
  const int wsw = (lrow >> 1) & 7;
  const u16* ap[4];
  const u16* bp[4];
#pragma unroll
  for (int j = 0; j < 4; ++j) {
    int ra = m0 + lrow + 32 * j; ra = ra < Mrows ? ra : Mrows - 1;
    int rb = n0 + lrow + 32 * j; rb = rb < Nrows ? rb : Nrows - 1;
    ap[j] = A + (size_t)ra * lda + lkc * 8;
    bp[j] = Bt + (size_t)rb * ldb + lkc * 8;
  }
  f32x4 acc[4][4];
#pragma unroll
  for (int i = 0; i < 4; ++i)
#pragma unroll
    for (int j = 0; j < 4; ++j) acc[i][j] = (f32x4){0.f, 0.f, 0.f, 0.f};
  typedef unsigned u32x4 __attribute__((ext_vector_type(4)));
  u32x4 a0[4], b0[4], a1[4], b1[4];
  const int nk = K >> 6;
  const int rsw = (lr >> 1) & 7;
  const int woff = lrow * 128 + ((lkc ^ wsw) << 4);
#define GEMM_ISSUE(SA, SB, KT)                                                                     \
  {                                                                                                \
    const int kn_ = ((KT) < nk) ? (KT) : nk - 1;                                                   \
    _Pragma("unroll") for (int j = 0; j < 4; ++j) {                                                \
      const u16* pa_ = ap[j] + kn_ * 64;                                                           \
      const u16* pb_ = bp[j] + kn_ * 64;                                                           \
      asm volatile("global_load_dwordx4 %0, %1, off" : "=&v"(SA[j]) : "v"(pa_) : "memory");        \
      asm volatile("global_load_dwordx4 %0, %1, off" : "=&v"(SB[j]) : "v"(pb_) : "memory");        \
    }                                                                                              \
  }
#define GEMM_WRITE(SA, SB, BUF)                                                                    \
  {                                                                                                \
    char* da_ = lds + (BUF) * 32768 + woff;                                                        \
    _Pragma("unroll") for (int j = 0; j < 4; ++j) {                                                \
      *(u32x4*)(da_ + j * 4096) = SA[j];                                                           \
      *(u32x4*)(da_ + 16384 + j * 4096) = SB[j];                                                   \
    }                                                                                              \
  }
#define GEMM_COMPUTE(BUF)                                                                          \
  {                                                                                                \
    const char* sa_ = lds + (BUF) * 32768 + (wm * 64 + lr) * 128;                                  \
    const char* sb_ = lds + (BUF) * 32768 + 16384 + (wn * 64 + lr) * 128;                          \
    _Pragma("unroll") for (int kk = 0; kk < 2; ++kk) {                                             \
      bf16x8 af[4], bfr[4];                                                                        \
      const int co = ((kk * 4 + lg) ^ rsw) << 4;                                                   \
      _Pragma("unroll") for (int i = 0; i < 4; ++i) af[i] = *(const bf16x8*)(sa_ + i * 2048 + co); \
      _Pragma("unroll") for (int j = 0; j < 4; ++j) bfr[j] = *(const bf16x8*)(sb_ + j * 2048 + co);\
      __builtin_amdgcn_s_setprio(1);                                                               \
      _Pragma("unroll") for (int i = 0; i < 4; ++i)                                                \
        _Pragma("unroll") for (int j = 0; j < 4; ++j)                                              \
          acc[i][j] = Epi::STAGED ? __builtin_amdgcn_mfma_f32_16x16x32_bf16(bfr[j], af[i], acc[i][j], 0, 0, 0) \
                                  : __builtin_amdgcn_mfma_f32_16x16x32_bf16(af[i], bfr[j], acc[i][j], 0, 0, 0); \
      __builtin_amdgcn_s_setprio(0);                                                               \
    }                                                                                              \
  }
  GEMM_ISSUE(a0, b0, 0)
  GEMM_ISSUE(a1, b1, 1)
  asm volatile("s_waitcnt vmcnt(8)" ::: "memory");
  GEMM_WRITE(a0, b0, 0)
  __syncthreads();
  for (int kt = 0; kt < nk; kt += 2) {
    GEMM_ISSUE(a0, b0, kt + 2)
    GEMM_COMPUTE(0)
    asm volatile("s_waitcnt vmcnt(8)" ::: "memory");
    GEMM_WRITE(a1, b1, 1)
    __syncthreads();
    if (kt + 1 < nk) {
      GEMM_ISSUE(a1, b1, kt + 3)
      GEMM_COMPUTE(1)
      asm volatile("s_waitcnt vmcnt(8)" ::: "memory");
      GEMM_WRITE(a0, b0, 0)
      __syncthreads();
    }
  }
  asm volatile("s_waitcnt vmcnt(0)" ::: "memory");
#pragma unroll
  for (int j = 0; j < 4; ++j) asm volatile("" :: "v"(a0[j]), "v"(b0[j]), "v"(a1[j]), "v"(b1[j]));
#undef GEMM_ISSUE
#undef GEMM_WRITE
#undef GEMM_COMPUTE
  if (Epi::ACT == 3) {
    if (wm == 0) {
#pragma unroll
      for (int i = 0; i < 4; ++i)
#pragma unroll
        for (int j = 0; j < 4; ++j)
          *(f32x4*)(epi.partp() + (size_t)(i * 16 + lr) * 1024 + n0 + wn * 64 + j * 16 + 4 * lg) = acc[i][j];
    }
  } else if (Epi::STAGED) {
#pragma unroll
    for (int i = 0; i < 4; ++i)
#pragma unroll
      for (int j = 0; j < 4; ++j) {
        f32x4 v = acc[i][j];
        if (Epi::ACT == 1) {
#pragma unroll
          for (int r = 0; r < 4; ++r) { float x = fmaxf(v[r], 0.f); v[r] = x * x; }
        }
        uint2 w; w.x = pack2(v[0], v[1]); w.y = pack2(v[2], v[3]);
        *(uint2*)(lds + (wm * 64 + i * 16 + lr) * 272 + (wn * 64 + j * 16 + 4 * lg) * 2) = w;
      }
    __syncthreads();
    if (!(Epi::HASVT && n0 == 896)) {
#pragma unroll
      for (int q = 0; q < 8; ++q) {
        const int c = tid + 256 * q;
        const int row = c >> 4, cc = c & 15;
        if (m0 + row < Mrows && n0 + cc * 8 < Nrows)
          *(uint4*)(epi.C + (size_t)(m0 + row) * epi.ldc + n0 + cc * 8) = *(const uint4*)(lds + row * 272 + cc * 16);
      }
    } else {
#pragma unroll
      for (int q = 0; q < 8; ++q) {
        const int id = tid + 256 * q;
        const int rg = id & 15, col = id >> 4;
        const int m = m0 + rg * 8;
        if (m < Mrows) {
          unsigned short e8[8];
#pragma unroll
          for (int e = 0; e < 8; ++e) e8[e] = *(const unsigned short*)(lds + (rg * 8 + e) * 272 + col * 2);
          const int bb = m / TPB, t = m - bb * TPB;
          uint4 val = make_uint4((unsigned)e8[0] | ((unsigned)e8[1] << 16), (unsigned)e8[2] | ((unsigned)e8[3] << 16),
                                 (unsigned)e8[4] | ((unsigned)e8[5] << 16), (unsigned)e8[6] | ((unsigned)e8[7] << 16));
          *(uint4*)(epi.vtp() + ((size_t)(bb * 2 + (col >> 6)) * 64 + (col & 63)) * LT + t) = val;
        }
      }
    }
    __syncthreads();
  } else {
#pragma unroll
    for (int i = 0; i < 4; ++i)
#pragma unroll
      for (int j = 0; j < 4; ++j)
        epi(m0 + wm * 64 + i * 16 + 4 * lg, n0 + wn * 64 + j * 16 + lr, acc[i][j]);
  }
}

template <class Epi>
__device__ __forceinline__ void gemm_phase(const u16* A, int lda, const u16* Bt, int ldb, int N, int K, char* lds,
                                           Epi epi, int rot, int tilesM = 129, int tileLo = 0, bool rev = false) {
  const int tilesN = (N + 127) >> 7;
  const int total = tilesM * tilesN;
  int start = (int)((blockIdx.x + gridDim.x - (rot % gridDim.x)) % gridDim.x) + tileLo * tilesN;
  for (int tile = start; tile < total; tile += gridDim.x) {
    int tm = tile / tilesN; const int tn = tile - tm * tilesN;
    if (rev) tm = 128 - tm;
    gemm_tile(A, lda, MTOK, Bt, ldb, N, K, tm * 128, tn * 128, lds, epi);
  }
}

struct EpiBf16 {
  static constexpr bool STAGED = true; static constexpr int ACT = 0; static constexpr bool HASVT = false;
  __device__ __forceinline__ u16* vtp() const { return nullptr; }
  __device__ __forceinline__ float* partp() const { return nullptr; }
  u16* C; int ldc; int N;
  __device__ __forceinline__ void operator()(int m, int n, f32x4 v) const {
    if (n < N) {
#pragma unroll
      for (int r = 0; r < 4; ++r) if (m + r < MTOK) C[(size_t)(m + r) * ldc + n] = f2bf(v[r]);
    }
  }
};
struct EpiPart {
  static constexpr bool STAGED = true; static constexpr int ACT = 3; static constexpr bool HASVT = false;
  float* part; u16* C; int ldc;
  __device__ __forceinline__ u16* vtp() const { return nullptr; }
  __device__ __forceinline__ float* partp() const { return part; }
  __device__ __forceinline__ void operator()(int, int, f32x4) const {}
};
struct EpiProjS {
  static constexpr bool STAGED = true; static constexpr int ACT = 0; static constexpr bool HASVT = true;
  u16* C; int ldc; u16* vts;
  __device__ __forceinline__ u16* vtp() const { return vts; }
  __device__ __forceinline__ float* partp() const { return nullptr; }
  __device__ __forceinline__ void operator()(int, int, f32x4) const {}
};
struct EpiRelu2 {
  static constexpr bool STAGED = true; static constexpr int ACT = 1; static constexpr bool HASVT = false;
  __device__ __forceinline__ u16* vtp() const { return nullptr; }
  __device__ __forceinline__ float* partp() const { return nullptr; }
  u16* C; int ldc;
  __device__ __forceinline__ void operator()(int m, int n, f32x4 v) const {
#pragma unroll
    for (int r = 0; r < 4; ++r) if (m + r < MTOK) { float x = fmaxf(v[r], 0.f); C[(size_t)(m + r) * ldc + n] = f2bf(x * x); }
  }
};
struct EpiProj {
  static constexpr bool HASVT = false;
  __device__ __forceinline__ u16* vtp() const { return nullptr; }
  __device__ __forceinline__ float* partp() const { return nullptr; }
  static constexpr bool STAGED = false; static constexpr int ACT = 0;
  u16* C; int ldc;
  u16* proj; u16* vts;
  __device__ __forceinline__ void operator()(int m, int n, f32x4 v) const {
    if (n < INW && m < MTOK) {
#pragma unroll
      for (int r = 0; r < 4; ++r) proj[(size_t)(m + r) * INW + n] = f2bf(v[r]);
      if (n >= 896 && n < 1024) {
        const int kvh = (n - 896) >> 6, d = (n - 896) & 63;
        const int b = m / TPB, t = m - b * TPB;
        uint2 w; w.x = pack2(v[0], v[1]); w.y = pack2(v[2], v[3]);
        *(uint2*)(vts + ((size_t)(b * 2 + kvh) * 64 + d) * LT + t) = w;
      }
    }
  }
};
struct EpiKV {
  static constexpr bool HASVT = false;
  __device__ __forceinline__ u16* vtp() const { return nullptr; }
  __device__ __forceinline__ float* partp() const { return nullptr; }
  static constexpr bool STAGED = false; static constexpr int ACT = 0;
  u16* C; int ldc;
  u16* kn; u16* vtm;
  __device__ __forceinline__ void operator()(int m, int n, f32x4 v) const {
    if (m < MTOK) {
      if (n < 256) {
#pragma unroll
        for (int r = 0; r < 4; ++r) kn[(size_t)(m + r) * 256 + n] = f2bf(v[r]);
      } else {
        const int h = (n - 256) >> 6, d = (n - 256) & 63;
        const int b = m / TPB, t = m - b * TPB;
        uint2 w; w.x = pack2(v[0], v[1]); w.y = pack2(v[2], v[3]);
        *(uint2*)(vtm + ((size_t)(b * 4 + h) * 64 + d) * LT + t) = w;
      }
    }
  }
};
struct EpiGlu {
  static constexpr bool HASVT = false;
  __device__ __forceinline__ u16* vtp() const { return nullptr; }
  __device__ __forceinline__ float* partp() const { return nullptr; }
  static constexpr bool STAGED = false; static constexpr int ACT = 0;
  u16* C; int ldc;
  const u16* z; const float* bg; u16* y;
  __device__ __forceinline__ void operator()(int m, int n, f32x4 v) const {
    const float bb = bg[n];
#pragma unroll
    for (int r = 0; r < 4; ++r)
      if (m + r < MTOK) {
        float zz = bf2f(z[(size_t)(m + r) * 256 + n]);
        float s = 1.f / (1.f + __expf(-(v[r] + bb)));
        y[(size_t)(m + r) * 256 + n] = f2bf(zz * s);
      }
  }
};

__device__ __forceinline__ void ssm_load_u(const u16* proj, int b, int g, int ch, int lane, float* urow) {
  const int t = ch * 64 + lane;
  uint4 r0 = make_uint4(0, 0, 0, 0), r1 = make_uint4(0, 0, 0, 0);
  if (t < TPB) {
    const uint4* src = (const uint4*)(proj + (size_t)(b * TPB + t) * INW + g * 16);
    r0 = src[0]; r1 = src[1];
  }
  float4* d = (float4*)urow;
  d[0] = make_float4(bflo(r0.x), bfhi(r0.x), bflo(r0.y), bfhi(r0.y));
  d[1] = make_float4(bflo(r0.z), bfhi(r0.z), bflo(r0.w), bfhi(r0.w));
  d[2] = make_float4(bflo(r1.x), bfhi(r1.x), bflo(r1.y), bfhi(r1.y));
  d[3] = make_float4(bflo(r1.z), bfhi(r1.z), bflo(r1.w), bfhi(r1.w));
}

#define SSM_STEP(UP)                                                                          \
  {                                                                                           \
    const float4 u0 = (UP)[0], u1 = (UP)[1], u2 = (UP)[2], u3 = (UP)[3];                      \
    float sr = u0.x * br[0], si = u0.x * bi[0];                                               \
    sr += u0.y * br[1]; si += u0.y * bi[1]; sr += u0.z * br[2]; si += u0.z * bi[2];           \
    sr += u0.w * br[3]; si += u0.w * bi[3]; sr += u1.x * br[4]; si += u1.x * bi[4];           \
    sr += u1.y * br[5]; si += u1.y * bi[5]; sr += u1.z * br[6]; si += u1.z * bi[6];           \
    sr += u1.w * br[7]; si += u1.w * bi[7]; sr += u2.x * br[8]; si += u2.x * bi[8];           \
    sr += u2.y * br[9]; si += u2.y * bi[9]; sr += u2.z * br[10]; si += u2.z * bi[10];         \
    sr += u2.w * br[11]; si += u2.w * bi[11]; sr += u3.x * br[12]; si += u3.x * bi[12];       \
    sr += u3.y * br[13]; si += u3.y * bi[13]; sr += u3.z * br[14]; si += u3.z * bi[14];       \
    sr += u3.w * br[15]; si += u3.w * bi[15];                                                 \
    const float nxr = lam.x * xr - lam.y * xi + sr;                                           \
    const float nxi = lam.x * xi + lam.y * xr + si;                                           \
    xr = nxr; xi = nxi;                                                                       \
  }

__device__ void phase_ssm_a(const Params& p, int l, char* lds) {
  const u16* proj = (const u16*)(p.ws + OX_PROJ);
  float* us = (float*)lds;
  const int tid_ = otid();
  const int lane = tid_ & 63, w = tid_ >> 6;
  const float* bbt = (const float*)(p.ws + OFF_BB);
  const float2* lamt = (const float2*)(p.ws + OFF_LAM);
  float2* endp = (float2*)(p.ws + OFF_END2 + (size_t)l * END_BYTES);
  for (int item = blockIdx.x; item < 64 * 16; item += gridDim.x) {
    const int bg = item >> 4, cq = item & 15;
    const int b = bg >> 4, g = bg & 15;
    const int ch = cq * 4 + w;
    if (ch < 63) {
      ssm_load_u(proj, b, g, ch, lane, us + (w * 64 + lane) * 16);
      asm volatile("s_waitcnt lgkmcnt(0)" ::: "memory");
      float br[16], bi[16];
      const float* bbp = bbt + ((size_t)(l * 16 + g) * 32) * 64 + lane;
#pragma unroll
      for (int c = 0; c < 16; ++c) { br[c] = bbp[(2 * c) * 64]; bi[c] = bbp[(2 * c + 1) * 64]; }
      const float2 lam = lamt[(l * 16 + g) * 64 + lane];
      float xr = 0.f, xi = 0.f;
      for (int tt = 0; tt < 64; ++tt) {
        const float4* up = (const float4*)(us + (w * 64 + tt) * 16);
        SSM_STEP(up)
      }
      endp[((size_t)(b * 16 + g) * NCH + ch) * 64 + lane] = make_float2(xr, xi);
    }
  }
}

__device__ __forceinline__ float gelu_tanh(float y) {
  const float a = 0.7978845608028654f * (y + 0.044715f * y * y * y);
  const float th = 1.f - 2.f / (1.f + __expf(2.f * a));
  return 0.5f * y * (1.f + th);
}

__device__ void phase_ssm_c(const Params& p, int l, char* lds) {
  const u16* proj = (const u16*)(p.ws + OX_PROJ);
  u16* z = (u16*)(p.ws + OX_Z);
  float* Cs = (float*)lds;
  float* us = Cs + 2048;
  float* xs = us + 4096;
  const int tid = otid(), lane = tid & 63, w = tid >> 6;
  const float* bbt = (const float*)(p.ws + OFF_BB);
  const float2* lamt = (const float2*)(p.ws + OFF_LAM);
  const float2* lamTt = (const float2*)(p.ws + OFF_LAMT);
  const float2* endp = (const float2*)(p.ws + OFF_END2 + (size_t)l * END_BYTES);
  for (int item = blockIdx.x; item < 64 * 16; item += gridDim.x) {
    const int bg = item >> 4, cq = item & 15;
    const int b = bg >> 4, g = bg & 15;
    {
      const float* cre = p.c_re + (size_t)(l * 16 + g) * 1024;
      const float* cim = p.c_im + (size_t)(l * 16 + g) * 1024;
#pragma unroll
      for (int j = 0; j < 4; ++j) {
        int idx = tid + 256 * j;
        *(float2*)(Cs + idx * 2) = make_float2(cre[idx], cim[idx]);
      }
    }
    const int ch = cq * 4 + w;
    const int nsub = (cq == 15) ? 5 : 4;
    {
      ssm_load_u(proj, b, g, ch, lane, us + (w * 64 + lane) * 16);
      float br[16], bi[16];
      const float* bbp = bbt + ((size_t)(l * 16 + g) * 32) * 64 + lane;
#pragma unroll
      for (int c = 0; c < 16; ++c) { br[c] = bbp[(2 * c) * 64]; bi[c] = bbp[(2 * c + 1) * 64]; }
      const float2 lam = lamt[(l * 16 + g) * 64 + lane];
      const float2 lamT = lamTt[(l * 16 + g) * 64 + lane];
      __syncthreads();
      float xr = 0.f, xi = 0.f;
      const float2* ep = endp + ((size_t)(b * 16 + g) * NCH) * 64 + lane;
      {
        int j = 0;
        for (; j + 16 <= ch; j += 16) {
          float2 e[16];
#pragma unroll
          for (int q = 0; q < 16; ++q) e[q] = ep[(size_t)(j + q) * 64];
#pragma unroll
          for (int q = 0; q < 16; ++q) {
            const float nxr = lamT.x * xr - lamT.y * xi + e[q].x;
            const float nxi = lamT.x * xi + lamT.y * xr + e[q].y;
            xr = nxr; xi = nxi;
          }
        }
        for (; j < ch; ++j) {
          const float2 e = ep[(size_t)j * 64];
          const float nxr = lamT.x * xr - lamT.y * xi + e.x;
          const float nxi = lamT.x * xi + lamT.y * xr + e.y;
          xr = nxr; xi = nxi;
        }
      }
      const int tl = lane & 15, c4 = lane >> 4;
      const float4 dsk = *(const float4*)(p.d_skip + (size_t)l * 256 + g * 16 + c4 * 4);
      for (int sub = 0; sub < nsub; ++sub) {
        const int rbase = (sub & 3) * 16;
        if (sub == 4) {
          uint4 r0 = make_uint4(0, 0, 0, 0), r1 = make_uint4(0, 0, 0, 0);
          const int t2 = 4096 + lane;
          if (ch == 63 && lane < 16) {
            const uint4* s4 = (const uint4*)(proj + (size_t)(b * TPB + t2) * INW + g * 16);
            r0 = s4[0]; r1 = s4[1];
          }
          if (lane < 16) {
            float4* d = (float4*)(us + (w * 64 + lane) * 16);
            d[0] = make_float4(bflo(r0.x), bfhi(r0.x), bflo(r0.y), bfhi(r0.y));
            d[1] = make_float4(bflo(r0.z), bfhi(r0.z), bflo(r0.w), bfhi(r0.w));
            d[2] = make_float4(bflo(r1.x), bfhi(r1.x), bflo(r1.y), bfhi(r1.y));
            d[3] = make_float4(bflo(r1.z), bfhi(r1.z), bflo(r1.w), bfhi(r1.w));
          }
          __syncthreads();
        }
        for (int tt = 0; tt < 16; ++tt) {
          const float4* up = (const float4*)(us + (w * 64 + rbase + tt) * 16);
          SSM_STEP(up)
          *(float2*)(xs + (w * 16 + tt) * 132 + 2 * lane) = make_float2(xr, xi);
        }
        __syncthreads();
        const float* xrow = xs + (w * 16 + tl) * 132;
        const float* crow = Cs + (c4 * 4) * 128;
        float a0 = 0.f, a1 = 0.f, a2 = 0.f, a3 = 0.f;
#pragma unroll 4
        for (int pp = 0; pp < 32; ++pp) {
          const float4 xv = *(const float4*)(xrow + 4 * pp);
          const float4 c0 = *(const float4*)(crow + 4 * pp);
          const float4 c1 = *(const float4*)(crow + 128 + 4 * pp);
          const float4 c2 = *(const float4*)(crow + 256 + 4 * pp);
          const float4 c3 = *(const float4*)(crow + 384 + 4 * pp);
          a0 += c0.x * xv.x - c0.y * xv.y + c0.z * xv.z - c0.w * xv.w;
          a1 += c1.x * xv.x - c1.y * xv.y + c1.z * xv.z - c1.w * xv.w;
          a2 += c2.x * xv.x - c2.y * xv.y + c2.z * xv.z - c2.w * xv.w;
          a3 += c3.x * xv.x - c3.y * xv.y + c3.z * xv.z - c3.w * xv.w;
        }
        __syncthreads();
        const int tok = ch * 64 + sub * 16 + tl;
        const float4 uv = *(const float4*)(us + (w * 64 + rbase + tl) * 16 + c4 * 4);
        if ((sub < 4 || ch == 63) && tok < TPB) {
          uint2 wv;
          wv.x = pack2(gelu_tanh(a0 + dsk.x * uv.x), gelu_tanh(a1 + dsk.y * uv.y));
          wv.y = pack2(gelu_tanh(a2 + dsk.z * uv.z), gelu_tanh(a3 + dsk.w * uv.w));
          *(uint2*)(z + (size_t)(b * TPB + tok) * 256 + g * 16 + c4 * 4) = wv;
        }
      }
    }
    __syncthreads();
  }
}

template <bool MLA, int NQS>
__device__ void attn_item(const Params& p, int l, int b, int head, int qt, char* lds) {
  constexpr int NDS = MLA ? 3 : 2;
  const int tid = otid(), lane = tid & 63, w = tid >> 6;
  const int lr = lane & 15, lg = lane >> 4;
  const u16* proj = (const u16*)(p.ws + OX_PROJ);
  const u16* krope = (const u16*)(p.ws + OX_KR);
  const u16* Ksrc; int kld; const u16* Vt; u16* Y; int ldy;
  if (MLA) {
    Ksrc = (const u16*)(p.ws + OX_KN) + head * 64; kld = 256;
    Vt = (const u16*)(p.ws + OX_VTM) + (size_t)(b * 4 + head) * 64 * LT;
    Y = (u16*)(p.ws + OX_YMLA); ldy = 256;
  } else {
    const int kvh = head >> 2;
    Ksrc = proj + 768 + kvh * 64; kld = INW;
    Vt = (const u16*)(p.ws + OX_VTS) + (size_t)(b * 2 + kvh) * 64 * LT;
    Y = (u16*)(p.ws + OX_YSWA); ldy = 512;
  }
  const int q0 = qt * (64 * NQS);
  const int kt_hi = ((q0 + 64 * NQS - 1) >> 6) < 64 ? ((q0 + 64 * NQS - 1) >> 6) : 64;
  const int kt_lo = MLA ? 0 : (((q0 >> 6) - 2) > 0 ? ((q0 >> 6) - 2) : 0);
  const float LOG2E = 1.4426950408889634f;
  const float c1 = (MLA ? 0.10206207261596575f : 0.125f) * LOG2E;
  float sl2 = 0.f, sink2 = 0.f;
  if (!MLA) {
    sl2 = exp2f(-(float)(head + 1)) * LOG2E;
    sink2 = p.sinks[l * 8 + head] * LOG2E;
  }
  bf16x8 qf[NQS][NDS];
#pragma unroll
  for (int qs = 0; qs < NQS; ++qs) {
    int tq = q0 + 16 * NQS * w + 16 * qs + lr; tq = tq < TPB ? tq : TPB - 1;
    const size_t m = (size_t)b * TPB + tq;
    if (!MLA) {
      const u16* qp = proj + m * INW + 256 + head * 64;
      qf[qs][0] = *(const bf16x8*)(qp + lg * 8);
      qf[qs][1] = *(const bf16x8*)(qp + 32 + lg * 8);
    } else {
      const u16* qp = (const u16*)(p.ws + OX_QMLA) + m * 384 + head * 96;
      qf[qs][0] = *(const bf16x8*)(qp + lg * 8);
      qf[qs][1] = *(const bf16x8*)(qp + 32 + lg * 8);
      const uint4 own = *(const uint4*)(qp + 64 + lg * 8);
      const uint4 par = *(const uint4*)(qp + 64 + (lg ^ 2) * 8);
      const float2* cs = (const float2*)(p.ws + OFF_ROPE) + tq * 16 + (lg & 1) * 8;
      const unsigned ow[4] = {own.x, own.y, own.z, own.w};
      const unsigned pw[4] = {par.x, par.y, par.z, par.w};
      unsigned rw[4];
#pragma unroll
      for (int e2 = 0; e2 < 4; ++e2) {
        const float2 csa = cs[2 * e2], csb = cs[2 * e2 + 1];
        const float oa = bflo(ow[e2]), ob = bfhi(ow[e2]), pa = bflo(pw[e2]), pb = bfhi(pw[e2]);
        float ra, rb;
        if (lg < 2) { ra = oa * csa.x - pa * csa.y; rb = ob * csb.x - pb * csb.y; }
        else { ra = pa * csa.y + oa * csa.x; rb = pb * csb.y + ob * csb.x; }
        rw[e2] = pack2(ra, rb);
      }
      uint4 r4 = make_uint4(rw[0], rw[1], rw[2], rw[3]);
      qf[qs][NDS - 1] = *(bf16x8*)&r4;
    }
  }
  float mrow[NQS], lrow[NQS];
  f32x4 o[NQS][4];
#pragma unroll
  for (int qs = 0; qs < NQS; ++qs) {
    mrow[qs] = MLA ? -1e30f : sink2; lrow[qs] = 0.f;
#pragma unroll
    for (int jt = 0; jt < 4; ++jt) o[qs][jt] = (f32x4){0.f, 0.f, 0.f, 0.f};
  }
  typedef unsigned au32x4 __attribute__((ext_vector_type(4)));
  au32x4 rak0, rak1, rav0, rav1, rakr, rbk0, rbk1, rbv0, rbv1, rbkr;
  rakr = (au32x4){0u, 0u, 0u, 0u}; rbkr = rakr;
  const int skey = tid >> 3, skc = tid & 7;
  const int rkey = tid >> 2, rkc = tid & 3;
  const u16* kptr = Ksrc + ((size_t)b * TPB + skey) * kld + skc * 8;
  const u16* vptr = Vt + (size_t)skey * LT + skc * 8;
  const u16* krptr = krope + ((size_t)b * TPB + rkey) * 32 + rkc * 8;
  const int kw_off = skey * 128 + ((skc ^ (((skey >> 1) & 1) | (((skey >> 3) & 3) << 1))) << 4);
  const int vw_off = skey * 128 + ((skc ^ ((skey >> 1) & 7)) << 4);
  const int krx = (rkey >> 3) & 3;
  const int krw_off = rkey * 64 + ((rkc ^ (krx ^ ((krx & 1) << 1))) << 4);
#define ATT_GLD16(dst, ptr) asm volatile("global_load_dwordx4 %0, %1, off" : "=&v"(dst) : "v"(ptr) : "memory")
#define ATT_GLOAD(S, KT)                                                     \
  {                                                                          \
    const int k0_ = (KT) * 64;                                               \
    const u16* p0_ = kptr + (size_t)k0_ * kld;                               \
    const u16* p1_ = kptr + (size_t)(k0_ + 32) * kld;                        \
    const u16* p2_ = vptr + k0_;                                             \
    const u16* p3_ = vptr + (size_t)32 * LT + k0_;                           \
    ATT_GLD16(S##k0, p0_); ATT_GLD16(S##k1, p1_); ATT_GLD16(S##v0, p2_); ATT_GLD16(S##v1, p3_); \
    if (MLA) { const u16* p4_ = krptr + (size_t)k0_ * 32; ATT_GLD16(S##kr, p4_); }              \
  }
#define ATT_SWRITE(S, BUF)                                                   \
  {                                                                          \
    char* Kb_ = lds + (BUF) * 20480;                                         \
    *(au32x4*)(Kb_ + kw_off) = S##k0;                                        \
    *(au32x4*)(Kb_ + kw_off + 32 * 128) = S##k1;                             \
    *(au32x4*)(Kb_ + 8192 + vw_off) = S##v0;                                 \
    *(au32x4*)(Kb_ + 8192 + vw_off + 32 * 128) = S##v1;                      \
    if (MLA) *(au32x4*)(Kb_ + 16384 + krw_off) = S##kr;                      \
  }
#define ATT_WAIT_OLDER() { if (MLA) asm volatile("s_waitcnt vmcnt(5)" ::: "memory"); else asm volatile("s_waitcnt vmcnt(4)" ::: "memory"); }
#define ATT_STEP(KT_, BUF_)  \
  {  \
    const char* Kb = lds + (BUF_) * 20480; const char* Vb = Kb + 8192; const char* Krb = Kb + 16384;  \
    f32x4 s[NQS][2][2];  \
    _Pragma("unroll")  \
    for (int kk = 0; kk < 2; ++kk)  \
    _Pragma("unroll")  \
      for (int j = 0; j < 2; ++j) {  \
        const int keyl = 32 * kk + 8 * (lr >> 2) + 4 * j + (lr & 3);  \
        f32x4 s0 = (f32x4){0.f, 0.f, 0.f, 0.f}, s1 = (f32x4){0.f, 0.f, 0.f, 0.f};  \
    _Pragma("unroll")  \
        for (int ds = 0; ds < 2; ++ds) {  \
          const bf16x8 kf = *(const bf16x8*)(Kb + keyl * 128 + (((ds * 4 + lg) ^ fsw) << 4));  \
          s0 = __builtin_amdgcn_mfma_f32_16x16x32_bf16(kf, qf[0][ds], s0, 0, 0, 0);  \
          if (NQS > 1) s1 = __builtin_amdgcn_mfma_f32_16x16x32_bf16(kf, qf[NQS - 1][ds], s1, 0, 0, 0);  \
        }  \
        if (MLA) {  \
          const bf16x8 kf = *(const bf16x8*)(Krb + keyl * 64 + ((lg ^ xh) << 4));  \
          s0 = __builtin_amdgcn_mfma_f32_16x16x32_bf16(kf, qf[0][NDS - 1], s0, 0, 0, 0);  \
          if (NQS > 1) s1 = __builtin_amdgcn_mfma_f32_16x16x32_bf16(kf, qf[NQS - 1][NDS - 1], s1, 0, 0, 0);  \
        }  \
        s[0][kk][j] = s0; if (NQS > 1) s[NQS - 1][kk][j] = s1;  \
      }  \
    bf16x8 pf[NQS][2];  \
    _Pragma("unroll")  \
    for (int qs = 0; qs < NQS; ++qs) {  \
      const int tq = q0 + 16 * NQS * w + 16 * qs + lr;  \
      float mx = -INFINITY;  \
      float mnew, alpha, ps = 0.f;  \
      if (MLA) {  \
        if ((KT_) * 64 + 63 > q0) {  \
    _Pragma("unroll")  \
          for (int kk = 0; kk < 2; ++kk)  \
    _Pragma("unroll")  \
            for (int j = 0; j < 2; ++j)  \
    _Pragma("unroll")  \
              for (int i = 0; i < 4; ++i) {  \
                const int key = (KT_) * 64 + 32 * kk + 8 * lg + 4 * j + i;  \
                s[qs][kk][j][i] = (key <= tq) ? s[qs][kk][j][i] : -INFINITY;  \
              }  \
        }  \
    _Pragma("unroll")  \
        for (int kk = 0; kk < 2; ++kk)  \
    _Pragma("unroll")  \
          for (int j = 0; j < 2; ++j)  \
    _Pragma("unroll")  \
            for (int i = 0; i < 4; ++i) mx = fmaxf(mx, s[qs][kk][j][i]);  \
        mx = fmaxf(mx, __shfl_xor(mx, 16));  \
        mx = fmaxf(mx, __shfl_xor(mx, 32));  \
        mnew = fmaxf(mrow[qs], mx * c1);  \
        alpha = fexp2(mrow[qs] - mnew);  \
        mrow[qs] = mnew;  \
    _Pragma("unroll")  \
        for (int kk = 0; kk < 2; ++kk) {  \
          float pv[8];  \
    _Pragma("unroll")  \
          for (int j = 0; j < 2; ++j)  \
    _Pragma("unroll")  \
            for (int i = 0; i < 4; ++i) {  \
              const float e = fexp2(__builtin_fmaf(s[qs][kk][j][i], c1, -mnew));  \
              pv[j * 4 + i] = e; ps += e;  \
            }  \
          uint4 r4 = make_uint4(pack2(pv[0], pv[1]), pack2(pv[2], pv[3]), pack2(pv[4], pv[5]), pack2(pv[6], pv[7]));  \
          pf[qs][kk] = *(bf16x8*)&r4;  \
        }  \
      } else {  \
    _Pragma("unroll")  \
        for (int kk = 0; kk < 2; ++kk)  \
    _Pragma("unroll")  \
          for (int j = 0; j < 2; ++j)  \
    _Pragma("unroll")  \
            for (int i = 0; i < 4; ++i) {  \
              const int key = (KT_) * 64 + 32 * kk + 8 * lg + 4 * j + i;  \
              float v = s[qs][kk][j][i] * c1 - sl2 * (float)(tq - key);  \
              const bool ok = (key <= tq) && (key > tq - 128);  \
              v = ok ? v : -INFINITY;  \
              s[qs][kk][j][i] = v;  \
              mx = fmaxf(mx, v);  \
            }  \
        mx = fmaxf(mx, __shfl_xor(mx, 16));  \
        mx = fmaxf(mx, __shfl_xor(mx, 32));  \
        mnew = fmaxf(mrow[qs], mx);  \
        alpha = fexp2(mrow[qs] - mnew);  \
        mrow[qs] = mnew;  \
    _Pragma("unroll")  \
        for (int kk = 0; kk < 2; ++kk) {  \
          float pv[8];  \
    _Pragma("unroll")  \
          for (int j = 0; j < 2; ++j)  \
    _Pragma("unroll")  \
            for (int i = 0; i < 4; ++i) {  \
              const float e = fexp2(s[qs][kk][j][i] - mnew);  \
              pv[j * 4 + i] = e; ps += e;  \
            }  \
          uint4 r4 = make_uint4(pack2(pv[0], pv[1]), pack2(pv[2], pv[3]), pack2(pv[4], pv[5]), pack2(pv[6], pv[7]));  \
          pf[qs][kk] = *(bf16x8*)&r4;  \
        }  \
      }  \
      lrow[qs] = lrow[qs] * alpha + ps;  \
    _Pragma("unroll")  \
      for (int jt = 0; jt < 4; ++jt) o[qs][jt] *= alpha;  \
    }  \
    _Pragma("unroll")  \
    for (int jt = 0; jt < 4; ++jt)  \
    _Pragma("unroll")  \
      for (int kk = 0; kk < 2; ++kk) {  \
        const bf16x8 vf = *(const bf16x8*)(Vb + (16 * jt + lr) * 128 + (((4 * kk + lg) ^ vsw) << 4));  \
        o[0][jt] = __builtin_amdgcn_mfma_f32_16x16x32_bf16(vf, pf[0][kk], o[0][jt], 0, 0, 0);  \
        if (NQS > 1) o[NQS - 1][jt] = __builtin_amdgcn_mfma_f32_16x16x32_bf16(vf, pf[NQS - 1][kk], o[NQS - 1][jt], 0, 0, 0);  \
      }  \
  }
  const int fsw = ((lr >> 1) & 1) | ((lr >> 2) << 1);
  const int xh = (lr >> 2) ^ (((lr >> 2) & 1) << 1);
  const int vsw = (lr >> 1) & 7;
  ATT_GLOAD(ra, kt_lo)
  ATT_GLOAD(rb, (kt_lo + 1 <= kt_hi ? kt_lo + 1 : kt_hi))
  ATT_WAIT_OLDER()
  ATT_SWRITE(ra, 0)
  __syncthreads();
  for (int kt = kt_lo; kt <= kt_hi; kt += 2) {
    ATT_GLOAD(ra, (kt + 2 <= kt_hi ? kt + 2 : kt_hi))
    ATT_STEP(kt, 0)
    ATT_WAIT_OLDER()
    ATT_SWRITE(rb, 1)
    __syncthreads();
    if (kt + 1 <= kt_hi) {
      ATT_GLOAD(rb, (kt + 3 <= kt_hi ? kt + 3 : kt_hi))
      ATT_STEP(kt + 1, 1)
      ATT_WAIT_OLDER()
      ATT_SWRITE(ra, 0)
      __syncthreads();
    }
  }
  asm volatile("s_waitcnt vmcnt(0)" ::: "memory");
  asm volatile("" :: "v"(rak0), "v"(rak1), "v"(rav0), "v"(rav1), "v"(rakr), "v"(rbk0), "v"(rbk1), "v"(rbv0), "v"(rbv1), "v"(rbkr));
#pragma unroll
  for (int qs = 0; qs < NQS; ++qs) {
    const int tq = q0 + 16 * NQS * w + 16 * qs + lr;
    float lsum = lrow[qs];
    lsum += __shfl_xor(lsum, 16);
    lsum += __shfl_xor(lsum, 32);
    if (!MLA) lsum += fexp2(sink2 - mrow[qs]);
    const float inv = 1.f / lsum;
    if (tq < TPB) {
      u16* yp = Y + ((size_t)b * TPB + tq) * ldy + head * 64 + 4 * lg;
#pragma unroll
      for (int jt = 0; jt < 4; ++jt) {
        uint2 wv;
        wv.x = pack2(o[qs][jt][0] * inv, o[qs][jt][1] * inv);
        wv.y = pack2(o[qs][jt][2] * inv, o[qs][jt][3] * inv);
        *(uint2*)(yp + 16 * jt) = wv;
      }
    }
  }
}


#define UP_EXP OFF_X
#define UP_TILES 16
#define P9_LO 0
#define P9_HI 129
#ifndef STOP_AFTER
#define STOP_AFTER 0
#endif
__device__ void dump_bf16(const Params& p, const u16* buf, int ld, int coloff, int shift = 0) {
  const int tid_ = otid();
  const int lane = tid_ & 63;
  const int wg = (int)((blockIdx.x + shift) % gridDim.x) * 4 + (tid_ >> 6), nw = gridDim.x * 4;
  for (int m = wg; m < MTOK; m += nw) {
    const int b = m / TPB, t = m - b * TPB;
    if (t < 16) continue;
    float* o = p.out + ((size_t)b * 4096 + (t - 16)) * DM;
    for (int j = 0; j < 16; ++j) o[j * 64 + lane] = bf2f(buf[(size_t)m * ld + coloff + j * 64 + lane]);
  }
}
#define XB_TMO      128
#define XB_XCNT(j)  (256  + 64 * (j))
#define XB_XSUB(j)  (1280 + 64 * (j))
#define XB_XGEN(j)  (2304 + 64 * (j))
#define XB_TOP      3328
#define XB_TOPGEN   3392
#define XCD_BAR_WORDS 3456
#define XB_SPIN_CAP (1u << 22)
#define LAS __attribute__((address_space(3)))
__device__ __forceinline__ unsigned xb_ld(unsigned* p) { return __hip_atomic_load(p, __ATOMIC_RELAXED, __HIP_MEMORY_SCOPE_AGENT); }
__device__ __forceinline__ unsigned xb_add(unsigned* p, unsigned v) { return __hip_atomic_fetch_add(p, v, __ATOMIC_RELAXED, __HIP_MEMORY_SCOPE_AGENT); }
__device__ __forceinline__ unsigned xb_xcc_id() { return (unsigned)__builtin_amdgcn_s_getreg((3 << 11) | 20) & 0xFu; }
#define XB_SPIN(cond, bar) do { unsigned _sp = 0; while (cond) { __builtin_amdgcn_s_sleep(1); \
    if ((++_sp & 255u) == 0u) { if (xb_ld(&(bar)[XB_TMO])) break; if (_sp > XB_SPIN_CAP) { atomicAdd(&(bar)[XB_TMO], 1u); break; } } } } while (0)
struct XcdBarrier { unsigned* bar; unsigned x; volatile unsigned* st; };
__device__ __forceinline__ XcdBarrier xcd_barrier_post(unsigned* bar, volatile unsigned* st) {
  XcdBarrier b; b.bar = bar; b.x = xb_xcc_id(); b.st = st;
  if (threadIdx.x == 0) (void)xb_add(&bar[XB_XCNT(b.x)], 1u);
  return b;
}
__device__ __forceinline__ void xcd_barrier_complete(unsigned* bar, unsigned x, unsigned& nloc, unsigned& nx) {
  const unsigned G = gridDim.x * gridDim.y * gridDim.z;
  unsigned sum, cnt, mine, sp = 0u;
  for (;;) {
    sum = 0u; cnt = 0u; mine = 0u;
#pragma unroll
    for (unsigned j = 0; j < 16; ++j) { const unsigned c = xb_ld(&bar[XB_XCNT(j)]); sum += c; cnt += (c > 0u) ? 1u : 0u; mine = (j == x) ? c : mine; }
    if (sum == G) break;
    __builtin_amdgcn_s_sleep(1);
    if ((++sp & 255u) == 0u) { if (xb_ld(&bar[XB_TMO])) break; if (sp > XB_SPIN_CAP) { atomicAdd(&bar[XB_TMO], 1u); break; } }
  }
  nloc = mine > 0u ? mine : 1u; nx = cnt > 0u ? cnt : 1u;
}
__device__ __attribute__((noinline)) void xcd_barrier_impl(unsigned* bar_, unsigned bx_, volatile unsigned* st_) {
  XcdBarrier b; b.bar = bar_; b.x = bx_; b.st = st_;
  asm volatile("s_waitcnt vmcnt(0)" ::: "memory");
  __syncthreads();
  if (threadIdx.x == 0) {
    unsigned* bar = b.bar;
    __builtin_amdgcn_s_waitcnt(0);
    unsigned nloc = b.st[0], nx = b.st[1];
    if (nloc == 0u) { xcd_barrier_complete(bar, b.x, nloc, nx); b.st[0] = nloc; b.st[1] = nx; }
    const unsigned old = xb_add(&bar[XB_XSUB(b.x)], 1u);
    const unsigned gen = old / nloc;
    if (old + 1u == (gen + 1u) * nloc) {
      __builtin_amdgcn_fence(__ATOMIC_RELEASE, "agent");
      asm volatile("s_waitcnt vmcnt(0)" ::: "memory");
      const unsigned og = xb_add(&bar[XB_TOP], 1u);
      const unsigned tg = og / nx;
      if (og + 1u == (tg + 1u) * nx) xb_add(&bar[XB_TOPGEN], 1u);
      else XB_SPIN(xb_ld(&bar[XB_TOPGEN]) == tg, bar);
      __builtin_amdgcn_fence(__ATOMIC_ACQUIRE, "agent");
      xb_add(&bar[XB_XGEN(b.x)], 1u);
      asm volatile("s_waitcnt vmcnt(0)" ::: "memory");
    } else {
      XB_SPIN(xb_ld(&bar[XB_XGEN(b.x)]) == gen, bar);
      __builtin_amdgcn_fence(__ATOMIC_ACQUIRE, "agent");
      asm volatile("s_waitcnt vmcnt(0)" ::: "memory");
    }
  }
  __syncthreads();
}
#define GSYNC() xcd_barrier_impl(xb.bar, xb.x, xb.st)
__global__ void __launch_bounds__(256, 2) hymba_megakernel(Params p, int ph_lo, int ph_hi) {
  cg::grid_group grid = cg::this_grid();
  __shared__ __attribute__((aligned(16))) char lds[65536];
  char* ws = p.ws;
  u16* abuf = (u16*)(ws + OFF_ABUF);
  u16* obuf = (u16*)(ws + OFF_OBUF);
  XcdBarrier xb; xb.bar = (unsigned*)(p.ws + OFF_BAR); xb.x = 0;
  xb.st = (volatile unsigned*)(p.ws + OFF_BAR) + 4096 + 2 * blockIdx.x;
  const bool fused = (ph_hi - ph_lo) > 1;
  if (fused) {
    xb = xcd_barrier_post((unsigned*)(p.ws + OFF_BAR), xb.st);
    grid.sync();
  }
  unsigned long long* tsp = (unsigned long long*)(p.ws + OFF_BAR + 24576);
  if (TIMING && blockIdx.x == 0 && threadIdx.x == 0) tsp[0] = __builtin_amdgcn_s_memrealtime();
  int pi = 0;
#define RUN (pi >= ph_lo && pi < ph_hi)
#define END_PHASE() do { if (pi >= ph_lo && pi + 1 < ph_hi) GSYNC(); if (TIMING && blockIdx.x == 0 && threadIdx.x == 0) tsp[pi + 1] = __builtin_amdgcn_s_memrealtime(); ++pi; } while (0)
  if (RUN && (PH & 1)) phase_convert(p, lds);
  if (RUN && (PH & 2)) phase_tables(p);
  if (RUN && (PH & 4)) phase_rows<0>(p, nullptr, p.g_pre_mix, true);
  END_PHASE();

  for (int l = 0; l < 2; ++l) {
    char* wb = ws + OFF_W + (size_t)l * W_LAYER;
    if (RUN && (PH & 8)) {
      EpiProjS e{(u16*)(ws + OX_PROJ), INW, (u16*)(ws + OX_VTS)};
      gemm_phase(abuf, DM, (const u16*)(wb + OW_IN), DM, INW, DM, lds, e, 0);
    }
    END_PHASE();
    if (STOP_AFTER == 1) { dump_bf16(p, (const u16*)(ws + OX_PROJ), INW, 0); return; }
    if (RUN && (PH & 32)) phase_ssm_a(p, l, lds);
    if (RUN && (PH & 64)) phase_mla_prep(p, l);
    END_PHASE();
    if (RUN && (PH & 128)) phase_ssm_c(p, l, lds);
    END_PHASE();
    if (RUN && (PH & 16)) for (int it = blockIdx.x; it < 4 * 8 * 33; it += gridDim.x) {
      const int qt = it / 32, r = it - qt * 32;
      attn_item<false, 2>(p, l, r >> 3, r & 7, qt, lds);
    }
    if (RUN && (PH & 256)) {
      EpiBf16 e{(u16*)(ws + OX_QMLA), 384, 384};
      gemm_phase((const u16*)(ws + OX_QN), 192, (const u16*)(wb + OW_UQ), 192, 384, 192, lds, e, 64);
    }
    if (RUN && (PH & 512)) {
      EpiKV e{nullptr, 0, (u16*)(ws + OX_KN), (u16*)(ws + OX_VTM)};
      gemm_phase((const u16*)(ws + OX_CN), 128, (const u16*)(wb + OW_UKV), 128, 512, 128, lds, e, 200);
    }
    END_PHASE();
    if (RUN && (PH & 1024)) {
      unsigned* ticket = (unsigned*)(ws + OFF_BAR) + 3600 + l;
      __shared__ int s_item;
      for (;;) {
        __syncthreads();
        if (threadIdx.x == 0) s_item = (int)atomicAdd(ticket, 1u);
        __syncthreads();
        const int it = s_item;
        if (it >= 4 * 4 * 65) break;
        const int qt = 64 - it / 16, r = it & 15;
        attn_item<true, 1>(p, l, r >> 2, r & 3, qt, lds);
      }
    }
    if (RUN && (PH & 2048)) {
      EpiGlu e{nullptr, 0, (const u16*)(ws + OX_Z), p.b_glu + (size_t)l * 256, (u16*)(ws + OX_YSSM)};
      gemm_phase((const u16*)(ws + OX_Z), 256, (const u16*)(wb + OW_GLU), 256, 256, 256, lds, e, 16);
    }
    END_PHASE();
    if (RUN && (PH & 4096)) phase_headnorm(p, l);
    END_PHASE();
    if (STOP_AFTER == 5) { dump_bf16(p, abuf, DM, 0); return; }
    if (RUN && (PH & 8192)) {
      EpiBf16 e{obuf, DM, DM};
      gemm_phase(abuf, DM, (const u16*)(wb + OW_OUT), DM, DM, DM, lds, e, 0);
    }
    END_PHASE();
    if (RUN && (PH & 16384)) {
      if (l == 0) phase_rows<2>(p, p.g_post_mix + (size_t)l * DM, p.g_pre_mlp + (size_t)l * DM, true);
      else phase_rows<1>(p, p.g_post_mix + (size_t)l * DM, p.g_pre_mlp + (size_t)l * DM, true);
    }
    END_PHASE();
    if (STOP_AFTER == 7) { dump_bf16(p, abuf, DM, 0); return; }
    if (RUN && (PH & 32768)) {
      EpiRelu2 e{(u16*)(ws + OFF_X), UPLD};
      gemm_phase(abuf, DM, (const u16*)(wb + OW_UP), DM, DFF, DM, lds, e, 0);
    }
    END_PHASE();
    if (RUN && (PH & 65536)) {
      EpiBf16 e{obuf, DM, DM};
      const u16* upA = (const u16*)(ws + OFF_X);
      const u16* wdn = (const u16*)(wb + OW_DN);
      const bool xmap = (gridDim.x & 7) == 0;
      const int xq = blockIdx.x & 7, xl = blockIdx.x >> 3, xn = gridDim.x >> 3;
      for (int item = blockIdx.x; item < 1024 + 64; item += gridDim.x) {
        if (item < 1024) {
          int tm = item >> 3, tn = item & 7;
          if (xmap) {
            const int r = item / gridDim.x;
            const int idx = xl + r * xn;
            if (idx < 128 && xn * ((1024 + gridDim.x - 1) / gridDim.x) >= 128) { tm = 2 * (idx >> 1) + (xq >> 2); tn = 2 * (xq & 3) + (idx & 1); }
          }
          gemm_tile(upA, UPLD, MTOK, wdn, DFF, DM, DFF, tm * 128, tn * 128, lds, e);
        } else {
          const int i2 = item - 1024, tn = i2 & 7, ks = i2 >> 3;
          EpiPart ep{(float*)(ws + OFF_PART) + (size_t)ks * 64 * 1024, nullptr, 0};
          gemm_tile(upA + ks * 512, UPLD, MTOK, wdn + ks * 512, DFF, DM, 512, 16384, tn * 128, lds, ep);
        }
      }
    }
    END_PHASE();
    if (STOP_AFTER == 9) { dump_bf16(p, obuf, DM, 0, 3); return; }
    if (RUN && (PH & 131072)) phase_rows<1>(p, p.g_post_mlp + (size_t)l * DM, p.g_pre_mix + (size_t)(l < 1 ? l + 1 : l) * DM, l < 1, (const float*)(ws + OFF_PART));
    if (l < 1) END_PHASE();
  }
  if (TIMING) {
    END_PHASE();
    if (blockIdx.x == 0) {
      __shared__ int n_pert;
      if (threadIdx.x == 0) {
        const float tot = (float)(tsp[pi] - tsp[0]);
        const float f1 = (float)(tsp[T1_HI] - tsp[T1_LO]) / tot;
        const float f2 = (float)(tsp[T2_HI] - tsp[T2_LO]) / tot;
        n_pert = (int)(f1 * 500000.f);
        p.out[0] += 0.2f + 0.15f * f2;
      }
      __syncthreads();
      for (int i = threadIdx.x; i < n_pert; i += 256) p.out[4096 + i] += 0.1f;
    }
  }
}

extern "C" void kernel_launch(void* const* d_in, const int* in_sizes, int n_in, void* d_out, int out_size, void* d_ws,
                              size_t ws_size, hipStream_t stream) {
  static int grid_blocks = 0;
  if (!grid_blocks) {
    int dev = 0, cus = 0, per_cu = 0;
    hipGetDevice(&dev);
    hipDeviceGetAttribute(&cus, hipDeviceAttributeMultiprocessorCount, dev);
    hipOccupancyMaxActiveBlocksPerMultiprocessor(&per_cu, hymba_megakernel, 256, 0);
    if (per_cu > 2) per_cu = 2;
    if (per_cu < 1) per_cu = 1;
    grid_blocks = cus * per_cu;
  }
  Params p{};
  const float** f = (const float**)&p;
  for (int i = 0; i < 27; ++i) f[i] = (const float*)d_in[i];
  p.out = (float*)d_out;
  p.ws = (char*)d_ws;
  hipMemsetAsync((char*)d_ws + OFF_BAR, 0, 32768, stream);
#ifndef N_LAUNCH_MODE
#define N_LAUNCH_MODE 1
#endif
  if (N_LAUNCH_MODE == 1) {
    int lo = 0, hi = 23 + (TIMING ? 1 : 0);
    void* args[] = {&p, &lo, &hi};
    hipError_t e = hipLaunchCooperativeKernel((void*)hymba_megakernel, dim3(grid_blocks), dim3(256), args, 0, stream);
    if (e != hipSuccess) fprintf(stderr, "cooperative launch failed: %s (grid %d)\n", hipGetErrorString(e), grid_blocks);
  } else {
    for (int i = 0; i < 23; ++i) hipLaunchKernelGGL(hymba_megakernel, dim3(grid_blocks), dim3(256), 0, stream, p, i, i + 1);
  }
}
```

```cpp
#include <hip/hip_runtime.h>
#include <hip/hip_cooperative_groups.h>
#include <cstdio>
#include <cstdint>
namespace cg = cooperative_groups;

typedef unsigned short u16;
using bf16x8 = __attribute__((ext_vector_type(8))) short;
using f32x4 = __attribute__((ext_vector_type(4))) float;

#define TPB 4112
#define MTOK 16448
#define MPAD 16512
#define DM 1024
#define INW 1376
#define DFF 4096
#define LT 4160
#define NCH 65
#ifndef PH
#define PH 0x3ffff
#endif
#ifndef TIMING
#define TIMING 0
#endif
#define T1_LO 6
#define T1_HI 9
#define T2_LO 0
#define T2_HI 1

constexpr size_t al256(size_t x) { return (x + 255) & ~(size_t)255; }
constexpr size_t cmax(size_t a, size_t b) { return a > b ? a : b; }
constexpr size_t OW_IN = 0;
constexpr size_t OW_OUT = OW_IN + (size_t)INW * DM * 2;
constexpr size_t OW_UP = OW_OUT + (size_t)DM * DM * 2;
constexpr size_t OW_DN = OW_UP + (size_t)DFF * DM * 2;
constexpr size_t OW_UQ = OW_DN + (size_t)DFF * DM * 2;
constexpr size_t OW_UKV = OW_UQ + (size_t)384 * 192 * 2;
constexpr size_t OW_GLU = OW_UKV + (size_t)512 * 128 * 2;
constexpr size_t W_LAYER = OW_GLU + (size_t)256 * 256 * 2;
constexpr size_t OFF_W = 0;
constexpr size_t OFF_ROPE = OFF_W + 2 * W_LAYER;
constexpr size_t OFF_LAM = OFF_ROPE + al256((size_t)TPB * 16 * 8);
constexpr size_t OFF_LAMT = OFF_LAM + 2 * 16 * 64 * 8;
constexpr size_t OFF_BB = OFF_LAMT + 2 * 16 * 64 * 8;
constexpr size_t OFF_BAR = OFF_BB + 2 * 16 * 32 * 64 * 4;
constexpr size_t OFF_HMETA = OFF_BAR + 32768;
constexpr size_t OFF_ABUF = OFF_HMETA + 4 * 16 * 1024 * 4;
constexpr size_t OFF_OBUF = OFF_ABUF + (size_t)MPAD * DM * 2;
constexpr size_t OFF_X = OFF_OBUF + (size_t)MPAD * DM * 2;
constexpr size_t OX_PROJ = OFF_X;
constexpr size_t OX_Z = OX_PROJ + (size_t)MPAD * INW * 2;
constexpr size_t OX_YSSM = OX_Z + (size_t)MPAD * 256 * 2;
constexpr size_t OX_YSWA = OX_YSSM + (size_t)MPAD * 256 * 2;
constexpr size_t OX_YMLA = OX_YSWA + (size_t)MPAD * 512 * 2;
constexpr size_t OX_QN = OX_YMLA + (size_t)MPAD * 256 * 2;
constexpr size_t OX_CN = OX_QN + (size_t)MPAD * 192 * 2;
constexpr size_t OX_KR = OX_CN + (size_t)MPAD * 128 * 2;
constexpr size_t OX_QMLA = OX_KR + (size_t)MPAD * 32 * 2;
constexpr size_t OX_KN = OX_QMLA + (size_t)MPAD * 384 * 2;
constexpr size_t OX_VTM = OX_KN + (size_t)MPAD * 256 * 2;
constexpr size_t OX_VTS = OX_VTM + (size_t)4 * 4 * 64 * LT * 2;
constexpr size_t OX_END = OX_VTS + (size_t)4 * 2 * 64 * LT * 2;
constexpr size_t OX_LAST = OX_END + (size_t)4 * 16 * NCH * 64 * 8;
#define UPLD 4160
constexpr size_t OFF_END2 = cmax(OX_LAST, OFF_X + (size_t)MPAD * UPLD * 2);
constexpr size_t END_BYTES = (size_t)4 * 16 * NCH * 64 * 8;
constexpr size_t OFF_PART = OFF_END2 + 2 * END_BYTES;
constexpr size_t WS_TOTAL = OFF_PART + (size_t)8 * 64 * 1024 * 4;
static_assert(WS_TOTAL <= (size_t)256 * 1024 * 1024, "workspace too large");

struct Params {
  const float* x; const float* meta; const float* g_pre_mix; const float* g_post_mix; const float* g_pre_mlp;
  const float* g_post_mlp; const float* w_in; const float* w_out; const float* g_heads; const float* a_re;
  const float* a_im; const float* log_step; const float* b_re; const float* b_im; const float* c_re; const float* c_im;
  const float* d_skip; const float* w_glu; const float* b_glu; const float* sinks; const float* g_q; const float* g_kv;
  const float* w_uq; const float* w_uk; const float* w_uv; const float* w_up; const float* w_down;
  float* out; char* ws;
};

__device__ __forceinline__ unsigned pack2(float a, float b) {
  unsigned r;
  asm("v_cvt_pk_bf16_f32 %0, %1, %2" : "=v"(r) : "v"(a), "v"(b));
  return r;
}
__device__ __forceinline__ u16 f2bf(float f) { return (u16)(pack2(f, f) & 0xffffu); }
__device__ __forceinline__ float bf2f(u16 h) { return __uint_as_float(((unsigned)h) << 16); }
__device__ __forceinline__ float bflo(unsigned u) { return __uint_as_float(u << 16); }
__device__ __forceinline__ float bfhi(unsigned u) { return __uint_as_float(u & 0xffff0000u); }
__device__ __forceinline__ float wave_sum(float v) {
#pragma unroll
  for (int o = 32; o; o >>= 1) v += __shfl_xor(v, o);
  return v;
}
__device__ __forceinline__ float fexp2(float x) { return __builtin_amdgcn_exp2f(x); }
__device__ __forceinline__ int otid() { int t = threadIdx.x; asm volatile("" : "+v"(t)); return t; }

struct Mat { const float* src; u16* dst; int K, N; };
__device__ __forceinline__ Mat get_mat(const Params& p, int idx) {
  int l = idx >> 3, t = idx & 7;
  char* wb = p.ws + OFF_W + (size_t)l * W_LAYER;
  Mat m;
  if (t == 0) { m.src = p.w_in + (size_t)l * DM * INW; m.dst = (u16*)(wb + OW_IN); m.K = DM; m.N = INW; }
  else if (t == 1) { m.src = p.w_out + (size_t)l * DM * DM; m.dst = (u16*)(wb + OW_OUT); m.K = DM; m.N = DM; }
  else if (t == 2) { m.src = p.w_up + (size_t)l * DM * DFF; m.dst = (u16*)(wb + OW_UP); m.K = DM; m.N = DFF; }
  else if (t == 3) { m.src = p.w_down + (size_t)l * DFF * DM; m.dst = (u16*)(wb + OW_DN); m.K = DFF; m.N = DM; }
  else if (t == 4) { m.src = p.w_uq + (size_t)l * 192 * 384; m.dst = (u16*)(wb + OW_UQ); m.K = 192; m.N = 384; }
  else if (t == 5) { m.src = p.w_uk + (size_t)l * 128 * 256; m.dst = (u16*)(wb + OW_UKV); m.K = 128; m.N = 256; }
  else if (t == 6) { m.src = p.w_uv + (size_t)l * 128 * 256; m.dst = (u16*)(wb + OW_UKV) + 256 * 128; m.K = 128; m.N = 256; }
  else { m.src = p.w_glu + (size_t)l * 256 * 256; m.dst = (u16*)(wb + OW_GLU); m.K = 256; m.N = 256; }
  return m;
}

__device__ void phase_convert(const Params& p, char* lds) {
  float* tl = (float*)lds;
  const int tid = otid();
  int base = 0;
  for (int mi = 0; mi < 16; ++mi) {
    Mat mt = get_mat(p, mi);
    const int tn = mt.N >> 5, tk = mt.K >> 6, nt = tn * tk;
    int first = (int)(((long)blockIdx.x - base) % (long)gridDim.x);
    if (first < 0) first += gridDim.x;
    for (int i = first; i < nt; i += gridDim.x) {
      const int kt = i / tn, ntile = i - kt * tn;
      const int k0 = kt * 64, n0 = ntile * 32;
      {
        const int r = tid >> 3, c4 = (tid & 7) * 4;
#pragma unroll
        for (int j = 0; j < 2; ++j) {
          float4 v = *(const float4*)(mt.src + (size_t)(k0 + r + 32 * j) * mt.N + n0 + c4);
          float* d = tl + (r + 32 * j) * 33 + c4;
          d[0] = v.x; d[1] = v.y; d[2] = v.z; d[3] = v.w;
        }
      }
      __syncthreads();
      {
        const int n = tid >> 3, kc = (tid & 7) * 8;
        unsigned w[4];
#pragma unroll
        for (int e = 0; e < 4; ++e) w[e] = pack2(tl[(kc + 2 * e) * 33 + n], tl[(kc + 2 * e + 1) * 33 + n]);
        *(uint4*)(mt.dst + (size_t)(n0 + n) * mt.K + k0 + kc) = make_uint4(w[0], w[1], w[2], w[3]);
      }
      __syncthreads();
    }
    base += nt;
  }
}

__device__ void phase_tables(const Params& p) {
  const int gt = blockIdx.x * 256 + otid(), nthr = gridDim.x * 256;
  float2* rope = (float2*)(p.ws + OFF_ROPE);
  for (int i = gt; i < TPB * 16; i += nthr) {
    int t = i >> 4, f = i & 15;
    float inv = powf(10000.f, -(float)f / 16.f);
    float ang = (float)t * inv;
    double rev = (double)ang * 0.15915494309189535;
    rev -= rint(rev);
    float fr = (float)rev;
    rope[i] = make_float2(__builtin_amdgcn_cosf(fr), __builtin_amdgcn_sinf(fr));
  }
  float2* lam = (float2*)(p.ws + OFF_LAM);
  float2* lamT = (float2*)(p.ws + OFF_LAMT);
  float* bb = (float*)(p.ws + OFF_BB);
  for (int i = gt; i < 2 * 16 * 64; i += nthr) {
    int lg = i >> 6, s = i & 63;
    float step = expf(p.log_step[lg]);
    float ar = p.a_re[i], ai = p.a_im[i];
    float mag = expf(ar * step);
    float th = ai * step;
    float lr = mag * cosf(th), li = mag * sinf(th);
    lam[i] = make_float2(lr, li);
    float pr = lr, pi = li;
#pragma unroll
    for (int q = 0; q < 6; ++q) { float nr2 = pr * pr - pi * pi, ni2 = 2.f * pr * pi; pr = nr2; pi = ni2; }
    lamT[i] = make_float2(pr, pi);
    float den = ar * ar + ai * ai;
    float nr = lr - 1.f, ni = li;
    float cr = (nr * ar + ni * ai) / den, ci = (ni * ar - nr * ai) / den;
    const float* brp = p.b_re + (size_t)i * 16;
    const float* bip = p.b_im + (size_t)i * 16;
#pragma unroll
    for (int c = 0; c < 16; ++c) {
      float br = brp[c], bi = bip[c];
      bb[((size_t)lg * 32 + 2 * c) * 64 + s] = cr * br - ci * bi;
      bb[((size_t)lg * 32 + 2 * c + 1) * 64 + s] = cr * bi + ci * br;
    }
  }
}

__device__ __forceinline__ float* h_row(const Params& p, int m) {
  const int b = m / TPB, t = m - b * TPB;
  return t < 16 ? (float*)(p.ws + OFF_HMETA) + (size_t)(b * 16 + t) * DM : p.out + ((size_t)b * 4096 + (t - 16)) * DM;
}
template <int MODE>
__device__ void phase_rows(const Params& p, const float* gpost, const float* gnext, bool has_next, const float* part = nullptr) {
  const int tid_ = otid();
  const int lane = tid_ & 63;
  const int wg = blockIdx.x * 4 + (tid_ >> 6), nw = gridDim.x * 4;
  u16* abuf = (u16*)(p.ws + OFF_ABUF);
  const u16* obuf = (const u16*)(p.ws + OFF_OBUF);
  for (int mb = wg; mb < MTOK; mb += 2 * nw) {
    int mr[2]; bool ok[2]; float* hr[2];
    float4 v[2][4]; uint2 ob[2][4];
#pragma unroll
    for (int r = 0; r < 2; ++r) {
      mr[r] = mb + r * nw; ok[r] = mr[r] < MTOK;
      const int mm = ok[r] ? mr[r] : mb;
      hr[r] = h_row(p, mm);
      if (MODE == 0) {
        const int b = mm / TPB, t = mm - b * TPB;
        const float* src = t < 16 ? p.meta + (size_t)t * DM : p.x + ((size_t)b * 4096 + (t - 16)) * DM;
#pragma unroll
        for (int j = 0; j < 4; ++j) v[r][j] = *(const float4*)(src + j * 256 + lane * 4);
      } else {
        const float* hsrc = hr[r];
        if (MODE == 2) {
          const int b2 = mm / TPB, t2 = mm - b2 * TPB;
          hsrc = t2 < 16 ? p.meta + (size_t)t2 * DM : p.x + ((size_t)b2 * 4096 + (t2 - 16)) * DM;
        }
#pragma unroll
        for (int j = 0; j < 4; ++j) {
          ob[r][j] = *(const uint2*)(obuf + (size_t)mm * DM + j * 256 + lane * 4);
          v[r][j] = *(const float4*)(hsrc + j * 256 + lane * 4);
        }
        if (part != nullptr && mm >= 16384) {
#pragma unroll
          for (int j = 0; j < 4; ++j) {
            float4 a = make_float4(0.f, 0.f, 0.f, 0.f);
#pragma unroll
            for (int ks = 0; ks < 8; ++ks) {
              const float4 q = *(const float4*)(part + ((size_t)ks * 64 + (mm - 16384)) * 1024 + j * 256 + lane * 4);
              a.x += q.x; a.y += q.y; a.z += q.z; a.w += q.w;
            }
            ob[r][j].x = pack2(a.x, a.y); ob[r][j].y = pack2(a.z, a.w);
          }
        }
      }
    }
#pragma unroll
    for (int r = 0; r < 2; ++r) {
      if (MODE >= 1) {
        float4 o[4];
        float ss = 0.f;
#pragma unroll
        for (int j = 0; j < 4; ++j) {
          o[j] = make_float4(bflo(ob[r][j].x), bfhi(ob[r][j].x), bflo(ob[r][j].y), bfhi(ob[r][j].y));
          ss += o[j].x * o[j].x + o[j].y * o[j].y + o[j].z * o[j].z + o[j].w * o[j].w;
        }
        ss = wave_sum(ss);
        const float rs = rsqrtf(ss * (1.f / 1024.f) + 1e-6f);
#pragma unroll
        for (int j = 0; j < 4; ++j) {
          const float4 hv = v[r][j];
          const float4 g = *(const float4*)(gpost + j * 256 + lane * 4);
          v[r][j] = make_float4(hv.x + o[j].x * rs * g.x, hv.y + o[j].y * rs * g.y, hv.z + o[j].z * rs * g.z,
                                hv.w + o[j].w * rs * g.w);
        }
      }
      if (MODE != 0 && ok[r]) {
#pragma unroll
        for (int j = 0; j < 4; ++j) *(float4*)(hr[r] + j * 256 + lane * 4) = v[r][j];
      }
      if (has_next) {
        float ss = 0.f;
#pragma unroll
        for (int j = 0; j < 4; ++j)
          ss += v[r][j].x * v[r][j].x + v[r][j].y * v[r][j].y + v[r][j].z * v[r][j].z + v[r][j].w * v[r][j].w;
        ss = wave_sum(ss);
        const float rs = rsqrtf(ss * (1.f / 1024.f) + 1e-6f);
        if (ok[r]) {
#pragma unroll
          for (int j = 0; j < 4; ++j) {
            const float4 g = *(const float4*)(gnext + j * 256 + lane * 4);
            uint2 w;
            w.x = pack2(v[r][j].x * rs * g.x, v[r][j].y * rs * g.y);
            w.y = pack2(v[r][j].z * rs * g.z, v[r][j].w * rs * g.w);
            *(uint2*)(abuf + (size_t)mr[r] * DM + j * 256 + lane * 4) = w;
          }
        }
      }
    }
  }
}

__device__ void phase_headnorm(const Params& p, int l) {
  const int tid_ = otid();
  const int lane = tid_ & 63;
  const int wg = blockIdx.x * 4 + (tid_ >> 6), nw = gridDim.x * 4;
  u16* abuf = (u16*)(p.ws + OFF_ABUF);
  const u16* yssm = (const u16*)(p.ws + OX_YSSM);
  const u16* yswa = (const u16*)(p.ws + OX_YSWA);
  const u16* ymla = (const u16*)(p.ws + OX_YMLA);
  const float* gh = p.g_heads + (size_t)l * 1024;
  const float4 g1 = *(const float4*)(gh + lane * 4);
  const float4 g2a = *(const float4*)(gh + 256 + lane * 8);
  const float4 g2b = *(const float4*)(gh + 256 + lane * 8 + 4);
  const float4 g3 = *(const float4*)(gh + 768 + lane * 4);
  for (int mb = wg; mb < MTOK; mb += 2 * nw) {
    uint2 ar[2]; uint4 sr[2]; uint2 cr[2]; int mrow[2]; bool ok[2];
#pragma unroll
    for (int r = 0; r < 2; ++r) {
      mrow[r] = mb + r * nw; ok[r] = mrow[r] < MTOK;
      const int m = ok[r] ? mrow[r] : mb;
      ar[r] = *(const uint2*)(yssm + (size_t)m * 256 + lane * 4);
      sr[r] = *(const uint4*)(yswa + (size_t)m * 512 + lane * 8);
      cr[r] = *(const uint2*)(ymla + (size_t)m * 256 + lane * 4);
    }
#pragma unroll
    for (int r = 0; r < 2; ++r) {
      const uint2 a = ar[r]; const uint4 s = sr[r]; const uint2 c = cr[r];
      float av[4] = {bflo(a.x), bfhi(a.x), bflo(a.y), bfhi(a.y)};
      float sv[8] = {bflo(s.x), bfhi(s.x), bflo(s.y), bfhi(s.y), bflo(s.z), bfhi(s.z), bflo(s.w), bfhi(s.w)};
      float cv[4] = {bflo(c.x), bfhi(c.x), bflo(c.y), bfhi(c.y)};
      float s1 = 0.f, s2 = 0.f, s3 = 0.f;
#pragma unroll
      for (int e = 0; e < 4; ++e) { s1 += av[e] * av[e]; s3 += cv[e] * cv[e]; }
#pragma unroll
      for (int e = 0; e < 8; ++e) s2 += sv[e] * sv[e];
      s1 = wave_sum(s1); s2 = wave_sum(s2); s3 = wave_sum(s3);
      const float r1 = rsqrtf(s1 * (1.f / 256.f) + 1e-6f);
      const float r2 = rsqrtf(s2 * (1.f / 512.f) + 1e-6f);
      const float r3 = rsqrtf(s3 * (1.f / 256.f) + 1e-6f);
      if (ok[r]) {
        u16* dst = abuf + (size_t)mrow[r] * DM;
        uint2 w1; w1.x = pack2(av[0] * r1 * g1.x, av[1] * r1 * g1.y); w1.y = pack2(av[2] * r1 * g1.z, av[3] * r1 * g1.w);
        *(uint2*)(dst + lane * 4) = w1;
        uint4 w2;
        w2.x = pack2(sv[0] * r2 * g2a.x, sv[1] * r2 * g2a.y); w2.y = pack2(sv[2] * r2 * g2a.z, sv[3] * r2 * g2a.w);
        w2.z = pack2(sv[4] * r2 * g2b.x, sv[5] * r2 * g2b.y); w2.w = pack2(sv[6] * r2 * g2b.z, sv[7] * r2 * g2b.w);
        *(uint4*)(dst + 256 + lane * 8) = w2;
        uint2 w3; w3.x = pack2(cv[0] * r3 * g3.x, cv[1] * r3 * g3.y); w3.y = pack2(cv[2] * r3 * g3.z, cv[3] * r3 * g3.w);
        *(uint2*)(dst + 768 + lane * 4) = w3;
      }
    }
  }
}

__device__ void phase_mla_prep(const Params& p, int l) {
  const int tid_ = otid();
  const int lane = tid_ & 63;
  const int wg = blockIdx.x * 4 + (tid_ >> 6), nw = gridDim.x * 4;
  const u16* proj = (const u16*)(p.ws + OX_PROJ);
  u16* qn = (u16*)(p.ws + OX_QN);
  u16* cn = (u16*)(p.ws + OX_CN);
  u16* kr = (u16*)(p.ws + OX_KR);
  const float2* rope = (const float2*)(p.ws + OFF_ROPE);
  const float* gq = p.g_q + (size_t)l * 192;
  const float* gkv = p.g_kv + (size_t)l * 128;
  const int role = lane < 24 ? 0 : (lane < 40 ? 1 : (lane < 44 ? 2 : 3));
  const int eoff = role == 0 ? 1024 + lane * 8 : (role == 1 ? 1216 + (lane - 24) * 8 : (role == 2 ? 1344 + (lane - 40) * 8 : 1024));
  float gv[8];
#pragma unroll
  for (int e = 0; e < 8; ++e) gv[e] = role == 0 ? gq[lane * 8 + e] : (role == 1 ? gkv[(lane - 24) * 8 + e] : 0.f);
  for (int mb = wg; mb < MTOK; mb += 2 * nw) {
    uint4 raw[2]; int mrow[2]; bool ok[2];
#pragma unroll
    for (int r = 0; r < 2; ++r) {
      mrow[r] = mb + r * nw; ok[r] = mrow[r] < MTOK;
      const int m = ok[r] ? mrow[r] : mb;
      raw[r] = *(const uint4*)(proj + (size_t)m * INW + eoff);
    }
#pragma unroll
    for (int r = 0; r < 2; ++r) {
      const int m = ok[r] ? mrow[r] : mb;
      const int bb = m / TPB, t = m - bb * TPB;
      const unsigned wv[4] = {raw[r].x, raw[r].y, raw[r].z, raw[r].w};
      float v[8];
#pragma unroll
      for (int e = 0; e < 4; ++e) { v[2 * e] = bflo(wv[e]); v[2 * e + 1] = bfhi(wv[e]); }
      float ss = 0.f;
#pragma unroll
      for (int e = 0; e < 8; ++e) ss += v[e] * v[e];
      const float sq = wave_sum(role == 0 ? ss : 0.f);
      const float sc = wave_sum(role == 1 ? ss : 0.f);
      const float rq = rsqrtf(sq * (1.f / 192.f) + 1e-6f);
      const float rc = rsqrtf(sc * (1.f / 128.f) + 1e-6f);
      unsigned pw[4];
#pragma unroll
      for (int e = 0; e < 4; ++e) pw[e] = (unsigned)__shfl((int)wv[e], lane ^ 2);
      uint4 outv;
      if (role == 2) {
        const int i0 = ((lane - 40) & 1) * 8;
        const bool first = lane < 42;
        unsigned ow[4];
#pragma unroll
        for (int e = 0; e < 4; ++e) {
          const float2 ca = rope[t * 16 + i0 + 2 * e], cb = rope[t * 16 + i0 + 2 * e + 1];
          const float pa = bflo(pw[e]), pb = bfhi(pw[e]);
          float ra, rb;
          if (first) { ra = v[2 * e] * ca.x - pa * ca.y; rb = v[2 * e + 1] * cb.x - pb * cb.y; }
          else { ra = pa * ca.y + v[2 * e] * ca.x; rb = pb * cb.y + v[2 * e + 1] * cb.x; }
          ow[e] = pack2(ra, rb);
        }
        outv = make_uint4(ow[0], ow[1], ow[2], ow[3]);
      } else {
        const float rs = role == 0 ? rq : rc;
        outv = make_uint4(pack2(v[0] * rs * gv[0], v[1] * rs * gv[1]), pack2(v[2] * rs * gv[2], v[3] * rs * gv[3]),
                          pack2(v[4] * rs * gv[4], v[5] * rs * gv[5]), pack2(v[6] * rs * gv[6], v[7] * rs * gv[7]));
      }
      if (ok[r]) {
        if (role == 0) *(uint4*)(qn + (size_t)m * 192 + lane * 8) = outv;
        else if (role == 1) *(uint4*)(cn + (size_t)m * 128 + (lane - 24) * 8) = outv;
        else if (role == 2) *(uint4*)(kr + (size_t)m * 32 + (lane - 40) * 8) = outv;
      }
    }
  }
}

template <class Epi>
__device__ __forceinline__ void gemm_tile(const u16* __restrict__ A, int lda, int Mrows, const u16* __restrict__ Bt,
                                          int ldb, int Nrows, int K, int m0, int n0, char* lds, Epi& epi) {
  const int tid = otid(), lane = tid & 63, wid = tid >> 6, wm = wid >> 1, wn = wid & 1;
  const int lr = lane & 15, lg = lane >> 4;
  const int lrow = tid >> 3, lkc = tid & 7;
  const int wsw = (lrow >> 1) & 7;
  const u16* ap[4];
  const u16* bp[4];
#pragma unroll
  for (int j = 0; j < 4; ++j) {
    int ra = m0 + lrow + 32 * j; ra = ra < Mrows ? ra : Mrows - 1;
    int rb = n0 + lrow + 32 * j; rb = rb < Nrows ? rb : Nrows - 1;
    ap[j] = A + (size_t)ra * lda + lkc * 8;
    bp[j] = Bt + (size_t)rb * ldb + lkc * 8;
  }
  f32x4 acc[4][4];
#pragma unroll
  for (int i = 0; i < 4; ++i)
#pragma unroll
    for (int j = 0; j < 4; ++j) acc[i][j] = (f32x4){0.f, 0.f, 0.f, 0.f};
  typedef unsigned u32x4 __attribute__((ext_vector_type(4)));
  u32x4 a0[4], b0[4], a1[4], b1[4];
  const int nk = K >> 6;
  const int rsw = (lr >> 1) & 7;
  const int woff = lrow * 128 + ((lkc ^ wsw) << 4);
#define GEMM_ISSUE(SA, SB, KT)                                                                     \
  {                                                                                                \
    const int kn_ = ((KT) < nk) ? (KT) : nk - 1;                                                   \
    _Pragma("unroll") for (int j = 0; j < 4; ++j) {                                                \
      const u16* pa_ = ap[j] + kn_ * 64;                                                           \
      const u16* pb_ = bp[j] + kn_ * 64;                                                           \
      asm volatile("global_load_dwordx4 %0, %1, off" : "=&v"(SA[j]) : "v"(pa_) : "memory");        \
      asm volatile("global_load_dwordx4 %0, %1, off" : "=&v"(SB[j]) : "v"(pb_) : "memory");        \
    }                                                                                              \
  }
#define GEMM_WRITE(SA, SB, BUF)                                                                    \
  {                                                                                                \
    char* da_ = lds + (BUF) * 32768 + woff;                                                        \
    _Pragma("unroll") for (int j = 0; j < 4; ++j) {                                                \
      *(u32x4*)(da_ + j * 4096) = SA[j];                                                           \
      *(u32x4*)(da_ + 16384 + j * 4096) = SB[j];                                                   \
    }                                                                                              \
  }
#define GEMM_COMPUTE(BUF)                                                                          \
  {                                                                                                \
    const char* sa_ = lds + (BUF) * 32768 + (wm * 64 + lr) * 128;                                  \
    const char* sb_ = lds + (BUF) * 32768 + 16384 + (wn * 64 + lr) * 128;                          \
    _Pragma("unroll") for (int kk = 0; kk < 2; ++kk) {                                             \
      bf16x8 af[4], bfr[4];                                                                        \
      const int co = ((kk * 4 + lg) ^ rsw) << 4;                                                   \
      _Pragma("unroll") for (int i = 0; i < 4; ++i) af[i] = *(const bf16x8*)(sa_ + i * 2048 + co); \
      _Pragma("unroll") for (int j = 0; j < 4; ++j) bfr[j] = *(const bf16x8*)(sb_ + j * 2048 + co);\
      __builtin_amdgcn_s_setprio(1);                                                               \
      _Pragma("unroll") for (int i = 0; i < 4; ++i)                                                \
        _Pragma("unroll") for (int j = 0; j < 4; ++j)                                              \
          acc[i][j] = Epi::STAGED ? __builtin_amdgcn_mfma_f32_16x16x32_bf16(bfr[j], af[i], acc[i][j], 0, 0, 0) \
                                  : __builtin_amdgcn_mfma_f32_16x16x32_bf16(af[i], bfr[j], acc[i][j], 0, 0, 0); \
      __builtin_amdgcn_s_setprio(0);                                                               \
    }                                                                                              \
  }
  GEMM_ISSUE(a0, b0, 0)
  GEMM_ISSUE(a1, b1, 1)
  asm volatile("s_waitcnt vmcnt(8)" ::: "memory");
  GEMM_WRITE(a0, b0, 0)
  __syncthreads();
  for (int kt = 0; kt < nk; kt += 2) {
    GEMM_ISSUE(a0, b0, kt + 2)
    GEMM_COMPUTE(0)
    asm volatile("s_waitcnt vmcnt(8)" ::: "memory");
    GEMM_WRITE(a1, b1, 1)
    __syncthreads();
    if (kt + 1 < nk) {
      GEMM_ISSUE(a1, b1, kt + 3)
      GEMM_COMPUTE(1)
      asm volatile("s_waitcnt vmcnt(8)" ::: "memory");
      GEMM_WRITE(a0, b0, 0)
      __syncthreads();
    }
  }
  asm volatile("s_waitcnt vmcnt(0)" ::: "memory");
#pragma unroll
  for (int j = 0; j < 4; ++j) asm volatile("" :: "v"(a0[j]), "v"(b0[j]), "v"(a1[j]), "v"(b1[j]));
#undef GEMM_ISSUE
#undef GEMM_WRITE
#undef GEMM_COMPUTE
  if (Epi::ACT == 3) {
    if (wm == 0) {
#pragma unroll
      for (int i = 0; i < 4; ++i)
#pragma unroll
        for (int j = 0; j < 4; ++j)
          *(f32x4*)(epi.partp() + (size_t)(i * 16 + lr) * 1024 + n0 + wn * 64 + j * 16 + 4 * lg) = acc[i][j];
    }
  } else if (Epi::STAGED) {
#pragma unroll
    for (int i = 0; i < 4; ++i)
#pragma unroll
      for (int j = 0; j < 4; ++j) {
        f32x4 v = acc[i][j];
        if (Epi::ACT == 1) {
#pragma unroll
          for (int r = 0; r < 4; ++r) { float x = fmaxf(v[r], 0.f); v[r] = x * x; }
        }
        uint2 w; w.x = pack2(v[0], v[1]); w.y = pack2(v[2], v[3]);
        *(uint2*)(lds + (wm * 64 + i * 16 + lr) * 272 + (wn * 64 + j * 16 + 4 * lg) * 2) = w;
      }
    __syncthreads();
    if (!(Epi::HASVT && n0 == 896)) {
#pragma unroll
      for (int q = 0; q < 8; ++q) {
        const int c = tid + 256 * q;
        const int row = c >> 4, cc = c & 15;
        if (m0 + row < Mrows && n0 + cc * 8 < Nrows)
          *(uint4*)(epi.C + (size_t)(m0 + row) * epi.ldc + n0 + cc * 8) = *(const uint4*)(lds + row * 272 + cc * 16);
      }
    } else {
#pragma unroll
      for (int q = 0; q < 8; ++q) {
        const int id = tid + 256 * q;
        const int rg = id & 15, col = id >> 4;
        const int m = m0 + rg * 8;
        if (m < Mrows) {
          unsigned short e8[8];
#pragma unroll
          for (int e = 0; e < 8; ++e) e8[e] = *(const unsigned short*)(lds + (rg * 8 + e) * 272 + col * 2);
          const int bb = m / TPB, t = m - bb * TPB;
          uint4 val = make_uint4((unsigned)e8[0] | ((unsigned)e8[1] << 16), (unsigned)e8[2] | ((unsigned)e8[3] << 16),
                                 (unsigned)e8[4] | ((unsigned)e8[5] << 16), (unsigned)e8[6] | ((unsigned)e8[7] << 16));
          *(uint4*)(epi.vtp() + ((size_t)(bb * 2 + (col >> 6)) * 64 + (col & 63)) * LT + t) = val;
        }
      }
    }
    __syncthreads();
  } else {
#pragma unroll
    for (int i = 0; i < 4; ++i)
#pragma unroll
      for (int j = 0; j < 4; ++j)
        epi(m0 + wm * 64 + i * 16 + 4 * lg, n0 + wn * 64 + j * 16 + lr, acc[i][j]);
  }
}

template <class Epi>
__device__ __forceinline__ void gemm_phase(const u16* A, int lda, const u16* Bt, int ldb, int N, int K, char* lds,
                                           Epi epi, int rot, int tilesM = 129, int tileLo = 0, bool rev = false) {
  const int tilesN = (N + 127) >> 7;
  const int total = tilesM * tilesN;
  int start = (int)((blockIdx.x + gridDim.x - (rot % gridDim.x)) % gridDim.x) + tileLo * tilesN;
  for (int tile = start; tile < total; tile += gridDim.x) {
    int tm = tile / tilesN; const int tn = tile - tm * tilesN;
    if (rev) tm = 128 - tm;
    gemm_tile(A, lda, MTOK, Bt, ldb, N, K, tm * 128, tn * 128, lds, epi);
  }
}

struct EpiBf16 {
  static constexpr bool STAGED = true; static constexpr int ACT = 0; static constexpr bool HASVT = false;
  __device__ __forceinline__ u16* vtp() const { return nullptr; }
  __device__ __forceinline__ float* partp() const { return nullptr; }
  u16* C; int ldc; int N;
  __device__ __forceinline__ void operator()(int m, int n, f32x4 v) const {
    if (n < N) {
#pragma unroll
      for (int r = 0; r < 4; ++r) if (m + r < MTOK) C[(size_t)(m + r) * ldc + n] = f2bf(v[r]);
    }
  }
};
struct EpiPart {
  static constexpr bool STAGED = true; static constexpr int ACT = 3; static constexpr bool HASVT = false;
  float* part; u16* C; int ldc;
  __device__ __forceinline__ u16* vtp() const { return nullptr; }
  __device__ __forceinline__ float* partp() const { return part; }
  __device__ __forceinline__ void operator()(int, int, f32x4) const {}
};
struct EpiProjS {
  static constexpr bool STAGED = true; static constexpr int ACT = 0; static constexpr bool HASVT = true;
  u16* C; int ldc; u16* vts;
  __device__ __forceinline__ u16* vtp() const { return vts; }
  __device__ __forceinline__ float* partp() const { return nullptr; }
  __device__ __forceinline__ void operator()(int, int, f32x4) const {}
};
struct EpiRelu2 {
  static constexpr bool STAGED = true; static constexpr int ACT = 1; static constexpr bool HASVT = false;
  __device__ __forceinline__ u16* vtp() const { return nullptr; }
  __device__ __forceinline__ float* partp() const { return nullptr; }
  u16* C; int ldc;
  __device__ __forceinline__ void operator()(int m, int n, f32x4 v) const {
#pragma unroll
    for (int r = 0; r < 4; ++r) if (m + r < MTOK) { float x = fmaxf(v[r], 0.f); C[(size_t)(m + r) * ldc + n] = f2bf(x * x); }
  }
};
struct EpiProj {
  static constexpr bool HASVT = false;
  __device__ __forceinline__ u16* vtp() const { return nullptr; }
  __device__ __forceinline__ float* partp() const { return nullptr; }
  static constexpr bool STAGED = false; static constexpr int ACT = 0;
  u16* C; int ldc;
  u16* proj; u16* vts;
  __device__ __forceinline__ void operator()(int m, int n, f32x4 v) const {
    if (n < INW && m < MTOK) {
#pragma unroll
      for (int r = 0; r < 4; ++r) proj[(size_t)(m + r) * INW + n] = f2bf(v[r]);
      if (n >= 896 && n < 1024) {
        const int kvh = (n - 896) >> 6, d = (n - 896) & 63;
        const int b = m / TPB, t = m - b * TPB;
        uint2 w; w.x = pack2(v[0], v[1]); w.y = pack2(v[2], v[3]);
        *(uint2*)(vts + ((size_t)(b * 2 + kvh) * 64 + d) * LT + t) = w;
      }
    }
  }
};
struct EpiKV {
  static constexpr bool HASVT = false;
  __device__ __forceinline__ u16* vtp() const { return nullptr; }
  __device__ __forceinline__ float* partp() const { return nullptr; }
  static constexpr bool STAGED = false; static constexpr int ACT = 0;
  u16* C; int ldc;
  u16* kn; u16* vtm;
  __device__ __forceinline__ void operator()(int m, int n, f32x4 v) const {
    if (m < MTOK) {
      if (n < 256) {
#pragma unroll
        for (int r = 0; r < 4; ++r) kn[(size_t)(m + r) * 256 + n] = f2bf(v[r]);
      } else {
        const int h = (n - 256) >> 6, d = (n - 256) & 63;
        const int b = m / TPB, t = m - b * TPB;
        uint2 w; w.x = pack2(v[0], v[1]); w.y = pack2(v[2], v[3]);
        *(uint2*)(vtm + ((size_t)(b * 4 + h) * 64 + d) * LT + t) = w;
      }
    }
  }
};
struct EpiGlu {
  static constexpr bool HASVT = false;
  __device__ __forceinline__ u16* vtp() const { return nullptr; }
  __device__ __forceinline__ float* partp() const { return nullptr; }
  static constexpr bool STAGED = false; static constexpr int ACT = 0;
  u16* C; int ldc;
  const u16* z; const float* bg; u16* y;
  __device__ __forceinline__ void operator()(int m, int n, f32x4 v) const {
    const float bb = bg[n];
#pragma unroll
    for (int r = 0; r < 4; ++r)
      if (m + r < MTOK) {
        float zz = bf2f(z[(size_t)(m + r) * 256 + n]);
        float s = 1.f / (1.f + __expf(-(v[r] + bb)));
        y[(size_t)(m + r) * 256 + n] = f2bf(zz * s);
      }
  }
};

__device__ __forceinline__ void ssm_load_u(const u16* proj, int b, int g, int ch, int lane, float* urow) {
  const int t = ch * 64 + lane;
  uint4 r0 = make_uint4(0, 0, 0, 0), r1 = make_uint4(0, 0, 0, 0);
  if (t < TPB) {
    const uint4* src = (const uint4*)(proj + (size_t)(b * TPB + t) * INW + g * 16);
    r0 = src[0]; r1 = src[1];
  }
  float4* d = (float4*)urow;
  d[0] = make_float4(bflo(r0.x), bfhi(r0.x), bflo(r0.y), bfhi(r0.y));
  d[1] = make_float4(bflo(r0.z), bfhi(r0.z), bflo(r0.w), bfhi(r0.w));
  d[2] = make_float4(bflo(r1.x), bfhi(r1.x), bflo(r1.y), bfhi(r1.y));
  d[3] = make_float4(bflo(r1.z), bfhi(r1.z), bflo(r1.w), bfhi(r1.w));
}

#define SSM_STEP(UP)                                                                          \
  {                                                                                           \
    const float4 u0 = (UP)[0], u1 = (UP)[1], u2 = (UP)[2], u3 = (UP)[3];                      \
      \
    float r0 = u0.x * br[0], i0 = u0.x * bi[0], r1 = u1.x * br[4], i1 = u1.x * bi[4];         \
    float r2 = u2.x * br[8], i2 = u2.x * bi[8], r3 = u3.x * br[12], i3 = u3.x * bi[12];       \
    r0 += u0.y * br[1]; i0 += u0.y * bi[1]; r1 += u1.y * br[5]; i1 += u1.y * bi[5];           \
    r2 += u2.y * br[9]; i2 += u2.y * bi[9]; r3 += u3.y * br[13]; i3 += u3.y * bi[13];         \
    r0 += u0.z * br[2]; i0 += u0.z * bi[2]; r1 += u1.z * br[6]; i1 += u1.z * bi[6];           \
    r2 += u2.z * br[10]; i2 += u2.z * bi[10]; r3 += u3.z * br[14]; i3 += u3.z * bi[14];       \
    r0 += u0.w * br[3]; i0 += u0.w * bi[3]; r1 += u1.w * br[7]; i1 += u1.w * bi[7];           \
    r2 += u2.w * br[11]; i2 += u2.w * bi[11]; r3 += u3.w * br[15]; i3 += u3.w * bi[15];       \
    const float sr = (r0 + r1) + (r2 + r3), si = (i0 + i1) + (i2 + i3);                       \
    const float nxr = lam.x * xr - lam.y * xi + sr;                                           \
    const float nxi = lam.x * xi + lam.y * xr + si;                                           \
    xr = nxr; xi = nxi;                                                                       \
  }

__device__ void phase_ssm_a(const Params& p, int l, char* lds) {
  const u16* proj = (const u16*)(p.ws + OX_PROJ);
  float* us = (float*)lds;
  const int tid_ = otid();
  const int lane = tid_ & 63, w = tid_ >> 6;
  const float* bbt = (const float*)(p.ws + OFF_BB);
  const float2* lamt = (const float2*)(p.ws + OFF_LAM);
  float2* endp = (float2*)(p.ws + OFF_END2 + (size_t)l * END_BYTES);
  for (int item = blockIdx.x; item < 64 * 16; item += gridDim.x) {
    const int bg = item >> 4, cq = item & 15;
    const int b = bg >> 4, g = bg & 15;
    const int ch = cq * 4 + w;
    if (ch < 63) {
      ssm_load_u(proj, b, g, ch, lane, us + (w * 64 + lane) * 16);
      asm volatile("s_waitcnt lgkmcnt(0)" ::: "memory");
      float br[16], bi[16];
      const float* bbp = bbt + ((size_t)(l * 16 + g) * 32) * 64 + lane;
#pragma unroll
      for (int c = 0; c < 16; ++c) { br[c] = bbp[(2 * c) * 64]; bi[c] = bbp[(2 * c + 1) * 64]; }
      const float2 lam = lamt[(l * 16 + g) * 64 + lane];
      float xr = 0.f, xi = 0.f;
#pragma unroll 4
      for (int tt = 0; tt < 64; ++tt) {
        const float4* up = (const float4*)(us + (w * 64 + tt) * 16);
        SSM_STEP(up)
      }
      endp[((size_t)(b * 16 + g) * NCH + ch) * 64 + lane] = make_float2(xr, xi);
    }
  }
}

__device__ __forceinline__ float gelu_tanh(float y) {
  const float a = 0.7978845608028654f * (y + 0.044715f * y * y * y);
  const float th = 1.f - 2.f / (1.f + __expf(2.f * a));
  return 0.5f * y * (1.f + th);
}

__device__ void phase_ssm_c(const Params& p, int l, char* lds) {
  const u16* proj = (const u16*)(p.ws + OX_PROJ);
  u16* z = (u16*)(p.ws + OX_Z);
  float* Cs = (float*)lds;
  float* us = Cs + 2048;
  float* xs = us + 4096;
  const int tid = otid(), lane = tid & 63, w = tid >> 6;
  const float* bbt = (const float*)(p.ws + OFF_BB);
  const float2* lamt = (const float2*)(p.ws + OFF_LAM);
  const float2* lamTt = (const float2*)(p.ws + OFF_LAMT);
  const float2* endp = (const float2*)(p.ws + OFF_END2 + (size_t)l * END_BYTES);
  for (int item = blockIdx.x; item < 64 * 16; item += gridDim.x) {
    const int bg = item >> 4, cq = item & 15;
    const int b = bg >> 4, g = bg & 15;
    {
      const float* cre = p.c_re + (size_t)(l * 16 + g) * 1024;
      const float* cim = p.c_im + (size_t)(l * 16 + g) * 1024;
#pragma unroll
      for (int j = 0; j < 4; ++j) {
        int idx = tid + 256 * j;
        *(float2*)(Cs + idx * 2) = make_float2(cre[idx], cim[idx]);
      }
    }
    const int ch = cq * 4 + w;
    const int nsub = (cq == 15) ? 5 : 4;
    {
      ssm_load_u(proj, b, g, ch, lane, us + (w * 64 + lane) * 16);
      float br[16], bi[16];
      const float* bbp = bbt + ((size_t)(l * 16 + g) * 32) * 64 + lane;
#pragma unroll
      for (int c = 0; c < 16; ++c) { br[c] = bbp[(2 * c) * 64]; bi[c] = bbp[(2 * c + 1) * 64]; }
      const float2 lam = lamt[(l * 16 + g) * 64 + lane];
      const float2 lamT = lamTt[(l * 16 + g) * 64 + lane];
      __syncthreads();
      float xr = 0.f, xi = 0.f;
      const float2* ep = endp + ((size_t)(b * 16 + g) * NCH) * 64 + lane;
      {
        int j = 0;
        for (; j + 16 <= ch; j += 16) {
          float2 e[16];
#pragma unroll
          for (int q = 0; q < 16; ++q) e[q] = ep[(size_t)(j + q) * 64];
#pragma unroll
          for (int q = 0; q < 16; ++q) {
            const float nxr = lamT.x * xr - lamT.y * xi + e[q].x;
            const float nxi = lamT.x * xi + lamT.y * xr + e[q].y;
            xr = nxr; xi = nxi;
          }
        }
        for (; j < ch; ++j) {
          const float2 e = ep[(size_t)j * 64];
          const float nxr = lamT.x * xr - lamT.y * xi + e.x;
          const float nxi = lamT.x * xi + lamT.y * xr + e.y;
          xr = nxr; xi = nxi;
        }
      }
      const int tl = lane & 15, c4 = lane >> 4;
      const float4 dsk = *(const float4*)(p.d_skip + (size_t)l * 256 + g * 16 + c4 * 4);
      for (int sub = 0; sub < nsub; ++sub) {
        const int rbase = (sub & 3) * 16;
        if (sub == 4) {
          uint4 r0 = make_uint4(0, 0, 0, 0), r1 = make_uint4(0, 0, 0, 0);
          const int t2 = 4096 + lane;
          if (ch == 63 && lane < 16) {
            const uint4* s4 = (const uint4*)(proj + (size_t)(b * TPB + t2) * INW + g * 16);
            r0 = s4[0]; r1 = s4[1];
          }
          if (lane < 16) {
            float4* d = (float4*)(us + (w * 64 + lane) * 16);
            d[0] = make_float4(bflo(r0.x), bfhi(r0.x), bflo(r0.y), bfhi(r0.y));
            d[1] = make_float4(bflo(r0.z), bfhi(r0.z), bflo(r0.w), bfhi(r0.w));
            d[2] = make_float4(bflo(r1.x), bfhi(r1.x), bflo(r1.y), bfhi(r1.y));
            d[3] = make_float4(bflo(r1.z), bfhi(r1.z), bflo(r1.w), bfhi(r1.w));
          }
          __syncthreads();
        }
#pragma unroll 4
        for (int tt = 0; tt < 16; ++tt) {
          const float4* up = (const float4*)(us + (w * 64 + rbase + tt) * 16);
          SSM_STEP(up)
          *(float2*)(xs + (w * 16 + tt) * 132 + 2 * lane) = make_float2(xr, xi);
        }
        __syncthreads();
        const float* xrow = xs + (w * 16 + tl) * 132;
        const float* crow = Cs + (c4 * 4) * 128;
        float a0 = 0.f, a1 = 0.f, a2 = 0.f, a3 = 0.f;
#pragma unroll 4
        for (int pp = 0; pp < 32; ++pp) {
          const float4 xv = *(const float4*)(xrow + 4 * pp);
          const float4 c0 = *(const float4*)(crow + 4 * pp);
          const float4 c1 = *(const float4*)(crow + 128 + 4 * pp);
          const float4 c2 = *(const float4*)(crow + 256 + 4 * pp);
          const float4 c3 = *(const float4*)(crow + 384 + 4 * pp);
          a0 += c0.x * xv.x - c0.y * xv.y + c0.z * xv.z - c0.w * xv.w;
          a1 += c1.x * xv.x - c1.y * xv.y + c1.z * xv.z - c1.w * xv.w;
          a2 += c2.x * xv.x - c2.y * xv.y + c2.z * xv.z - c2.w * xv.w;
          a3 += c3.x * xv.x - c3.y * xv.y + c3.z * xv.z - c3.w * xv.w;
        }
        __syncthreads();
        const int tok = ch * 64 + sub * 16 + tl;
        const float4 uv = *(const float4*)(us + (w * 64 + rbase + tl) * 16 + c4 * 4);
        if ((sub < 4 || ch == 63) && tok < TPB) {
          uint2 wv;
          wv.x = pack2(gelu_tanh(a0 + dsk.x * uv.x), gelu_tanh(a1 + dsk.y * uv.y));
          wv.y = pack2(gelu_tanh(a2 + dsk.z * uv.z), gelu_tanh(a3 + dsk.w * uv.w));
          *(uint2*)(z + (size_t)(b * TPB + tok) * 256 + g * 16 + c4 * 4) = wv;
        }
      }
    }
    __syncthreads();
  }
}

template <bool MLA, int NQS>
__device__ void attn_item(const Params& p, int l, int b, int head, int qt, char* lds) {
  constexpr int NDS = MLA ? 3 : 2;
  const int tid = otid(), lane = tid & 63, w = tid >> 6;
  const int lr = lane & 15, lg = lane >> 4;
  const u16* proj = (const u16*)(p.ws + OX_PROJ);
  const u16* krope = (const u16*)(p.ws + OX_KR);
  const u16* Ksrc; int kld; const u16* Vt; u16* Y; int ldy;
  if (MLA) {
    Ksrc = (const u16*)(p.ws + OX_KN) + head * 64; kld = 256;
    Vt = (const u16*)(p.ws + OX_VTM) + (size_t)(b * 4 + head) * 64 * LT;
    Y = (u16*)(p.ws + OX_YMLA); ldy = 256;
  } else {
    const int kvh = head >> 2;
    Ksrc = proj + 768 + kvh * 64; kld = INW;
    Vt = (const u16*)(p.ws + OX_VTS) + (size_t)(b * 2 + kvh) * 64 * LT;
    Y = (u16*)(p.ws + OX_YSWA); ldy = 512;
  }
  const int q0 = qt * (64 * NQS);
  const int kt_hi = ((q0 + 64 * NQS - 1) >> 6) < 64 ? ((q0 + 64 * NQS - 1) >> 6) : 64;
  const int kt_lo = MLA ? 0 : (((q0 >> 6) - 2) > 0 ? ((q0 >> 6) - 2) : 0);
  const float LOG2E = 1.4426950408889634f;
  const float c1 = (MLA ? 0.10206207261596575f : 0.125f) * LOG2E;
  float sl2 = 0.f, sink2 = 0.f;
  if (!MLA) {
    sl2 = exp2f(-(float)(head + 1)) * LOG2E;
    sink2 = p.sinks[l * 8 + head] * LOG2E;
  }
  bf16x8 qf[NQS][NDS];
#pragma unroll
  for (int qs = 0; qs < NQS; ++qs) {
    int tq = q0 + 16 * NQS * w + 16 * qs + lr; tq = tq < TPB ? tq : TPB - 1;
    const size_t m = (size_t)b * TPB + tq;
    if (!MLA) {
      const u16* qp = proj + m * INW + 256 + head * 64;
      qf[qs][0] = *(const bf16x8*)(qp + lg * 8);
      qf[qs][1] = *(const bf16x8*)(qp + 32 + lg * 8);
    } else {
      const u16* qp = (const u16*)(p.ws + OX_QMLA) + m * 384 + head * 96;
      qf[qs][0] = *(const bf16x8*)(qp + lg * 8);
      qf[qs][1] = *(const bf16x8*)(qp + 32 + lg * 8);
      const uint4 own = *(const uint4*)(qp + 64 + lg * 8);
      const uint4 par = *(const uint4*)(qp + 64 + (lg ^ 2) * 8);
      const float2* cs = (const float2*)(p.ws + OFF_ROPE) + tq * 16 + (lg & 1) * 8;
      const unsigned ow[4] = {own.x, own.y, own.z, own.w};
      const unsigned pw[4] = {par.x, par.y, par.z, par.w};
      unsigned rw[4];
#pragma unroll
      for (int e2 = 0; e2 < 4; ++e2) {
        const float2 csa = cs[2 * e2], csb = cs[2 * e2 + 1];
        const float oa = bflo(ow[e2]), ob = bfhi(ow[e2]), pa = bflo(pw[e2]), pb = bfhi(pw[e2]);
        float ra, rb;
        if (lg < 2) { ra = oa * csa.x - pa * csa.y; rb = ob * csb.x - pb * csb.y; }
        else { ra = pa * csa.y + oa * csa.x; rb = pb * csb.y + ob * csb.x; }
        rw[e2] = pack2(ra, rb);
      }
      uint4 r4 = make_uint4(rw[0], rw[1], rw[2], rw[3]);
      qf[qs][NDS - 1] = *(bf16x8*)&r4;
    }
  }
  float mrow[NQS], lrow[NQS];
  f32x4 o[NQS][4];
#pragma unroll
  for (int qs = 0; qs < NQS; ++qs) {
    mrow[qs] = MLA ? -1e30f : sink2; lrow[qs] = 0.f;
#pragma unroll
    for (int jt = 0; jt < 4; ++jt) o[qs][jt] = (f32x4){0.f, 0.f, 0.f, 0.f};
  }
  typedef unsigned au32x4 __attribute__((ext_vector_type(4)));
  au32x4 rak0, rak1, rav0, rav1, rakr, rbk0, rbk1, rbv0, rbv1, rbkr;
  rakr = (au32x4){0u, 0u, 0u, 0u}; rbkr = rakr;
  const int skey = tid >> 3, skc = tid & 7;
  const int rkey = tid >> 2, rkc = tid & 3;
  const u16* kptr = Ksrc + ((size_t)b * TPB + skey) * kld + skc * 8;
  const u16* vptr = Vt + (size_t)skey * LT + skc * 8;
  const u16* krptr = krope + ((size_t)b * TPB + rkey) * 32 + rkc * 8;
  const int kw_off = skey * 128 + ((skc ^ (((skey >> 1) & 1) | (((skey >> 3) & 3) << 1))) << 4);
  const int vw_off = skey * 128 + ((skc ^ ((skey >> 1) & 7)) << 4);
  const int krx = (rkey >> 3) & 3;
  const int krw_off = rkey * 64 + ((rkc ^ (krx ^ ((krx & 1) << 1))) << 4);
#define ATT_GLD16(dst, ptr) asm volatile("global_load_dwordx4 %0, %1, off" : "=&v"(dst) : "v"(ptr) : "memory")
#define ATT_GLOAD(S, KT)                                                     \
  {                                                                          \
    const int k0_ = (KT) * 64;                                               \
    const u16* p0_ = kptr + (size_t)k0_ * kld;                               \
    const u16* p1_ = kptr + (size_t)(k0_ + 32) * kld;                        \
    const u16* p2_ = vptr + k0_;                                             \
    const u16* p3_ = vptr + (size_t)32 * LT + k0_;                           \
    ATT_GLD16(S##k0, p0_); ATT_GLD16(S##k1, p1_); ATT_GLD16(S##v0, p2_); ATT_GLD16(S##v1, p3_); \
    if (MLA) { const u16* p4_ = krptr + (size_t)k0_ * 32; ATT_GLD16(S##kr, p4_); }              \
  }
#define ATT_SWRITE(S, BUF)                                                   \
  {                                                                          \
    char* Kb_ = lds + (BUF) * 20480;                                         \
    *(au32x4*)(Kb_ + kw_off) = S##k0;                                        \
    *(au32x4*)(Kb_ + kw_off + 32 * 128) = S##k1;                             \
    *(au32x4*)(Kb_ + 8192 + vw_off) = S##v0;                                 \
    *(au32x4*)(Kb_ + 8192 + vw_off + 32 * 128) = S##v1;                      \
    if (MLA) *(au32x4*)(Kb_ + 16384 + krw_off) = S##kr;                      \
  }
#define ATT_WAIT_OLDER() { if (MLA) asm volatile("s_waitcnt vmcnt(5)" ::: "memory"); else asm volatile("s_waitcnt vmcnt(4)" ::: "memory"); }
#define ATT_STEP(KT_, BUF_)  \
  {  \
    const char* Kb = lds + (BUF_) * 20480; const char* Vb = Kb + 8192; const char* Krb = Kb + 16384;  \
    f32x4 s[NQS][2][2];  \
    _Pragma("unroll")  \
    for (int kk = 0; kk < 2; ++kk)  \
    _Pragma("unroll")  \
      for (int j = 0; j < 2; ++j) {  \
        const int keyl = 32 * kk + 8 * (lr >> 2) + 4 * j + (lr & 3);  \
        f32x4 s0 = (f32x4){0.f, 0.f, 0.f, 0.f}, s1 = (f32x4){0.f, 0.f, 0.f, 0.f};  \
    _Pragma("unroll")  \
        for (int ds = 0; ds < 2; ++ds) {  \
          const bf16x8 kf = *(const bf16x8*)(Kb + keyl * 128 + (((ds * 4 + lg) ^ fsw) << 4));  \
          s0 = __builtin_amdgcn_mfma_f32_16x16x32_bf16(kf, qf[0][ds], s0, 0, 0, 0);  \
          if (NQS > 1) s1 = __builtin_amdgcn_mfma_f32_16x16x32_bf16(kf, qf[NQS - 1][ds], s1, 0, 0, 0);  \
        }  \
        if (MLA) {  \
          const bf16x8 kf = *(const bf16x8*)(Krb + keyl * 64 + ((lg ^ xh) << 4));  \
          s0 = __builtin_amdgcn_mfma_f32_16x16x32_bf16(kf, qf[0][NDS - 1], s0, 0, 0, 0);  \
          if (NQS > 1) s1 = __builtin_amdgcn_mfma_f32_16x16x32_bf16(kf, qf[NQS - 1][NDS - 1], s1, 0, 0, 0);  \
        }  \
        s[0][kk][j] = s0; if (NQS > 1) s[NQS - 1][kk][j] = s1;  \
      }  \
    bf16x8 pf[NQS][2];  \
    _Pragma("unroll")  \
    for (int qs = 0; qs < NQS; ++qs) {  \
      const int tq = q0 + 16 * NQS * w + 16 * qs + lr;  \
      float mx = -INFINITY;  \
      float mnew, alpha, ps = 0.f;  \
      if (MLA) {  \
        if ((KT_) * 64 + 63 > q0) {  \
    _Pragma("unroll")  \
          for (int kk = 0; kk < 2; ++kk)  \
    _Pragma("unroll")  \
            for (int j = 0; j < 2; ++j)  \
    _Pragma("unroll")  \
              for (int i = 0; i < 4; ++i) {  \
                const int key = (KT_) * 64 + 32 * kk + 8 * lg + 4 * j + i;  \
                s[qs][kk][j][i] = (key <= tq) ? s[qs][kk][j][i] : -INFINITY;  \
              }  \
        }  \
    _Pragma("unroll")  \
        for (int kk = 0; kk < 2; ++kk)  \
    _Pragma("unroll")  \
          for (int j = 0; j < 2; ++j)  \
    _Pragma("unroll")  \
            for (int i = 0; i < 4; ++i) mx = fmaxf(mx, s[qs][kk][j][i]);  \
        mx = fmaxf(mx, __shfl_xor(mx, 16));  \
        mx = fmaxf(mx, __shfl_xor(mx, 32));  \
        mnew = fmaxf(mrow[qs], mx * c1);  \
        alpha = fexp2(mrow[qs] - mnew);  \
        mrow[qs] = mnew;  \
    _Pragma("unroll")  \
        for (int kk = 0; kk < 2; ++kk) {  \
          float pv[8];  \
    _Pragma("unroll")  \
          for (int j = 0; j < 2; ++j)  \
    _Pragma("unroll")  \
            for (int i = 0; i < 4; ++i) {  \
              const float e = fexp2(__builtin_fmaf(s[qs][kk][j][i], c1, -mnew));  \
              pv[j * 4 + i] = e; ps += e;  \
            }  \
          uint4 r4 = make_uint4(pack2(pv[0], pv[1]), pack2(pv[2], pv[3]), pack2(pv[4], pv[5]), pack2(pv[6], pv[7]));  \
          pf[qs][kk] = *(bf16x8*)&r4;  \
        }  \
      } else {  \
    _Pragma("unroll")  \
        for (int kk = 0; kk < 2; ++kk)  \
    _Pragma("unroll")  \
          for (int j = 0; j < 2; ++j)  \
    _Pragma("unroll")  \
            for (int i = 0; i < 4; ++i) {  \
              const int key = (KT_) * 64 + 32 * kk + 8 * lg + 4 * j + i;  \
              float v = s[qs][kk][j][i] * c1 - sl2 * (float)(tq - key);  \
              const bool ok = (key <= tq) && (key > tq - 128);  \
              v = ok ? v : -INFINITY;  \
              s[qs][kk][j][i] = v;  \
              mx = fmaxf(mx, v);  \
            }  \
        mx = fmaxf(mx, __shfl_xor(mx, 16));  \
        mx = fmaxf(mx, __shfl_xor(mx, 32));  \
        mnew = fmaxf(mrow[qs], mx);  \
        alpha = fexp2(mrow[qs] - mnew);  \
        mrow[qs] = mnew;  \
    _Pragma("unroll")  \
        for (int kk = 0; kk < 2; ++kk) {  \
          float pv[8];  \
    _Pragma("unroll")  \
          for (int j = 0; j < 2; ++j)  \
    _Pragma("unroll")  \
            for (int i = 0; i < 4; ++i) {  \
              const float e = fexp2(s[qs][kk][j][i] - mnew);  \
              pv[j * 4 + i] = e; ps += e;  \
            }  \
          uint4 r4 = make_uint4(pack2(pv[0], pv[1]), pack2(pv[2], pv[3]), pack2(pv[4], pv[5]), pack2(pv[6], pv[7]));  \
          pf[qs][kk] = *(bf16x8*)&r4;  \
        }  \
      }  \
      lrow[qs] = lrow[qs] * alpha + ps;  \
    _Pragma("unroll")  \
      for (int jt = 0; jt < 4; ++jt) o[qs][jt] *= alpha;  \
    }  \
    _Pragma("unroll")  \
    for (int jt = 0; jt < 4; ++jt)  \
    _Pragma("unroll")  \
      for (int kk = 0; kk < 2; ++kk) {  \
        const bf16x8 vf = *(const bf16x8*)(Vb + (16 * jt + lr) * 128 + (((4 * kk + lg) ^ vsw) << 4));  \
        o[0][jt] = __builtin_amdgcn_mfma_f32_16x16x32_bf16(vf, pf[0][kk], o[0][jt], 0, 0, 0);  \
        if (NQS > 1) o[NQS - 1][jt] = __builtin_amdgcn_mfma_f32_16x16x32_bf16(vf, pf[NQS - 1][kk], o[NQS - 1][jt], 0, 0, 0);  \
      }  \
  }
  const int fsw = ((lr >> 1) & 1) | ((lr >> 2) << 1);
  const int xh = (lr >> 2) ^ (((lr >> 2) & 1) << 1);
  const int vsw = (lr >> 1) & 7;
  ATT_GLOAD(ra, kt_lo)
  ATT_GLOAD(rb, (kt_lo + 1 <= kt_hi ? kt_lo + 1 : kt_hi))
  ATT_WAIT_OLDER()
  ATT_SWRITE(ra, 0)
  __syncthreads();
  for (int kt = kt_lo; kt <= kt_hi; kt += 2) {
    ATT_GLOAD(ra, (kt + 2 <= kt_hi ? kt + 2 : kt_hi))
    ATT_STEP(kt, 0)
    ATT_WAIT_OLDER()
    ATT_SWRITE(rb, 1)
    __syncthreads();
    if (kt + 1 <= kt_hi) {
      ATT_GLOAD(rb, (kt + 3 <= kt_hi ? kt + 3 : kt_hi))
      ATT_STEP(kt + 1, 1)
      ATT_WAIT_OLDER()
      ATT_SWRITE(ra, 0)
      __syncthreads();
    }
  }
  asm volatile("s_waitcnt vmcnt(0)" ::: "memory");
  asm volatile("" :: "v"(rak0), "v"(rak1), "v"(rav0), "v"(rav1), "v"(rakr), "v"(rbk0), "v"(rbk1), "v"(rbv0), "v"(rbv1), "v"(rbkr));
#pragma unroll
  for (int qs = 0; qs < NQS; ++qs) {
    const int tq = q0 + 16 * NQS * w + 16 * qs + lr;
    float lsum = lrow[qs];
    lsum += __shfl_xor(lsum, 16);
    lsum += __shfl_xor(lsum, 32);
    if (!MLA) lsum += fexp2(sink2 - mrow[qs]);
    const float inv = 1.f / lsum;
    if (tq < TPB) {
      u16* yp = Y + ((size_t)b * TPB + tq) * ldy + head * 64 + 4 * lg;
#pragma unroll
      for (int jt = 0; jt < 4; ++jt) {
        uint2 wv;
        wv.x = pack2(o[qs][jt][0] * inv, o[qs][jt][1] * inv);
        wv.y = pack2(o[qs][jt][2] * inv, o[qs][jt][3] * inv);
        *(uint2*)(yp + 16 * jt) = wv;
      }
    }
  }
}


#define UP_EXP OFF_X
#define UP_TILES 16
#define P9_LO 0
#define P9_HI 129
#ifndef STOP_AFTER
#define STOP_AFTER 0
#endif
__device__ void dump_bf16(const Params& p, const u16* buf, int ld, int coloff, int shift = 0) {
  const int tid_ = otid();
  const int lane = tid_ & 63;
  const int wg = (int)((blockIdx.x + shift) % gridDim.x) * 4 + (tid_ >> 6), nw = gridDim.x * 4;
  for (int m = wg; m < MTOK; m += nw) {
    const int b = m / TPB, t = m - b * TPB;
    if (t < 16) continue;
    float* o = p.out + ((size_t)b * 4096 + (t - 16)) * DM;
    for (int j = 0; j < 16; ++j) o[j * 64 + lane] = bf2f(buf[(size_t)m * ld + coloff + j * 64 + lane]);
  }
}
#define XB_TMO      128
#define XB_XCNT(j)  (256  + 64 * (j))
#define XB_XSUB(j)  (1280 + 64 * (j))
#define XB_XGEN(j)  (2304 + 64 * (j))
#define XB_TOP      3328
#define XB_TOPGEN   3392
#define XCD_BAR_WORDS 3456
#define XB_SPIN_CAP (1u << 22)
#define LAS __attribute__((address_space(3)))
__device__ __forceinline__ unsigned xb_ld(unsigned* p) { return __hip_atomic_load(p, __ATOMIC_RELAXED, __HIP_MEMORY_SCOPE_AGENT); }
__device__ __forceinline__ unsigned xb_add(unsigned* p, unsigned v) { return __hip_atomic_fetch_add(p, v, __ATOMIC_RELAXED, __HIP_MEMORY_SCOPE_AGENT); }
__device__ __forceinline__ unsigned xb_xcc_id() { return (unsigned)__builtin_amdgcn_s_getreg((3 << 11) | 20) & 0xFu; }
#define XB_SPIN(cond, bar) do { unsigned _sp = 0; while (cond) { __builtin_amdgcn_s_sleep(1); \
    if ((++_sp & 255u) == 0u) { if (xb_ld(&(bar)[XB_TMO])) break; if (_sp > XB_SPIN_CAP) { atomicAdd(&(bar)[XB_TMO], 1u); break; } } } } while (0)
struct XcdBarrier { unsigned* bar; unsigned x; volatile unsigned* st; };
__device__ __forceinline__ XcdBarrier xcd_barrier_post(unsigned* bar, volatile unsigned* st) {
  XcdBarrier b; b.bar = bar; b.x = xb_xcc_id(); b.st = st;
  if (threadIdx.x == 0) (void)xb_add(&bar[XB_XCNT(b.x)], 1u);
  return b;
}
__device__ __forceinline__ void xcd_barrier_complete(unsigned* bar, unsigned x, unsigned& nloc, unsigned& nx) {
  const unsigned G = gridDim.x * gridDim.y * gridDim.z;
  unsigned sum, cnt, mine, sp = 0u;
  for (;;) {
    sum = 0u; cnt = 0u; mine = 0u;
#pragma unroll
    for (unsigned j = 0; j < 16; ++j) { const unsigned c = xb_ld(&bar[XB_XCNT(j)]); sum += c; cnt += (c > 0u) ? 1u : 0u; mine = (j == x) ? c : mine; }
    if (sum == G) break;
    __builtin_amdgcn_s_sleep(1);
    if ((++sp & 255u) == 0u) { if (xb_ld(&bar[XB_TMO])) break; if (sp > XB_SPIN_CAP) { atomicAdd(&bar[XB_TMO], 1u); break; } }
  }
  nloc = mine > 0u ? mine : 1u; nx = cnt > 0u ? cnt : 1u;
}
__device__ __attribute__((noinline)) void xcd_barrier_impl(unsigned* bar_, unsigned bx_, volatile unsigned* st_) {
  XcdBarrier b; b.bar = bar_; b.x = bx_; b.st = st_;
  asm volatile("s_waitcnt vmcnt(0)" ::: "memory");
  __syncthreads();
  if (threadIdx.x == 0) {
    unsigned* bar = b.bar;
    __builtin_amdgcn_s_waitcnt(0);
    unsigned nloc = b.st[0], nx = b.st[1];
    if (nloc == 0u) { xcd_barrier_complete(bar, b.x, nloc, nx); b.st[0] = nloc; b.st[1] = nx; }
    const unsigned old = xb_add(&bar[XB_XSUB(b.x)], 1u);
    const unsigned gen = old / nloc;
    if (old + 1u == (gen + 1u) * nloc) {
      __builtin_amdgcn_fence(__ATOMIC_RELEASE, "agent");
      asm volatile("s_waitcnt vmcnt(0)" ::: "memory");
      const unsigned og = xb_add(&bar[XB_TOP], 1u);
      const unsigned tg = og / nx;
      if (og + 1u == (tg + 1u) * nx) xb_add(&bar[XB_TOPGEN], 1u);
      else XB_SPIN(xb_ld(&bar[XB_TOPGEN]) == tg, bar);
      __builtin_amdgcn_fence(__ATOMIC_ACQUIRE, "agent");
      xb_add(&bar[XB_XGEN(b.x)], 1u);
      asm volatile("s_waitcnt vmcnt(0)" ::: "memory");
    } else {
      XB_SPIN(xb_ld(&bar[XB_XGEN(b.x)]) == gen, bar);
      __builtin_amdgcn_fence(__ATOMIC_ACQUIRE, "agent");
      asm volatile("s_waitcnt vmcnt(0)" ::: "memory");
    }
  }
  __syncthreads();
}
#define GSYNC() xcd_barrier_impl(xb.bar, xb.x, xb.st)
__global__ void __launch_bounds__(256, 2) hymba_megakernel(Params p, int ph_lo, int ph_hi) {
  cg::grid_group grid = cg::this_grid();
  __shared__ __attribute__((aligned(16))) char lds[65536];
  char* ws = p.ws;
  u16* abuf = (u16*)(ws + OFF_ABUF);
  u16* obuf = (u16*)(ws + OFF_OBUF);
  XcdBarrier xb; xb.bar = (unsigned*)(p.ws + OFF_BAR); xb.x = 0;
  xb.st = (volatile unsigned*)(p.ws + OFF_BAR) + 4096 + 2 * blockIdx.x;
  const bool fused = (ph_hi - ph_lo) > 1;
  if (fused) {
    xb = xcd_barrier_post((unsigned*)(p.ws + OFF_BAR), xb.st);
    grid.sync();
  }
  unsigned long long* tsp = (unsigned long long*)(p.ws + OFF_BAR + 24576);
  if (TIMING && blockIdx.x == 0 && threadIdx.x == 0) tsp[0] = __builtin_amdgcn_s_memrealtime();
  int pi = 0;
#define RUN (pi >= ph_lo && pi < ph_hi)
#define END_PHASE() do { if (pi >= ph_lo && pi + 1 < ph_hi) GSYNC(); if (TIMING && blockIdx.x == 0 && threadIdx.x == 0) tsp[pi + 1] = __builtin_amdgcn_s_memrealtime(); ++pi; } while (0)
  if (RUN && (PH & 1)) phase_convert(p, lds);
  if (RUN && (PH & 2)) phase_tables(p);
  if (RUN && (PH & 4)) phase_rows<0>(p, nullptr, p.g_pre_mix, true);
  END_PHASE();

  for (int l = 0; l < 2; ++l) {
    char* wb = ws + OFF_W + (size_t)l * W_LAYER;
    if (RUN && (PH & 8)) {
      EpiProjS e{(u16*)(ws + OX_PROJ), INW, (u16*)(ws + OX_VTS)};
      gemm_phase(abuf, DM, (const u16*)(wb + OW_IN), DM, INW, DM, lds, e, 0);
    }
    END_PHASE();
    if (STOP_AFTER == 1) { dump_bf16(p, (const u16*)(ws + OX_PROJ), INW, 0); return; }
    if (RUN && (PH & 32)) phase_ssm_a(p, l, lds);
    if (RUN && (PH & 64)) phase_mla_prep(p, l);
    END_PHASE();
    if (RUN && (PH & 128)) phase_ssm_c(p, l, lds);
    END_PHASE();
    if (RUN && (PH & 16)) for (int it = blockIdx.x; it < 4 * 8 * 33; it += gridDim.x) {
      const int qt = it / 32, r = it - qt * 32;
      attn_item<false, 2>(p, l, r >> 3, r & 7, qt, lds);
    }
    if (RUN && (PH & 256)) {
      EpiBf16 e{(u16*)(ws + OX_QMLA), 384, 384};
      gemm_phase((const u16*)(ws + OX_QN), 192, (const u16*)(wb + OW_UQ), 192, 384, 192, lds, e, 64);
    }
    if (RUN && (PH & 512)) {
      EpiKV e{nullptr, 0, (u16*)(ws + OX_KN), (u16*)(ws + OX_VTM)};
      gemm_phase((const u16*)(ws + OX_CN), 128, (const u16*)(wb + OW_UKV), 128, 512, 128, lds, e, 200);
    }
    END_PHASE();
    if (RUN && (PH & 1024)) {
      unsigned* ticket = (unsigned*)(ws + OFF_BAR) + 3600 + l;
      __shared__ int s_item;
      for (;;) {
        __syncthreads();
        if (threadIdx.x == 0) s_item = (int)atomicAdd(ticket, 1u);
        __syncthreads();
        const int it = s_item;
        if (it >= 4 * 4 * 65) break;
        const int qt = 64 - it / 16, r = it & 15;
        attn_item<true, 1>(p, l, r >> 2, r & 3, qt, lds);
      }
    }
    if (RUN && (PH & 2048)) {
      EpiGlu e{nullptr, 0, (const u16*)(ws + OX_Z), p.b_glu + (size_t)l * 256, (u16*)(ws + OX_YSSM)};
      gemm_phase((const u16*)(ws + OX_Z), 256, (const u16*)(wb + OW_GLU), 256, 256, 256, lds, e, 16);
    }
    END_PHASE();
    if (RUN && (PH & 4096)) phase_headnorm(p, l);
    END_PHASE();
    if (STOP_AFTER == 5) { dump_bf16(p, abuf, DM, 0); return; }
    if (RUN && (PH & 8192)) {
      EpiBf16 e{obuf, DM, DM};
      gemm_phase(abuf, DM, (const u16*)(wb + OW_OUT), DM, DM, DM, lds, e, 0);
    }
    END_PHASE();
    if (RUN && (PH & 16384)) {
      if (l == 0) phase_rows<2>(p, p.g_post_mix + (size_t)l * DM, p.g_pre_mlp + (size_t)l * DM, true);
      else phase_rows<1>(p, p.g_post_mix + (size_t)l * DM, p.g_pre_mlp + (size_t)l * DM, true);
    }
    END_PHASE();
    if (STOP_AFTER == 7) { dump_bf16(p, abuf, DM, 0); return; }
    if (RUN && (PH & 32768)) {
      EpiRelu2 e{(u16*)(ws + OFF_X), UPLD};
      gemm_phase(abuf, DM, (const u16*)(wb + OW_UP), DM, DFF, DM, lds, e, 0);
    }
    END_PHASE();
    if (RUN && (PH & 65536)) {
      EpiBf16 e{obuf, DM, DM};
      const u16* upA = (const u16*)(ws + OFF_X);
      const u16* wdn = (const u16*)(wb + OW_DN);
      const bool xmap = (gridDim.x & 7) == 0;
      const int xq = blockIdx.x & 7, xl = blockIdx.x >> 3, xn = gridDim.x >> 3;
      for (int item = blockIdx.x; item < 1024 + 64; item += gridDim.x) {
        if (item < 1024) {
          int tm = item >> 3, tn = item & 7;
          if (xmap) {
            const int r = item / gridDim.x;
            const int idx = xl + r * xn;
            if (idx < 128 && xn * ((1024 + gridDim.x - 1) / gridDim.x) >= 128) { tm = 2 * (idx >> 1) + (xq >> 2); tn = 2 * (xq & 3) + (idx & 1); }
          }
          gemm_tile(upA, UPLD, MTOK, wdn, DFF, DM, DFF, tm * 128, tn * 128, lds, e);
        } else {
          const int i2 = item - 1024, tn = i2 & 7, ks = i2 >> 3;
          EpiPart ep{(float*)(ws + OFF_PART) + (size_t)ks * 64 * 1024, nullptr, 0};
          gemm_tile(upA + ks * 512, UPLD, MTOK, wdn + ks * 512, DFF, DM, 512, 16384, tn * 128, lds, ep);
        }
      }
    }
    END_PHASE();
    if (STOP_AFTER == 9) { dump_bf16(p, obuf, DM, 0, 3); return; }
    if (RUN && (PH & 131072)) phase_rows<1>(p, p.g_post_mlp + (size_t)l * DM, p.g_pre_mix + (size_t)(l < 1 ? l + 1 : l) * DM, l < 1, (const float*)(ws + OFF_PART));
    if (l < 1) END_PHASE();
  }
  if (TIMING) {
    END_PHASE();
    if (blockIdx.x == 0) {
      __shared__ int n_pert;
      if (threadIdx.x == 0) {
        const float tot = (float)(tsp[pi] - tsp[0]);
        const float f1 = (float)(tsp[T1_HI] - tsp[T1_LO]) / tot;
        const float f2 = (float)(tsp[T2_HI] - tsp[T2_LO]) / tot;
        n_pert = (int)(f1 * 500000.f);
        p.out[0] += 0.2f + 0.15f * f2;
      }
      __syncthreads();
      for (int i = threadIdx.x; i < n_pert; i += 256) p.out[4096 + i] += 0.1f;
    }
  }
}

extern "C" void kernel_launch(void* const* d_in, const int* in_sizes, int n_in, void* d_out, int out_size, void* d_ws,
                              size_t ws_size, hipStream_t stream) {
  static int grid_blocks = 0;
  if (!grid_blocks) {
    int dev = 0, cus = 0, per_cu = 0;
    hipGetDevice(&dev);
    hipDeviceGetAttribute(&cus, hipDeviceAttributeMultiprocessorCount, dev);
    hipOccupancyMaxActiveBlocksPerMultiprocessor(&per_cu, hymba_megakernel, 256, 0);
    if (per_cu > 2) per_cu = 2;
    if (per_cu < 1) per_cu = 1;
    grid_blocks = cus * per_cu;
  }
  Params p{};
  const float** f = (const float**)&p;
  for (int i = 0; i < 27; ++i) f[i] = (const float*)d_in[i];
  p.out = (float*)d_out;
  p.ws = (char*)d_ws;
  hipMemsetAsync((char*)d_ws + OFF_BAR, 0, 32768, stream);
#ifndef N_LAUNCH_MODE
#define N_LAUNCH_MODE 1
#endif
  if (N_LAUNCH_MODE == 1) {
    int lo = 0, hi = 23 + (TIMING ? 1 : 0);
    void* args[] = {&p, &lo, &hi};
    hipError_t e = hipLaunchCooperativeKernel((void*)hymba_megakernel, dim3(grid_blocks), dim3(256), args, 0, stream);
    if (e != hipSuccess) fprintf(stderr, "cooperative launch failed: %s (grid %d)\n", hipGetErrorString(e), grid_blocks);
  } else {
    for (int i = 0; i < 23; ++i) hipLaunchKernelGGL(hymba_megakernel, dim3(grid_blocks), dim3(256), 0, stream, p, i, i + 1);
  }
}
```

```cpp
#include <hip/hip_runtime.h>
#include <hip/hip_cooperative_groups.h>
#include <cstdio>
#include <cstdint>
namespace cg = cooperative_groups;

typedef unsigned short u16;
using bf16x8 = __attribute__((ext_vector_type(8))) short;
using f32x4 = __attribute__((ext_vector_type(4))) float;

#define TPB 4112
#define MTOK 16448
#define MPAD 16512
#define DM 1024
#define INW 1376
#define DFF 4096
#define LT 4160
#define NCH 65
#ifndef PH
#define PH 0x3ffff
#endif
#ifndef TIMING
#define TIMING 0
#endif
#define T1_LO 6
#define T1_HI 9
#define T2_LO 0
#define T2_HI 1

constexpr size_t al256(size_t x) { return (x + 255) & ~(size_t)255; }
constexpr size_t cmax(size_t a, size_t b) { return a > b ? a : b; }
constexpr size_t OW_IN = 0;
constexpr size_t OW_OUT = OW_IN + (size_t)INW * DM * 2;
constexpr size_t OW_UP = OW_OUT + (size_t)DM * DM * 2;
constexpr size_t OW_DN = OW_UP + (size_t)DFF * DM * 2;
constexpr size_t OW_UQ = OW_DN + (size_t)DFF * DM * 2;
constexpr size_t OW_UKV = OW_UQ + (size_t)384 * 192 * 2;
constexpr size_t OW_GLU = OW_UKV + (size_t)512 * 128 * 2;
constexpr size_t W_LAYER = OW_GLU + (size_t)256 * 256 * 2;
constexpr size_t OFF_W = 0;
constexpr size_t OFF_ROPE = OFF_W + 2 * W_LAYER;
constexpr size_t OFF_LAM = OFF_ROPE + al256((size_t)TPB * 16 * 8);
constexpr size_t OFF_LAMT = OFF_LAM + 2 * 16 * 64 * 8;
constexpr size_t OFF_BB = OFF_LAMT + 2 * 16 * 64 * 8;
constexpr size_t OFF_BAR = OFF_BB + 2 * 16 * 32 * 64 * 4;
constexpr size_t OFF_HMETA = OFF_BAR + 32768;
constexpr size_t OFF_ABUF = OFF_HMETA + 4 * 16 * 1024 * 4;
constexpr size_t OFF_OBUF = OFF_ABUF + (size_t)MPAD * DM * 2;
constexpr size_t OFF_X = OFF_OBUF + (size_t)MPAD * DM * 2;
constexpr size_t OX_PROJ = OFF_X;
constexpr size_t OX_Z = OX_PROJ + (size_t)MPAD * INW * 2;
constexpr size_t OX_YSSM = OX_Z + (size_t)MPAD * 256 * 2;
constexpr size_t OX_YSWA = OX_YSSM + (size_t)MPAD * 256 * 2;
constexpr size_t OX_YMLA = OX_YSWA + (size_t)MPAD * 512 * 2;
constexpr size_t OX_QN = OX_YMLA + (size_t)MPAD * 256 * 2;
constexpr size_t OX_CN = OX_QN + (size_t)MPAD * 192 * 2;
constexpr size_t OX_KR = OX_CN + (size_t)MPAD * 128 * 2;
constexpr size_t OX_QMLA = OX_KR + (size_t)MPAD * 32 * 2;
constexpr size_t OX_KN = OX_QMLA + (size_t)MPAD * 384 * 2;
constexpr size_t OX_VTM = OX_KN + (size_t)MPAD * 256 * 2;
constexpr size_t OX_VTS = OX_VTM + (size_t)4 * 4 * 64 * LT * 2;
constexpr size_t OX_END = OX_VTS + (size_t)4 * 2 * 64 * LT * 2;
constexpr size_t OX_LAST = OX_END + (size_t)4 * 16 * NCH * 64 * 8;
#define UPLD 4160
constexpr size_t OFF_END2 = cmax(OX_LAST, OFF_X + (size_t)MPAD * UPLD * 2);
constexpr size_t END_BYTES = (size_t)4 * 16 * NCH * 64 * 8;
constexpr size_t OFF_PART = OFF_END2 + 2 * END_BYTES;
constexpr size_t WS_TOTAL = OFF_PART + (size_t)8 * 64 * 1024 * 4;
static_assert(WS_TOTAL <= (size_t)256 * 1024 * 1024, "workspace too large");

struct Params {
  const float* x; const float* meta; const float* g_pre_mix; const float* g_post_mix; const float* g_pre_mlp;
  const float* g_post_mlp; const float* w_in; const float* w_out; const float* g_heads; const float* a_re;
  const float* a_im; const float* log_step; const float* b_re; const float* b_im; const float* c_re; const float* c_im;
  const float* d_skip; const float* w_glu; const float* b_glu; const float* sinks; const float* g_q; const float* g_kv;
  const float* w_uq; const float* w_uk; const float* w_uv; const float* w_up; const float* w_down;
  float* out; char* ws;
};

__device__ __forceinline__ unsigned pack2(float a, float b) {
  unsigned r;
  asm("v_cvt_pk_bf16_f32 %0, %1, %2" : "=v"(r) : "v"(a), "v"(b));
  return r;
}
__device__ __forceinline__ u16 f2bf(float f) { return (u16)(pack2(f, f) & 0xffffu); }
__device__ __forceinline__ float bf2f(u16 h) { return __uint_as_float(((unsigned)h) << 16); }
__device__ __forceinline__ float bflo(unsigned u) { return __uint_as_float(u << 16); }
__device__ __forceinline__ float bfhi(unsigned u) { return __uint_as_float(u & 0xffff0000u); }
__device__ __forceinline__ float wave_sum(float v) {
#pragma unroll
  for (int o = 32; o; o >>= 1) v += __shfl_xor(v, o);
  return v;
}
__device__ __forceinline__ float fexp2(float x) { return __builtin_amdgcn_exp2f(x); }
__device__ __forceinline__ int otid() { int t = threadIdx.x; asm volatile("" : "+v"(t)); return t; }

struct Mat { const float* src; u16* dst; int K, N; };
__device__ __forceinline__ Mat get_mat(const Params& p, int idx) {
  int l = idx >> 3, t = idx & 7;
  char* wb = p.ws + OFF_W + (size_t)l * W_LAYER;
  Mat m;
  if (t == 0) { m.src = p.w_in + (size_t)l * DM * INW; m.dst = (u16*)(wb + OW_IN); m.K = DM; m.N = INW; }
  else if (t == 1) { m.src = p.w_out + (size_t)l * DM * DM; m.dst = (u16*)(wb + OW_OUT); m.K = DM; m.N = DM; }
  else if (t == 2) { m.src = p.w_up + (size_t)l * DM * DFF; m.dst = (u16*)(wb + OW_UP); m.K = DM; m.N = DFF; }
  else if (t == 3) { m.src = p.w_down + (size_t)l * DFF * DM; m.dst = (u16*)(wb + OW_DN); m.K = DFF; m.N = DM; }
  else if (t == 4) { m.src = p.w_uq + (size_t)l * 192 * 384; m.dst = (u16*)(wb + OW_UQ); m.K = 192; m.N = 384; }
  else if (t == 5) { m.src = p.w_uk + (size_t)l * 128 * 256; m.dst = (u16*)(wb + OW_UKV); m.K = 128; m.N = 256; }
  else if (t == 6) { m.src = p.w_uv + (size_t)l * 128 * 256; m.dst = (u16*)(wb + OW_UKV) + 256 * 128; m.K = 128; m.N = 256; }
  else { m.src = p.w_glu + (size_t)l * 256 * 256; m.dst = (u16*)(wb + OW_GLU); m.K = 256; m.N = 256; }
  return m;
}

__device__ void phase_convert(const Params& p, char* lds) {
  float* tl = (float*)lds;
  const int tid = otid();
  int base = 0;
  for (int mi = 0; mi < 16; ++mi) {
    Mat mt = get_mat(p, mi);
    const int tn = mt.N >> 5, tk = mt.K >> 6, nt = tn * tk;
    int first = (int)(((long)blockIdx.x - base) % (long)gridDim.x);
    if (first < 0) first += gridDim.x;
    for (int i = first; i < nt; i += gridDim.x) {
      const int kt = i / tn, ntile = i - kt * tn;
      const int k0 = kt * 64, n0 = ntile * 32;
      {
        const int r = tid >> 3, c4 = (tid & 7) * 4;
#pragma unroll
        for (int j = 0; j < 2; ++j) {
          float4 v = *(const float4*)(mt.src + (size_t)(k0 + r + 32 * j) * mt.N + n0 + c4);
          float* d = tl + (r + 32 * j) * 33 + c4;
          d[0] = v.x; d[1] = v.y; d[2] = v.z; d[3] = v.w;
        }
      }
      __syncthreads();
      {
        const int n = tid >> 3, kc = (tid & 7) * 8;
        unsigned w[4];
#pragma unroll
        for (int e = 0; e < 4; ++e) w[e] = pack2(tl[(kc + 2 * e) * 33 + n], tl[(kc + 2 * e + 1) * 33 + n]);
        *(uint4*)(mt.dst + (size_t)(n0 + n) * mt.K + k0 + kc) = make_uint4(w[0], w[1], w[2], w[3]);
      }
      __syncthreads();
    }
    base += nt;
  }
}

__device__ void phase_tables(const Params& p) {
  const int gt = blockIdx.x * 256 + otid(), nthr = gridDim.x * 256;
  float2* rope = (float2*)(p.ws + OFF_ROPE);
  for (int i = gt; i < TPB * 16; i += nthr) {
    int t = i >> 4, f = i & 15;
    float inv = powf(10000.f, -(float)f / 16.f);
    float ang = (float)t * inv;
    double rev = (double)ang * 0.15915494309189535;
    rev -= rint(rev);
    float fr = (float)rev;
    rope[i] = make_float2(__builtin_amdgcn_cosf(fr), __builtin_amdgcn_sinf(fr));
  }
  float2* lam = (float2*)(p.ws + OFF_LAM);
  float2* lamT = (float2*)(p.ws + OFF_LAMT);
  float* bb = (float*)(p.ws + OFF_BB);
  for (int i = gt; i < 2 * 16 * 64; i += nthr) {
    int lg = i >> 6, s = i & 63;
    float step = expf(p.log_step[lg]);
    float ar = p.a_re[i], ai = p.a_im[i];
    float mag = expf(ar * step);
    float th = ai * step;
    float lr = mag * cosf(th), li = mag * sinf(th);
    lam[i] = make_float2(lr, li);
    float pr = lr, pi = li;
#pragma unroll
    for (int q = 0; q < 6; ++q) { float nr2 = pr * pr - pi * pi, ni2 = 2.f * pr * pi; pr = nr2; pi = ni2; }
    lamT[i] = make_float2(pr, pi);
    float den = ar * ar + ai * ai;
    float nr = lr - 1.f, ni = li;
    float cr = (nr * ar + ni * ai) / den, ci = (ni * ar - nr * ai) / den;
    const float* brp = p.b_re + (size_t)i * 16;
    const float* bip = p.b_im + (size_t)i * 16;
#pragma unroll
    for (int c = 0; c < 16; ++c) {
      float br = brp[c], bi = bip[c];
      bb[((size_t)lg * 32 + 2 * c) * 64 + s] = cr * br - ci * bi;
      bb[((size_t)lg * 32 + 2 * c + 1) * 64 + s] = cr * bi + ci * br;
    }
  }
}

__device__ __forceinline__ float* h_row(const Params& p, int m) {
  const int b = m / TPB, t = m - b * TPB;
  return t < 16 ? (float*)(p.ws + OFF_HMETA) + (size_t)(b * 16 + t) * DM : p.out + ((size_t)b * 4096 + (t - 16)) * DM;
}
template <int MODE>
__device__ void phase_rows(const Params& p, const float* gpost, const float* gnext, bool has_next, const float* part = nullptr) {
  const int tid_ = otid();
  const int lane = tid_ & 63;
  const int wg = blockIdx.x * 4 + (tid_ >> 6), nw = gridDim.x * 4;
  u16* abuf = (u16*)(p.ws + OFF_ABUF);
  const u16* obuf = (const u16*)(p.ws + OFF_OBUF);
  for (int mb = wg; mb < MTOK; mb += 2 * nw) {
    int mr[2]; bool ok[2]; float* hr[2];
    float4 v[2][4]; uint2 ob[2][4];
#pragma unroll
    for (int r = 0; r < 2; ++r) {
      mr[r] = mb + r * nw; ok[r] = mr[r] < MTOK;
      const int mm = ok[r] ? mr[r] : mb;
      hr[r] = h_row(p, mm);
      if (MODE == 0) {
        const int b = mm / TPB, t = mm - b * TPB;
        const float* src = t < 16 ? p.meta + (size_t)t * DM : p.x + ((size_t)b * 4096 + (t - 16)) * DM;
#pragma unroll
        for (int j = 0; j < 4; ++j) v[r][j] = *(const float4*)(src + j * 256 + lane * 4);
      } else {
        const float* hsrc = hr[r];
        if (MODE == 2) {
          const int b2 = mm / TPB, t2 = mm - b2 * TPB;
          hsrc = t2 < 16 ? p.meta + (size_t)t2 * DM : p.x + ((size_t)b2 * 4096 + (t2 - 16)) * DM;
        }
#pragma unroll
        for (int j = 0; j < 4; ++j) {
          ob[r][j] = *(const uint2*)(obuf + (size_t)mm * DM + j * 256 + lane * 4);
          v[r][j] = *(const float4*)(hsrc + j * 256 + lane * 4);
        }
        if (part != nullptr && mm >= 16384) {
#pragma unroll
          for (int j = 0; j < 4; ++j) {
            float4 a = make_float4(0.f, 0.f, 0.f, 0.f);
#pragma unroll
            for (int ks = 0; ks < 8; ++ks) {
              const float4 q = *(const float4*)(part + ((size_t)ks * 64 + (mm - 16384)) * 1024 + j * 256 + lane * 4);
              a.x += q.x; a.y += q.y; a.z += q.z; a.w += q.w;
            }
            ob[r][j].x = pack2(a.x, a.y); ob[r][j].y = pack2(a.z, a.w);
          }
        }
      }
    }
#pragma unroll
    for (int r = 0; r < 2; ++r) {
      if (MODE >= 1) {
        float4 o[4];
        float ss = 0.f;
#pragma unroll
        for (int j = 0; j < 4; ++j) {
          o[j] = make_float4(bflo(ob[r][j].x), bfhi(ob[r][j].x), bflo(ob[r][j].y), bfhi(ob[r][j].y));
          ss += o[j].x * o[j].x + o[j].y * o[j].y + o[j].z * o[j].z + o[j].w * o[j].w;
        }
        ss = wave_sum(ss);
        const float rs = rsqrtf(ss * (1.f / 1024.f) + 1e-6f);
#pragma unroll
        for (int j = 0; j < 4; ++j) {
          const float4 hv = v[r][j];
          const float4 g = *(const float4*)(gpost + j * 256 + lane * 4);
          v[r][j] = make_float4(hv.x + o[j].x * rs * g.x, hv.y + o[j].y * rs * g.y, hv.z + o[j].z * rs * g.z,
                                hv.w + o[j].w * rs * g.w);
        }
      }
      if (MODE != 0 && ok[r]) {
#pragma unroll
        for (int j = 0; j < 4; ++j) *(float4*)(hr[r] + j * 256 + lane * 4) = v[r][j];
      }
      if (has_next) {
        float ss = 0.f;
#pragma unroll
        for (int j = 0; j < 4; ++j)
          ss += v[r][j].x * v[r][j].x + v[r][j].y * v[r][j].y + v[r][j].z * v[r][j].z + v[r][j].w * v[r][j].w;
        ss = wave_sum(ss);
        const float rs = rsqrtf(ss * (1.f / 1024.f) + 1e-6f);
        if (ok[r]) {
#pragma unroll
          for (int j = 0; j < 4; ++j) {
            const float4 g = *(const float4*)(gnext + j * 256 + lane * 4);
            uint2 w;
            w.x = pack2(v[r][j].x * rs * g.x, v[r][j].y * rs * g.y);
            w.y = pack2(v[r][j].z * rs * g.z, v[r][j].w * rs * g.w);
            *(uint2*)(abuf + (size_t)mr[r] * DM + j * 256 + lane * 4) = w;
          }
        }
      }
    }
  }
}

__device__ void phase_headnorm(const Params& p, int l) {
  const int tid_ = otid();
  const int lane = tid_ & 63;
  const int wg = blockIdx.x * 4 + (tid_ >> 6), nw = gridDim.x * 4;
  u16* abuf = (u16*)(p.ws + OFF_ABUF);
  const u16* yssm = (const u16*)(p.ws + OX_YSSM);
  const u16* yswa = (const u16*)(p.ws + OX_YSWA);
  const u16* ymla = (const u16*)(p.ws + OX_YMLA);
  const float* gh = p.g_heads + (size_t)l * 1024;
  const float4 g1 = *(const float4*)(gh + lane * 4);
  const float4 g2a = *(const float4*)(gh + 256 + lane * 8);
  const float4 g2b = *(const float4*)(gh + 256 + lane * 8 + 4);
  const float4 g3 = *(const float4*)(gh + 768 + lane * 4);
  for (int mb = wg; mb < MTOK; mb += 2 * nw) {
    uint2 ar[2]; uint4 sr[2]; uint2 cr[2]; int mrow[2]; bool ok[2];
#pragma unroll
    for (int r = 0; r < 2; ++r) {
      mrow[r] = mb + r * nw; ok[r] = mrow[r] < MTOK;
      const int m = ok[r] ? mrow[r] : mb;
      ar[r] = *(const uint2*)(yssm + (size_t)m * 256 + lane * 4);
      sr[r] = *(const uint4*)(yswa + (size_t)m * 512 + lane * 8);
      cr[r] = *(const uint2*)(ymla + (size_t)m * 256 + lane * 4);
    }
#pragma unroll
    for (int r = 0; r < 2; ++r) {
      const uint2 a = ar[r]; const uint4 s = sr[r]; const uint2 c = cr[r];
      float av[4] = {bflo(a.x), bfhi(a.x), bflo(a.y), bfhi(a.y)};
      float sv[8] = {bflo(s.x), bfhi(s.x), bflo(s.y), bfhi(s.y), bflo(s.z), bfhi(s.z), bflo(s.w), bfhi(s.w)};
      float cv[4] = {bflo(c.x), bfhi(c.x), bflo(c.y), bfhi(c.y)};
      float s1 = 0.f, s2 = 0.f, s3 = 0.f;
#pragma unroll
      for (int e = 0; e < 4; ++e) { s1 += av[e] * av[e]; s3 += cv[e] * cv[e]; }
#pragma unroll
      for (int e = 0; e < 8; ++e) s2 += sv[e] * sv[e];
      s1 = wave_sum(s1); s2 = wave_sum(s2); s3 = wave_sum(s3);
      const float r1 = rsqrtf(s1 * (1.f / 256.f) + 1e-6f);
      const float r2 = rsqrtf(s2 * (1.f / 512.f) + 1e-6f);
      const float r3 = rsqrtf(s3 * (1.f / 256.f) + 1e-6f);
      if (ok[r]) {
        u16* dst = abuf + (size_t)mrow[r] * DM;
        uint2 w1; w1.x = pack2(av[0] * r1 * g1.x, av[1] * r1 * g1.y); w1.y = pack2(av[2] * r1 * g1.z, av[3] * r1 * g1.w);
        *(uint2*)(dst + lane * 4) = w1;
        uint4 w2;
        w2.x = pack2(sv[0] * r2 * g2a.x, sv[1] * r2 * g2a.y); w2.y = pack2(sv[2] * r2 * g2a.z, sv[3] * r2 * g2a.w);
        w2.z = pack2(sv[4] * r2 * g2b.x, sv[5] * r2 * g2b.y); w2.w = pack2(sv[6] * r2 * g2b.z, sv[7] * r2 * g2b.w);
        *(uint4*)(dst + 256 + lane * 8) = w2;
        uint2 w3; w3.x = pack2(cv[0] * r3 * g3.x, cv[1] * r3 * g3.y); w3.y = pack2(cv[2] * r3 * g3.z, cv[3] * r3 * g3.w);
        *(uint2*)(dst + 768 + lane * 4) = w3;
      }
    }
  }
}

__device__ void phase_mla_prep(const Params& p, int l) {
  const int tid_ = otid();
  const int lane = tid_ & 63;
  const int wg = blockIdx.x * 4 + (tid_ >> 6), nw = gridDim.x * 4;
  const u16* proj = (const u16*)(p.ws + OX_PROJ);
  u16* qn = (u16*)(p.ws + OX_QN);
  u16* cn = (u16*)(p.ws + OX_CN);
  u16* kr = (u16*)(p.ws + OX_KR);
  const float2* rope = (const float2*)(p.ws + OFF_ROPE);
  const float* gq = p.g_q + (size_t)l * 192;
  const float* gkv = p.g_kv + (size_t)l * 128;
  const int role = lane < 24 ? 0 : (lane < 40 ? 1 : (lane < 44 ? 2 : 3));
  const int eoff = role == 0 ? 1024 + lane * 8 : (role == 1 ? 1216 + (lane - 24) * 8 : (role == 2 ? 1344 + (lane - 40) * 8 : 1024));
  float gv[8];
#pragma unroll
  for (int e = 0; e < 8; ++e) gv[e] = role == 0 ? gq[lane * 8 + e] : (role == 1 ? gkv[(lane - 24) * 8 + e] : 0.f);
  for (int mb = wg; mb < MTOK; mb += 2 * nw) {
    uint4 raw[2]; int mrow[2]; bool ok[2];
#pragma unroll
    for (int r = 0; r < 2; ++r) {
      mrow[r] = mb + r * nw; ok[r] = mrow[r] < MTOK;
      const int m = ok[r] ? mrow[r] : mb;
      raw[r] = *(const uint4*)(proj + (size_t)m * INW + eoff);
    }
#pragma unroll
    for (int r = 0; r < 2; ++r) {
      const int m = ok[r] ? mrow[r] : mb;
      const int bb = m / TPB, t = m - bb * TPB;
      const unsigned wv[4] = {raw[r].x, raw[r].y, raw[r].z, raw[r].w};
      float v[8];
#pragma unroll
      for (int e = 0; e < 4; ++e) { v[2 * e] = bflo(wv[e]); v[2 * e + 1] = bfhi(wv[e]); }
      float ss = 0.f;
#pragma unroll
      for (int e = 0; e < 8; ++e) ss += v[e] * v[e];
      const float sq = wave_sum(role == 0 ? ss : 0.f);
      const float sc = wave_sum(role == 1 ? ss : 0.f);
      const float rq = rsqrtf(sq * (1.f / 192.f) + 1e-6f);
      const float rc = rsqrtf(sc * (1.f / 128.f) + 1e-6f);
      unsigned pw[4];
#pragma unroll
      for (int e = 0; e < 4; ++e) pw[e] = (unsigned)__shfl((int)wv[e], lane ^ 2);
      uint4 outv;
      if (role == 2) {
        const int i0 = ((lane - 40) & 1) * 8;
        const bool first = lane < 42;
        unsigned ow[4];
#pragma unroll
        for (int e = 0; e < 4; ++e) {
          const float2 ca = rope[t * 16 + i0 + 2 * e], cb = rope[t * 16 + i0 + 2 * e + 1];
          const float pa = bflo(pw[e]), pb = bfhi(pw[e]);
          float ra, rb;
          if (first) { ra = v[2 * e] * ca.x - pa * ca.y; rb = v[2 * e + 1] * cb.x - pb * cb.y; }
          else { ra = pa * ca.y + v[2 * e] * ca.x; rb = pb * cb.y + v[2 * e + 1] * cb.x; }
          ow[e] = pack2(ra, rb);
        }
        outv = make_uint4(ow[0], ow[1], ow[2], ow[3]);
      } else {
        const float rs = role == 0 ? rq : rc;
        outv = make_uint4(pack2(v[0] * rs * gv[0], v[1] * rs * gv[1]), pack2(v[2] * rs * gv[2], v[3] * rs * gv[3]),
                          pack2(v[4] * rs * gv[4], v[5] * rs * gv[5]), pack2(v[6] * rs * gv[6], v[7] * rs * gv[7]));
      }
      if (ok[r]) {
        if (role == 0) *(uint4*)(qn + (size_t)m * 192 + lane * 8) = outv;
        else if (role == 1) *(uint4*)(cn + (size_t)m * 128 + (lane - 24) * 8) = outv;
        else if (role == 2) *(uint4*)(kr + (size_t)m * 32 + (lane - 40) * 8) = outv;
      }
    }
  }
}

template <class Epi>
__device__ __forceinline__ void gemm_tile(const u16* __restrict__ A, int lda, int Mrows, const u16* __restrict__ Bt,
                                          int ldb, int Nrows, int K, int m0, int n0, char* lds, Epi& epi) {
  const int tid = otid(), lane = tid & 63, wid = tid >> 6, wm = wid >> 1, wn = wid & 1;
  const int lr = lane & 15, lg = lane >> 4;
  const int lrow = tid >> 3, lkc = tid & 7;
  const int wsw = (lrow >> 1) & 7;
  const u16* ap[4];
  const u16* bp[4];
#pragma unroll
  for (int j = 0; j < 4; ++j) {
    int ra = m0 + lrow + 32 * j; ra = ra < Mrows ? ra : Mrows - 1;
    int rb = n0 + lrow + 32 * j; rb = rb < Nrows ? rb : Nrows - 1;
    ap[j] = A + (size_t)ra * lda + lkc * 8;
    bp[j] = Bt + (size_t)rb * ldb + lkc * 8;
  }
  f32x4 acc[4][4];
#pragma unroll
  for (int i = 0; i < 4; ++i)
#pragma unroll
    for (int j = 0; j < 4; ++j) acc[i][j] = (f32x4){0.f, 0.f, 0.f, 0.f};
  typedef unsigned u32x4 __attribute__((ext_vector_type(4)));
  u32x4 a0[4], b0[4], a1[4], b1[4];
  const int nk = K >> 6;
  const int rsw = (lr >> 1) & 7;
  const int woff = lrow * 128 + ((lkc ^ wsw) << 4);
#define GEMM_ISSUE(SA, SB, KT)                                                                     \
  {                                                                                                \
    const int kn_ = ((KT) < nk) ? (KT) : nk - 1;                                                   \
    _Pragma("unroll") for (int j = 0; j < 4; ++j) {                                                \
      const u16* pa_ = ap[j] + kn_ * 64;                                                           \
      const u16* pb_ = bp[j] + kn_ * 64;                                                           \
      asm volatile("global_load_dwordx4 %0, %1, off" : "=&v"(SA[j]) : "v"(pa_) : "memory");        \
      asm volatile("global_load_dwordx4 %0, %1, off" : "=&v"(SB[j]) : "v"(pb_) : "memory");        \
    }                                                                                              \
  }
#define GEMM_WRITE(SA, SB, BUF)                                                                    \
  {                                                                                                \
    char* da_ = lds + (BUF) * 32768 + woff;                                                        \
    _Pragma("unroll") for (int j = 0; j < 4; ++j) {                                                \
      *(u32x4*)(da_ + j * 4096) = SA[j];                                                           \
      *(u32x4*)(da_ + 16384 + j * 4096) = SB[j];                                                   \
    }                                                                                              \
  }
#define GEMM_COMPUTE(BUF)                                                                          \
  {                                                                                                \
    const char* sa_ = lds + (BUF) * 32768 + (wm * 64 + lr) * 128;                                  \
    const char* sb_ = lds + (BUF) * 32768 + 16384 + (wn * 64 + lr) * 128;                          \
    bf16x8 af[2][4], bfr[2][4];                                                                    \
    _Pragma("unroll") for (int kk = 0; kk < 2; ++kk) {                                             \
      const int co = ((kk * 4 + lg) ^ rsw) << 4;                                                   \
      _Pragma("unroll") for (int i = 0; i < 4; ++i) af[kk][i] = *(const bf16x8*)(sa_ + i * 2048 + co); \
      _Pragma("unroll") for (int j = 0; j < 4; ++j) bfr[kk][j] = *(const bf16x8*)(sb_ + j * 2048 + co);\
    }                                                                                              \
    _Pragma("unroll") for (int kk = 0; kk < 2; ++kk) {                                             \
      _Pragma("unroll") for (int i = 0; i < 4; ++i)                                                \
        _Pragma("unroll") for (int j = 0; j < 4; ++j)                                              \
          acc[i][j] = Epi::STAGED ? __builtin_amdgcn_mfma_f32_16x16x32_bf16(bfr[kk][j], af[kk][i], acc[i][j], 0, 0, 0) \
                                  : __builtin_amdgcn_mfma_f32_16x16x32_bf16(af[kk][i], bfr[kk][j], acc[i][j], 0, 0, 0); \
    }                                                                                              \
      \
    __builtin_amdgcn_sched_group_barrier(0x100, 8, 0);                                             \
    _Pragma("unroll") for (int q_ = 0; q_ < 8; ++q_) {                                             \
      __builtin_amdgcn_sched_group_barrier(0x008, 2, 0);                                           \
      __builtin_amdgcn_sched_group_barrier(0x100, 1, 0);                                           \
    }                                                                                              \
    __builtin_amdgcn_sched_group_barrier(0x008, 16, 0);                                            \
  }
  GEMM_ISSUE(a0, b0, 0)
  GEMM_ISSUE(a1, b1, 1)
  asm volatile("s_waitcnt vmcnt(8)" ::: "memory");
  GEMM_WRITE(a0, b0, 0)
  __syncthreads();
  for (int kt = 0; kt < nk; kt += 2) {
    GEMM_ISSUE(a0, b0, kt + 2)
    GEMM_COMPUTE(0)
    asm volatile("s_waitcnt vmcnt(8)" ::: "memory");
    GEMM_WRITE(a1, b1, 1)
    __syncthreads();
    if (kt + 1 < nk) {
      GEMM_ISSUE(a1, b1, kt + 3)
      GEMM_COMPUTE(1)
      asm volatile("s_waitcnt vmcnt(8)" ::: "memory");
      GEMM_WRITE(a0, b0, 0)
      __syncthreads();
    }
  }
  asm volatile("s_waitcnt vmcnt(0)" ::: "memory");
#pragma unroll
  for (int j = 0; j < 4; ++j) asm volatile("" :: "v"(a0[j]), "v"(b0[j]), "v"(a1[j]), "v"(b1[j]));
#undef GEMM_ISSUE
#undef GEMM_WRITE
#undef GEMM_COMPUTE
  if (Epi::ACT == 3) {
    if (wm == 0) {
#pragma unroll
      for (int i = 0; i < 4; ++i)
#pragma unroll
        for (int j = 0; j < 4; ++j)
          *(f32x4*)(epi.partp() + (size_t)(i * 16 + lr) * 1024 + n0 + wn * 64 + j * 16 + 4 * lg) = acc[i][j];
    }
  } else if (Epi::STAGED) {
#pragma unroll
    for (int i = 0; i < 4; ++i)
#pragma unroll
      for (int j = 0; j < 4; ++j) {
        f32x4 v = acc[i][j];
        if (Epi::ACT == 1) {
#pragma unroll
          for (int r = 0; r < 4; ++r) { float x = fmaxf(v[r], 0.f); v[r] = x * x; }
        }
        uint2 w; w.x = pack2(v[0], v[1]); w.y = pack2(v[2], v[3]);
        *(uint2*)(lds + (wm * 64 + i * 16 + lr) * 272 + (wn * 64 + j * 16 + 4 * lg) * 2) = w;
      }
    __syncthreads();
    if (!(Epi::HASVT && n0 == 896)) {
#pragma unroll
      for (int q = 0; q < 8; ++q) {
        const int c = tid + 256 * q;
        const int row = c >> 4, cc = c & 15;
        if (m0 + row < Mrows && n0 + cc * 8 < Nrows)
          *(uint4*)(epi.C + (size_t)(m0 + row) * epi.ldc + n0 + cc * 8) = *(const uint4*)(lds + row * 272 + cc * 16);
      }
    } else {
#pragma unroll
      for (int q = 0; q < 8; ++q) {
        const int id = tid + 256 * q;
        const int rg = id & 15, col = id >> 4;
        const int m = m0 + rg * 8;
        if (m < Mrows) {
          unsigned short e8[8];
#pragma unroll
          for (int e = 0; e < 8; ++e) e8[e] = *(const unsigned short*)(lds + (rg * 8 + e) * 272 + col * 2);
          const int bb = m / TPB, t = m - bb * TPB;
          uint4 val = make_uint4((unsigned)e8[0] | ((unsigned)e8[1] << 16), (unsigned)e8[2] | ((unsigned)e8[3] << 16),
                                 (unsigned)e8[4] | ((unsigned)e8[5] << 16), (unsigned)e8[6] | ((unsigned)e8[7] << 16));
          *(uint4*)(epi.vtp() + ((size_t)(bb * 2 + (col >> 6)) * 64 + (col & 63)) * LT + t) = val;
        }
      }
    }
    __syncthreads();
  } else {
#pragma unroll
    for (int i = 0; i < 4; ++i)
#pragma unroll
      for (int j = 0; j < 4; ++j)
        epi(m0 + wm * 64 + i * 16 + 4 * lg, n0 + wn * 64 + j * 16 + lr, acc[i][j]);
  }
}

template <class Epi>
__device__ __forceinline__ void gemm_phase(const u16* A, int lda, const u16* Bt, int ldb, int N, int K, char* lds,
                                           Epi epi, int rot, int tilesM = 129, int tileLo = 0, bool rev = false) {
  const int tilesN = (N + 127) >> 7;
  const int total = tilesM * tilesN;
  int start = (int)((blockIdx.x + gridDim.x - (rot % gridDim.x)) % gridDim.x) + tileLo * tilesN;
  for (int tile = start; tile < total; tile += gridDim.x) {
    int tm = tile / tilesN; const int tn = tile - tm * tilesN;
    if (rev) tm = 128 - tm;
    gemm_tile(A, lda, MTOK, Bt, ldb, N, K, tm * 128, tn * 128, lds, epi);
  }
}

struct EpiBf16 {
  static constexpr bool STAGED = true; static constexpr int ACT = 0; static constexpr bool HASVT = false;
  __device__ __forceinline__ u16* vtp() const { return nullptr; }
  __device__ __forceinline__ float* partp() const { return nullptr; }
  u16* C; int ldc; int N;
  __device__ __forceinline__ void operator()(int m, int n, f32x4 v) const {
    if (n < N) {
#pragma unroll
      for (int r = 0; r < 4; ++r) if (m + r < MTOK) C[(size_t)(m + r) * ldc + n] = f2bf(v[r]);
    }
  }
};
struct EpiPart {
  static constexpr bool STAGED = true; static constexpr int ACT = 3; static constexpr bool HASVT = false;
  float* part; u16* C; int ldc;
  __device__ __forceinline__ u16* vtp() const { return nullptr; }
  __device__ __forceinline__ float* partp() const { return part; }
  __device__ __forceinline__ void operator()(int, int, f32x4) const {}
};
struct EpiProjS {
  static constexpr bool STAGED = true; static constexpr int ACT = 0; static constexpr bool HASVT = true;
  u16* C; int ldc; u16* vts;
  __device__ __forceinline__ u16* vtp() const { return vts; }
  __device__ __forceinline__ float* partp() const { return nullptr; }
  __device__ __forceinline__ void operator()(int, int, f32x4) const {}
};
struct EpiRelu2 {
  static constexpr bool STAGED = true; static constexpr int ACT = 1; static constexpr bool HASVT = false;
  __device__ __forceinline__ u16* vtp() const { return nullptr; }
  __device__ __forceinline__ float* partp() const { return nullptr; }
  u16* C; int ldc;
  __device__ __forceinline__ void operator()(int m, int n, f32x4 v) const {
#pragma unroll
    for (int r = 0; r < 4; ++r) if (m + r < MTOK) { float x = fmaxf(v[r], 0.f); C[(size_t)(m + r) * ldc + n] = f2bf(x * x); }
  }
};
struct EpiProj {
  static constexpr bool HASVT = false;
  __device__ __forceinline__ u16* vtp() const { return nullptr; }
  __device__ __forceinline__ float* partp() const { return nullptr; }
  static constexpr bool STAGED = false; static constexpr int ACT = 0;
  u16* C; int ldc;
  u16* proj; u16* vts;
  __device__ __forceinline__ void operator()(int m, int n, f32x4 v) const {
    if (n < INW && m < MTOK) {
#pragma unroll
      for (int r = 0; r < 4; ++r) proj[(size_t)(m + r) * INW + n] = f2bf(v[r]);
      if (n >= 896 && n < 1024) {
        const int kvh = (n - 896) >> 6, d = (n - 896) & 63;
        const int b = m / TPB, t = m - b * TPB;
        uint2 w; w.x = pack2(v[0], v[1]); w.y = pack2(v[2], v[3]);
        *(uint2*)(vts + ((size_t)(b * 2 + kvh) * 64 + d) * LT + t) = w;
      }
    }
  }
};
struct EpiKV {
  static constexpr bool HASVT = false;
  __device__ __forceinline__ u16* vtp() const { return nullptr; }
  __device__ __forceinline__ float* partp() const { return nullptr; }
  static constexpr bool STAGED = false; static constexpr int ACT = 0;
  u16* C; int ldc;
  u16* kn; u16* vtm;
  __device__ __forceinline__ void operator()(int m, int n, f32x4 v) const {
    if (m < MTOK) {
      if (n < 256) {
#pragma unroll
        for (int r = 0; r < 4; ++r) kn[(size_t)(m + r) * 256 + n] = f2bf(v[r]);
      } else {
        const int h = (n - 256) >> 6, d = (n - 256) & 63;
        const int b = m / TPB, t = m - b * TPB;
        uint2 w; w.x = pack2(v[0], v[1]); w.y = pack2(v[2], v[3]);
        *(uint2*)(vtm + ((size_t)(b * 4 + h) * 64 + d) * LT + t) = w;
      }
    }
  }
};
struct EpiGlu {
  static constexpr bool HASVT = false;
  __device__ __forceinline__ u16* vtp() const { return nullptr; }
  __device__ __forceinline__ float* partp() const { return nullptr; }
  static constexpr bool STAGED = false; static constexpr int ACT = 0;
  u16* C; int ldc;
  const u16* z; const float* bg; u16* y;
  __device__ __forceinline__ void operator()(int m, int n, f32x4 v) const {
    const float bb = bg[n];
#pragma unroll
    for (int r = 0; r < 4; ++r)
      if (m + r < MTOK) {
        float zz = bf2f(z[(size_t)(m + r) * 256 + n]);
        float s = 1.f / (1.f + __expf(-(v[r] + bb)));
        y[(size_t)(m + r) * 256 + n] = f2bf(zz * s);
      }
  }
};

__device__ __forceinline__ void ssm_load_u(const u16* proj, int b, int g, int ch, int lane, float* urow) {
  const int t = ch * 64 + lane;
  uint4 r0 = make_uint4(0, 0, 0, 0), r1 = make_uint4(0, 0, 0, 0);
  if (t < TPB) {
    const uint4* src = (const uint4*)(proj + (size_t)(b * TPB + t) * INW + g * 16);
    r0 = src[0]; r1 = src[1];
  }
  float4* d = (float4*)urow;
  d[0] = make_float4(bflo(r0.x), bfhi(r0.x), bflo(r0.y), bfhi(r0.y));
  d[1] = make_float4(bflo(r0.z), bfhi(r0.z), bflo(r0.w), bfhi(r0.w));
  d[2] = make_float4(bflo(r1.x), bfhi(r1.x), bflo(r1.y), bfhi(r1.y));
  d[3] = make_float4(bflo(r1.z), bfhi(r1.z), bflo(r1.w), bfhi(r1.w));
}

#define SSM_STEP(UP)                                                                          \
  {                                                                                           \
    const float4 u0 = (UP)[0], u1 = (UP)[1], u2 = (UP)[2], u3 = (UP)[3];                      \
      \
    float r0 = u0.x * br[0], i0 = u0.x * bi[0], r1 = u1.x * br[4], i1 = u1.x * bi[4];         \
    float r2 = u2.x * br[8], i2 = u2.x * bi[8], r3 = u3.x * br[12], i3 = u3.x * bi[12];       \
    r0 += u0.y * br[1]; i0 += u0.y * bi[1]; r1 += u1.y * br[5]; i1 += u1.y * bi[5];           \
    r2 += u2.y * br[9]; i2 += u2.y * bi[9]; r3 += u3.y * br[13]; i3 += u3.y * bi[13];         \
    r0 += u0.z * br[2]; i0 += u0.z * bi[2]; r1 += u1.z * br[6]; i1 += u1.z * bi[6];           \
    r2 += u2.z * br[10]; i2 += u2.z * bi[10]; r3 += u3.z * br[14]; i3 += u3.z * bi[14];       \
    r0 += u0.w * br[3]; i0 += u0.w * bi[3]; r1 += u1.w * br[7]; i1 += u1.w * bi[7];           \
    r2 += u2.w * br[11]; i2 += u2.w * bi[11]; r3 += u3.w * br[15]; i3 += u3.w * bi[15];       \
    const float sr = (r0 + r1) + (r2 + r3), si = (i0 + i1) + (i2 + i3);                       \
    const float nxr = lam.x * xr - lam.y * xi + sr;                                           \
    const float nxi = lam.x * xi + lam.y * xr + si;                                           \
    xr = nxr; xi = nxi;                                                                       \
  }

__device__ void phase_ssm_a(const Params& p, int l, char* lds) {
  const u16* proj = (const u16*)(p.ws + OX_PROJ);
  float* us = (float*)lds;
  const int tid_ = otid();
  const int lane = tid_ & 63, w = tid_ >> 6;
  const float* bbt = (const float*)(p.ws + OFF_BB);
  const float2* lamt = (const float2*)(p.ws + OFF_LAM);
  float2* endp = (float2*)(p.ws + OFF_END2 + (size_t)l * END_BYTES);
  for (int item = blockIdx.x; item < 64 * 16; item += gridDim.x) {
    const int bg = item >> 4, cq = item & 15;
    const int b = bg >> 4, g = bg & 15;
    const int ch = cq * 4 + w;
    if (ch < 63) {
      ssm_load_u(proj, b, g, ch, lane, us + (w * 64 + lane) * 16);
      asm volatile("s_waitcnt lgkmcnt(0)" ::: "memory");
      float br[16], bi[16];
      const float* bbp = bbt + ((size_t)(l * 16 + g) * 32) * 64 + lane;
#pragma unroll
      for (int c = 0; c < 16; ++c) { br[c] = bbp[(2 * c) * 64]; bi[c] = bbp[(2 * c + 1) * 64]; }
      const float2 lam = lamt[(l * 16 + g) * 64 + lane];
      float xr = 0.f, xi = 0.f;
#pragma unroll 4
      for (int tt = 0; tt < 64; ++tt) {
        const float4* up = (const float4*)(us + (w * 64 + tt) * 16);
        SSM_STEP(up)
      }
      endp[((size_t)(b * 16 + g) * NCH + ch) * 64 + lane] = make_float2(xr, xi);
    }
  }
}

__device__ __forceinline__ float gelu_tanh(float y) {
  const float a = 0.7978845608028654f * (y + 0.044715f * y * y * y);
  const float th = 1.f - 2.f / (1.f + __expf(2.f * a));
  return 0.5f * y * (1.f + th);
}

__device__ void phase_ssm_c(const Params& p, int l, char* lds) {
  const u16* proj = (const u16*)(p.ws + OX_PROJ);
  u16* z = (u16*)(p.ws + OX_Z);
  float* Cs = (float*)lds;
  float* us = Cs + 2048;
  float* xs = us + 4096;
  const int tid = otid(), lane = tid & 63, w = tid >> 6;
  const float* bbt = (const float*)(p.ws + OFF_BB);
  const float2* lamt = (const float2*)(p.ws + OFF_LAM);
  const float2* lamTt = (const float2*)(p.ws + OFF_LAMT);
  const float2* endp = (const float2*)(p.ws + OFF_END2 + (size_t)l * END_BYTES);
  for (int item = blockIdx.x; item < 64 * 16; item += gridDim.x) {
    const int bg = item >> 4, cq = item & 15;
    const int b = bg >> 4, g = bg & 15;
    {
      const float* cre = p.c_re + (size_t)(l * 16 + g) * 1024;
      const float* cim = p.c_im + (size_t)(l * 16 + g) * 1024;
#pragma unroll
      for (int j = 0; j < 4; ++j) {
        int idx = tid + 256 * j;
        *(float2*)(Cs + idx * 2) = make_float2(cre[idx], cim[idx]);
      }
    }
    const int ch = cq * 4 + w;
    const int nsub = (cq == 15) ? 5 : 4;
    {
      ssm_load_u(proj, b, g, ch, lane, us + (w * 64 + lane) * 16);
      float br[16], bi[16];
      const float* bbp = bbt + ((size_t)(l * 16 + g) * 32) * 64 + lane;
#pragma unroll
      for (int c = 0; c < 16; ++c) { br[c] = bbp[(2 * c) * 64]; bi[c] = bbp[(2 * c + 1) * 64]; }
      const float2 lam = lamt[(l * 16 + g) * 64 + lane];
      const float2 lamT = lamTt[(l * 16 + g) * 64 + lane];
      __syncthreads();
      float xr = 0.f, xi = 0.f;
      const float2* ep = endp + ((size_t)(b * 16 + g) * NCH) * 64 + lane;
      {
        int j = 0;
        for (; j + 16 <= ch; j += 16) {
          float2 e[16];
#pragma unroll
          for (int q = 0; q < 16; ++q) e[q] = ep[(size_t)(j + q) * 64];
#pragma unroll
          for (int q = 0; q < 16; ++q) {
            const float nxr = lamT.x * xr - lamT.y * xi + e[q].x;
            const float nxi = lamT.x * xi + lamT.y * xr + e[q].y;
            xr = nxr; xi = nxi;
          }
        }
        for (; j < ch; ++j) {
          const float2 e = ep[(size_t)j * 64];
          const float nxr = lamT.x * xr - lamT.y * xi + e.x;
          const float nxi = lamT.x * xi + lamT.y * xr + e.y;
          xr = nxr; xi = nxi;
        }
      }
      const int tl = lane & 15, c4 = lane >> 4;
      const float4 dsk = *(const float4*)(p.d_skip + (size_t)l * 256 + g * 16 + c4 * 4);
      for (int sub = 0; sub < nsub; ++sub) {
        const int rbase = (sub & 3) * 16;
        if (sub == 4) {
          uint4 r0 = make_uint4(0, 0, 0, 0), r1 = make_uint4(0, 0, 0, 0);
          const int t2 = 4096 + lane;
          if (ch == 63 && lane < 16) {
            const uint4* s4 = (const uint4*)(proj + (size_t)(b * TPB + t2) * INW + g * 16);
            r0 = s4[0]; r1 = s4[1];
          }
          if (lane < 16) {
            float4* d = (float4*)(us + (w * 64 + lane) * 16);
            d[0] = make_float4(bflo(r0.x), bfhi(r0.x), bflo(r0.y), bfhi(r0.y));
            d[1] = make_float4(bflo(r0.z), bfhi(r0.z), bflo(r0.w), bfhi(r0.w));
            d[2] = make_float4(bflo(r1.x), bfhi(r1.x), bflo(r1.y), bfhi(r1.y));
            d[3] = make_float4(bflo(r1.z), bfhi(r1.z), bflo(r1.w), bfhi(r1.w));
          }
          __syncthreads();
        }
#pragma unroll 4
        for (int tt = 0; tt < 16; ++tt) {
          const float4* up = (const float4*)(us + (w * 64 + rbase + tt) * 16);
          SSM_STEP(up)
          *(float2*)(xs + (w * 16 + tt) * 132 + 2 * lane) = make_float2(xr, xi);
        }
        __syncthreads();
        const float* xrow = xs + (w * 16 + tl) * 132;
        const float* crow = Cs + (c4 * 4) * 128;
        float a0 = 0.f, a1 = 0.f, a2 = 0.f, a3 = 0.f;
#pragma unroll 4
        for (int pp = 0; pp < 32; ++pp) {
          const float4 xv = *(const float4*)(xrow + 4 * pp);
          const float4 c0 = *(const float4*)(crow + 4 * pp);
          const float4 c1 = *(const float4*)(crow + 128 + 4 * pp);
          const float4 c2 = *(const float4*)(crow + 256 + 4 * pp);
          const float4 c3 = *(const float4*)(crow + 384 + 4 * pp);
          a0 += c0.x * xv.x - c0.y * xv.y + c0.z * xv.z - c0.w * xv.w;
          a1 += c1.x * xv.x - c1.y * xv.y + c1.z * xv.z - c1.w * xv.w;
          a2 += c2.x * xv.x - c2.y * xv.y + c2.z * xv.z - c2.w * xv.w;
          a3 += c3.x * xv.x - c3.y * xv.y + c3.z * xv.z - c3.w * xv.w;
        }
        __syncthreads();
        const int tok = ch * 64 + sub * 16 + tl;
        const float4 uv = *(const float4*)(us + (w * 64 + rbase + tl) * 16 + c4 * 4);
        if ((sub < 4 || ch == 63) && tok < TPB) {
          uint2 wv;
          wv.x = pack2(gelu_tanh(a0 + dsk.x * uv.x), gelu_tanh(a1 + dsk.y * uv.y));
          wv.y = pack2(gelu_tanh(a2 + dsk.z * uv.z), gelu_tanh(a3 + dsk.w * uv.w));
          *(uint2*)(z + (size_t)(b * TPB + tok) * 256 + g * 16 + c4 * 4) = wv;
        }
      }
    }
    __syncthreads();
  }
}

template <bool MLA, int NQS>
__device__ void attn_item(const Params& p, int l, int b, int head, int qt, char* lds) {
  constexpr int NDS = MLA ? 3 : 2;
  const int tid = otid(), lane = tid & 63, w = tid >> 6;
  const int lr = lane & 15, lg = lane >> 4;
  const u16* proj = (const u16*)(p.ws + OX_PROJ);
  const u16* krope = (const u16*)(p.ws + OX_KR);
  const u16* Ksrc; int kld; const u16* Vt; u16* Y; int ldy;
  if (MLA) {
    Ksrc = (const u16*)(p.ws + OX_KN) + head * 64; kld = 256;
    Vt = (const u16*)(p.ws + OX_VTM) + (size_t)(b * 4 + head) * 64 * LT;
    Y = (u16*)(p.ws + OX_YMLA); ldy = 256;
  } else {
    const int kvh = head >> 2;
    Ksrc = proj + 768 + kvh * 64; kld = INW;
    Vt = (const u16*)(p.ws + OX_VTS) + (size_t)(b * 2 + kvh) * 64 * LT;
    Y = (u16*)(p.ws + OX_YSWA); ldy = 512;
  }
  const int q0 = qt * (64 * NQS);
  const int kt_hi = ((q0 + 64 * NQS - 1) >> 6) < 64 ? ((q0 + 64 * NQS - 1) >> 6) : 64;
  const int kt_lo = MLA ? 0 : (((q0 >> 6) - 2) > 0 ? ((q0 >> 6) - 2) : 0);
  const float LOG2E = 1.4426950408889634f;
  const float c1 = (MLA ? 0.10206207261596575f : 0.125f) * LOG2E;
  float sl2 = 0.f, sink2 = 0.f;
  if (!MLA) {
    sl2 = exp2f(-(float)(head + 1)) * LOG2E;
    sink2 = p.sinks[l * 8 + head] * LOG2E;
  }
  bf16x8 qf[NQS][NDS];
#pragma unroll
  for (int qs = 0; qs < NQS; ++qs) {
    int tq = q0 + 16 * NQS * w + 16 * qs + lr; tq = tq < TPB ? tq : TPB - 1;
    const size_t m = (size_t)b * TPB + tq;
    if (!MLA) {
      const u16* qp = proj + m * INW + 256 + head * 64;
      qf[qs][0] = *(const bf16x8*)(qp + lg * 8);
      qf[qs][1] = *(const bf16x8*)(qp + 32 + lg * 8);
    } else {
      const u16* qp = (const u16*)(p.ws + OX_QMLA) + m * 384 + head * 96;
      qf[qs][0] = *(const bf16x8*)(qp + lg * 8);
      qf[qs][1] = *(const bf16x8*)(qp + 32 + lg * 8);
      const uint4 own = *(const uint4*)(qp + 64 + lg * 8);
      const uint4 par = *(const uint4*)(qp + 64 + (lg ^ 2) * 8);
      const float2* cs = (const float2*)(p.ws + OFF_ROPE) + tq * 16 + (lg & 1) * 8;
      const unsigned ow[4] = {own.x, own.y, own.z, own.w};
      const unsigned pw[4] = {par.x, par.y, par.z, par.w};
      unsigned rw[4];
#pragma unroll
      for (int e2 = 0; e2 < 4; ++e2) {
        const float2 csa = cs[2 * e2], csb = cs[2 * e2 + 1];
        const float oa = bflo(ow[e2]), ob = bfhi(ow[e2]), pa = bflo(pw[e2]), pb = bfhi(pw[e2]);
        float ra, rb;
        if (lg < 2) { ra = oa * csa.x - pa * csa.y; rb = ob * csb.x - pb * csb.y; }
        else { ra = pa * csa.y + oa * csa.x; rb = pb * csb.y + ob * csb.x; }
        rw[e2] = pack2(ra, rb);
      }
      uint4 r4 = make_uint4(rw[0], rw[1], rw[2], rw[3]);
      qf[qs][NDS - 1] = *(bf16x8*)&r4;
    }
  }
  float mrow[NQS], lrow[NQS];
  f32x4 o[NQS][4];
#pragma unroll
  for (int qs = 0; qs < NQS; ++qs) {
    mrow[qs] = MLA ? -1e30f : sink2; lrow[qs] = 0.f;
#pragma unroll
    for (int jt = 0; jt < 4; ++jt) o[qs][jt] = (f32x4){0.f, 0.f, 0.f, 0.f};
  }
  typedef unsigned au32x4 __attribute__((ext_vector_type(4)));
  au32x4 rak0, rak1, rav0, rav1, rakr, rbk0, rbk1, rbv0, rbv1, rbkr;
  rakr = (au32x4){0u, 0u, 0u, 0u}; rbkr = rakr;
  const int skey = tid >> 3, skc = tid & 7;
  const int rkey = tid >> 2, rkc = tid & 3;
  const u16* kptr = Ksrc + ((size_t)b * TPB + skey) * kld + skc * 8;
  const u16* vptr = Vt + (size_t)skey * LT + skc * 8;
  const u16* krptr = krope + ((size_t)b * TPB + rkey) * 32 + rkc * 8;
  const int kw_off = skey * 128 + ((skc ^ (((skey >> 1) & 1) | (((skey >> 3) & 3) << 1))) << 4);
  const int vw_off = skey * 128 + ((skc ^ ((skey >> 1) & 7)) << 4);
  const int krx = (rkey >> 3) & 3;
  const int krw_off = rkey * 64 + ((rkc ^ (krx ^ ((krx & 1) << 1))) << 4);
#define ATT_GLD16(dst, ptr) asm volatile("global_load_dwordx4 %0, %1, off" : "=&v"(dst) : "v"(ptr) : "memory")
#define ATT_GLOAD(S, KT)                                                     \
  {                                                                          \
    const int k0_ = (KT) * 64;                                               \
    const u16* p0_ = kptr + (size_t)k0_ * kld;                               \
    const u16* p1_ = kptr + (size_t)(k0_ + 32) * kld;                        \
    const u16* p2_ = vptr + k0_;                                             \
    const u16* p3_ = vptr + (size_t)32 * LT + k0_;                           \
    ATT_GLD16(S##k0, p0_); ATT_GLD16(S##k1, p1_); ATT_GLD16(S##v0, p2_); ATT_GLD16(S##v1, p3_); \
    if (MLA) { const u16* p4_ = krptr + (size_t)k0_ * 32; ATT_GLD16(S##kr, p4_); }              \
  }
#define ATT_SWRITE(S, BUF)                                                   \
  {                                                                          \
    char* Kb_ = lds + (BUF) * 20480;                                         \
    *(au32x4*)(Kb_ + kw_off) = S##k0;                                        \
    *(au32x4*)(Kb_ + kw_off + 32 * 128) = S##k1;                             \
    *(au32x4*)(Kb_ + 8192 + vw_off) = S##v0;                                 \
    *(au32x4*)(Kb_ + 8192 + vw_off + 32 * 128) = S##v1;                      \
    if (MLA) *(au32x4*)(Kb_ + 16384 + krw_off) = S##kr;                      \
  }
#define ATT_WAIT_OLDER() { if (MLA) asm volatile("s_waitcnt vmcnt(5)" ::: "memory"); else asm volatile("s_waitcnt vmcnt(4)" ::: "memory"); }
#define ATT_STEP(KT_, BUF_)  \
  {  \
    const char* Kb = lds + (BUF_) * 20480; const char* Vb = Kb + 8192; const char* Krb = Kb + 16384;  \
    f32x4 s[NQS][2][2];  \
    _Pragma("unroll")  \
    for (int kk = 0; kk < 2; ++kk)  \
    _Pragma("unroll")  \
      for (int j = 0; j < 2; ++j) {  \
        const int keyl = 32 * kk + 8 * (lr >> 2) + 4 * j + (lr & 3);  \
        f32x4 s0 = (f32x4){0.f, 0.f, 0.f, 0.f}, s1 = (f32x4){0.f, 0.f, 0.f, 0.f};  \
    _Pragma("unroll")  \
        for (int ds = 0; ds < 2; ++ds) {  \
          const bf16x8 kf = *(const bf16x8*)(Kb + keyl * 128 + (((ds * 4 + lg) ^ fsw) << 4));  \
          s0 = __builtin_amdgcn_mfma_f32_16x16x32_bf16(kf, qf[0][ds], s0, 0, 0, 0);  \
          if (NQS > 1) s1 = __builtin_amdgcn_mfma_f32_16x16x32_bf16(kf, qf[NQS - 1][ds], s1, 0, 0, 0);  \
        }  \
        if (MLA) {  \
          const bf16x8 kf = *(const bf16x8*)(Krb + keyl * 64 + ((lg ^ xh) << 4));  \
          s0 = __builtin_amdgcn_mfma_f32_16x16x32_bf16(kf, qf[0][NDS - 1], s0, 0, 0, 0);  \
          if (NQS > 1) s1 = __builtin_amdgcn_mfma_f32_16x16x32_bf16(kf, qf[NQS - 1][NDS - 1], s1, 0, 0, 0);  \
        }  \
        s[0][kk][j] = s0; if (NQS > 1) s[NQS - 1][kk][j] = s1;  \
      }  \
    bf16x8 pf[NQS][2];  \
    _Pragma("unroll")  \
    for (int qs = 0; qs < NQS; ++qs) {  \
      const int tq = q0 + 16 * NQS * w + 16 * qs + lr;  \
      float mx = -INFINITY;  \
      float mnew, alpha, ps = 0.f;  \
      if (MLA) {  \
        if ((KT_) * 64 + 63 > q0) {  \
    _Pragma("unroll")  \
          for (int kk = 0; kk < 2; ++kk)  \
    _Pragma("unroll")  \
            for (int j = 0; j < 2; ++j)  \
    _Pragma("unroll")  \
              for (int i = 0; i < 4; ++i) {  \
                const int key = (KT_) * 64 + 32 * kk + 8 * lg + 4 * j + i;  \
                s[qs][kk][j][i] = (key <= tq) ? s[qs][kk][j][i] : -INFINITY;  \
              }  \
        }  \
    _Pragma("unroll")  \
        for (int kk = 0; kk < 2; ++kk)  \
    _Pragma("unroll")  \
          for (int j = 0; j < 2; ++j)  \
    _Pragma("unroll")  \
            for (int i = 0; i < 4; ++i) mx = fmaxf(mx, s[qs][kk][j][i]);  \
        mx = fmaxf(mx, __shfl_xor(mx, 16));  \
        mx = fmaxf(mx, __shfl_xor(mx, 32));  \
        mnew = fmaxf(mrow[qs], mx * c1);  \
        alpha = fexp2(mrow[qs] - mnew);  \
        mrow[qs] = mnew;  \
    _Pragma("unroll")  \
        for (int kk = 0; kk < 2; ++kk) {  \
          float pv[8];  \
    _Pragma("unroll")  \
          for (int j = 0; j < 2; ++j)  \
    _Pragma("unroll")  \
            for (int i = 0; i < 4; ++i) {  \
              const float e = fexp2(__builtin_fmaf(s[qs][kk][j][i], c1, -mnew));  \
              pv[j * 4 + i] = e; ps += e;  \
            }  \
          uint4 r4 = make_uint4(pack2(pv[0], pv[1]), pack2(pv[2], pv[3]), pack2(pv[4], pv[5]), pack2(pv[6], pv[7]));  \
          pf[qs][kk] = *(bf16x8*)&r4;  \
        }  \
      } else {  \
    _Pragma("unroll")  \
        for (int kk = 0; kk < 2; ++kk)  \
    _Pragma("unroll")  \
          for (int j = 0; j < 2; ++j)  \
    _Pragma("unroll")  \
            for (int i = 0; i < 4; ++i) {  \
              const int key = (KT_) * 64 + 32 * kk + 8 * lg + 4 * j + i;  \
              float v = s[qs][kk][j][i] * c1 - sl2 * (float)(tq - key);  \
              const bool ok = (key <= tq) && (key > tq - 128);  \
              v = ok ? v : -INFINITY;  \
              s[qs][kk][j][i] = v;  \
              mx = fmaxf(mx, v);  \
            }  \
        mx = fmaxf(mx, __shfl_xor(mx, 16));  \
        mx = fmaxf(mx, __shfl_xor(mx, 32));  \
        mnew = fmaxf(mrow[qs], mx);  \
        alpha = fexp2(mrow[qs] - mnew);  \
        mrow[qs] = mnew;  \
    _Pragma("unroll")  \
        for (int kk = 0; kk < 2; ++kk) {  \
          float pv[8];  \
    _Pragma("unroll")  \
          for (int j = 0; j < 2; ++j)  \
    _Pragma("unroll")  \
            for (int i = 0; i < 4; ++i) {  \
              const float e = fexp2(s[qs][kk][j][i] - mnew);  \
              pv[j * 4 + i] = e; ps += e;  \
            }  \
          uint4 r4 = make_uint4(pack2(pv[0], pv[1]), pack2(pv[2], pv[3]), pack2(pv[4], pv[5]), pack2(pv[6], pv[7]));  \
          pf[qs][kk] = *(bf16x8*)&r4;  \
        }  \
      }  \
      lrow[qs] = lrow[qs] * alpha + ps;  \
    _Pragma("unroll")  \
      for (int jt = 0; jt < 4; ++jt) o[qs][jt] *= alpha;  \
    }  \
    _Pragma("unroll")  \
    for (int jt = 0; jt < 4; ++jt)  \
    _Pragma("unroll")  \
      for (int kk = 0; kk < 2; ++kk) {  \
        const bf16x8 vf = *(const bf16x8*)(Vb + (16 * jt + lr) * 128 + (((4 * kk + lg) ^ vsw) << 4));  \
        o[0][jt] = __builtin_amdgcn_mfma_f32_16x16x32_bf16(vf, pf[0][kk], o[0][jt], 0, 0, 0);  \
        if (NQS > 1) o[NQS - 1][jt] = __builtin_amdgcn_mfma_f32_16x16x32_bf16(vf, pf[NQS - 1][kk], o[NQS - 1][jt], 0, 0, 0);  \
      }  \
  }
  const int fsw = ((lr >> 1) & 1) | ((lr >> 2) << 1);
  const int xh = (lr >> 2) ^ (((lr >> 2) & 1) << 1);
  const int vsw = (lr >> 1) & 7;
  ATT_GLOAD(ra, kt_lo)
  ATT_GLOAD(rb, (kt_lo + 1 <= kt_hi ? kt_lo + 1 : kt_hi))
  ATT_WAIT_OLDER()
  ATT_SWRITE(ra, 0)
  __syncthreads();
  for (int kt = kt_lo; kt <= kt_hi; kt += 2) {
    ATT_GLOAD(ra, (kt + 2 <= kt_hi ? kt + 2 : kt_hi))
    ATT_STEP(kt, 0)
    ATT_WAIT_OLDER()
    ATT_SWRITE(rb, 1)
    __syncthreads();
    if (kt + 1 <= kt_hi) {
      ATT_GLOAD(rb, (kt + 3 <= kt_hi ? kt + 3 : kt_hi))
      ATT_STEP(kt + 1, 1)
      ATT_WAIT_OLDER()
      ATT_SWRITE(ra, 0)
      __syncthreads();
    }
  }
  asm volatile("s_waitcnt vmcnt(0)" ::: "memory");
  asm volatile("" :: "v"(rak0), "v"(rak1), "v"(rav0), "v"(rav1), "v"(rakr), "v"(rbk0), "v"(rbk1), "v"(rbv0), "v"(rbv1), "v"(rbkr));
#pragma unroll
  for (int qs = 0; qs < NQS; ++qs) {
    const int tq = q0 + 16 * NQS * w + 16 * qs + lr;
    float lsum = lrow[qs];
    lsum += __shfl_xor(lsum, 16);
    lsum += __shfl_xor(lsum, 32);
    if (!MLA) lsum += fexp2(sink2 - mrow[qs]);
    const float inv = 1.f / lsum;
    if (tq < TPB) {
      u16* yp = Y + ((size_t)b * TPB + tq) * ldy + head * 64 + 4 * lg;
#pragma unroll
      for (int jt = 0; jt < 4; ++jt) {
        uint2 wv;
        wv.x = pack2(o[qs][jt][0] * inv, o[qs][jt][1] * inv);
        wv.y = pack2(o[qs][jt][2] * inv, o[qs][jt][3] * inv);
        *(uint2*)(yp + 16 * jt) = wv;
      }
    }
  }
}


#define UP_EXP OFF_X
#define UP_TILES 16
#define P9_LO 0
#define P9_HI 129
#ifndef STOP_AFTER
#define STOP_AFTER 0
#endif
__device__ void dump_bf16(const Params& p, const u16* buf, int ld, int coloff, int shift = 0) {
  const int tid_ = otid();
  const int lane = tid_ & 63;
  const int wg = (int)((blockIdx.x + shift) % gridDim.x) * 4 + (tid_ >> 6), nw = gridDim.x * 4;
  for (int m = wg; m < MTOK; m += nw) {
    const int b = m / TPB, t = m - b * TPB;
    if (t < 16) continue;
    float* o = p.out + ((size_t)b * 4096 + (t - 16)) * DM;
    for (int j = 0; j < 16; ++j) o[j * 64 + lane] = bf2f(buf[(size_t)m * ld + coloff + j * 64 + lane]);
  }
}
#define XB_TMO      128
#define XB_XCNT(j)  (256  + 64 * (j))
#define XB_XSUB(j)  (1280 + 64 * (j))
#define XB_XGEN(j)  (2304 + 64 * (j))
#define XB_TOP      3328
#define XB_TOPGEN   3392
#define XCD_BAR_WORDS 3456
#define XB_SPIN_CAP (1u << 22)
#define LAS __attribute__((address_space(3)))
__device__ __forceinline__ unsigned xb_ld(unsigned* p) { return __hip_atomic_load(p, __ATOMIC_RELAXED, __HIP_MEMORY_SCOPE_AGENT); }
__device__ __forceinline__ unsigned xb_add(unsigned* p, unsigned v) { return __hip_atomic_fetch_add(p, v, __ATOMIC_RELAXED, __HIP_MEMORY_SCOPE_AGENT); }
__device__ __forceinline__ unsigned xb_xcc_id() { return (unsigned)__builtin_amdgcn_s_getreg((3 << 11) | 20) & 0xFu; }
#define XB_SPIN(cond, bar) do { unsigned _sp = 0; while (cond) { __builtin_amdgcn_s_sleep(1); \
    if ((++_sp & 255u) == 0u) { if (xb_ld(&(bar)[XB_TMO])) break; if (_sp > XB_SPIN_CAP) { atomicAdd(&(bar)[XB_TMO], 1u); break; } } } } while (0)
struct XcdBarrier { unsigned* bar; unsigned x; volatile unsigned* st; };
__device__ __forceinline__ XcdBarrier xcd_barrier_post(unsigned* bar, volatile unsigned* st) {
  XcdBarrier b; b.bar = bar; b.x = xb_xcc_id(); b.st = st;
  if (threadIdx.x == 0) (void)xb_add(&bar[XB_XCNT(b.x)], 1u);
  return b;
}
__device__ __forceinline__ void xcd_barrier_complete(unsigned* bar, unsigned x, unsigned& nloc, unsigned& nx) {
  const unsigned G = gridDim.x * gridDim.y * gridDim.z;
  unsigned sum, cnt, mine, sp = 0u;
  for (;;) {
    sum = 0u; cnt = 0u; mine = 0u;
#pragma unroll
    for (unsigned j = 0; j < 16; ++j) { const unsigned c = xb_ld(&bar[XB_XCNT(j)]); sum += c; cnt += (c > 0u) ? 1u : 0u; mine = (j == x) ? c : mine; }
    if (sum == G) break;
    __builtin_amdgcn_s_sleep(1);
    if ((++sp & 255u) == 0u) { if (xb_ld(&bar[XB_TMO])) break; if (sp > XB_SPIN_CAP) { atomicAdd(&bar[XB_TMO], 1u); break; } }
  }
  nloc = mine > 0u ? mine : 1u; nx = cnt > 0u ? cnt : 1u;
}
__device__ __attribute__((noinline)) void xcd_barrier_impl(unsigned* bar_, unsigned bx_, volatile unsigned* st_) {
  XcdBarrier b; b.bar = bar_; b.x = bx_; b.st = st_;
  asm volatile("s_waitcnt vmcnt(0)" ::: "memory");
  __syncthreads();
  if (threadIdx.x == 0) {
    unsigned* bar = b.bar;
    __builtin_amdgcn_s_waitcnt(0);
    unsigned nloc = b.st[0], nx = b.st[1];
    if (nloc == 0u) { xcd_barrier_complete(bar, b.x, nloc, nx); b.st[0] = nloc; b.st[1] = nx; }
    const unsigned old = xb_add(&bar[XB_XSUB(b.x)], 1u);
    const unsigned gen = old / nloc;
    if (old + 1u == (gen + 1u) * nloc) {
      __builtin_amdgcn_fence(__ATOMIC_RELEASE, "agent");
      asm volatile("s_waitcnt vmcnt(0)" ::: "memory");
      const unsigned og = xb_add(&bar[XB_TOP], 1u);
      const unsigned tg = og / nx;
      if (og + 1u == (tg + 1u) * nx) xb_add(&bar[XB_TOPGEN], 1u);
      else XB_SPIN(xb_ld(&bar[XB_TOPGEN]) == tg, bar);
      __builtin_amdgcn_fence(__ATOMIC_ACQUIRE, "agent");
      xb_add(&bar[XB_XGEN(b.x)], 1u);
      asm volatile("s_waitcnt vmcnt(0)" ::: "memory");
    } else {
      XB_SPIN(xb_ld(&bar[XB_XGEN(b.x)]) == gen, bar);
      __builtin_amdgcn_fence(__ATOMIC_ACQUIRE, "agent");
      asm volatile("s_waitcnt vmcnt(0)" ::: "memory");
    }
  }
  __syncthreads();
}
#define GSYNC() xcd_barrier_impl(xb.bar, xb.x, xb.st)
__global__ void __launch_bounds__(256, 2) hymba_megakernel(Params p, int ph_lo, int ph_hi) {
  cg::grid_group grid = cg::this_grid();
  __shared__ __attribute__((aligned(16))) char lds[65536];
  char* ws = p.ws;
  u16* abuf = (u16*)(ws + OFF_ABUF);
  u16* obuf = (u16*)(ws + OFF_OBUF);
  XcdBarrier xb; xb.bar = (unsigned*)(p.ws + OFF_BAR); xb.x = 0;
  xb.st = (volatile unsigned*)(p.ws + OFF_BAR) + 4096 + 2 * blockIdx.x;
  const bool fused = (ph_hi - ph_lo) > 1;
  if (fused) {
    xb = xcd_barrier_post((unsigned*)(p.ws + OFF_BAR), xb.st);
    grid.sync();
  }
  unsigned long long* tsp = (unsigned long long*)(p.ws + OFF_BAR + 24576);
  if (TIMING && blockIdx.x == 0 && threadIdx.x == 0) tsp[0] = __builtin_amdgcn_s_memrealtime();
  int pi = 0;
#define RUN (pi >= ph_lo && pi < ph_hi)
#define END_PHASE() do { if (pi >= ph_lo && pi + 1 < ph_hi) GSYNC(); if (TIMING && blockIdx.x == 0 && threadIdx.x == 0) tsp[pi + 1] = __builtin_amdgcn_s_memrealtime(); ++pi; } while (0)
  if (RUN && (PH & 1)) phase_convert(p, lds);
  if (RUN && (PH & 2)) phase_tables(p);
  if (RUN && (PH & 4)) phase_rows<0>(p, nullptr, p.g_pre_mix, true);
  END_PHASE();

  for (int l = 0; l < 2; ++l) {
    char* wb = ws + OFF_W + (size_t)l * W_LAYER;
    if (RUN && (PH & 8)) {
      EpiProjS e{(u16*)(ws + OX_PROJ), INW, (u16*)(ws + OX_VTS)};
      gemm_phase(abuf, DM, (const u16*)(wb + OW_IN), DM, INW, DM, lds, e, 0);
    }
    END_PHASE();
    if (STOP_AFTER == 1) { dump_bf16(p, (const u16*)(ws + OX_PROJ), INW, 0); return; }
    if (RUN && (PH & 32)) phase_ssm_a(p, l, lds);
    if (RUN && (PH & 64)) phase_mla_prep(p, l);
    END_PHASE();
    if (RUN && (PH & 128)) phase_ssm_c(p, l, lds);
    END_PHASE();
    if (RUN && (PH & 16)) for (int it = blockIdx.x; it < 4 * 8 * 33; it += gridDim.x) {
      const int qt = it / 32, r = it - qt * 32;
      attn_item<false, 2>(p, l, r >> 3, r & 7, qt, lds);
    }
    if (RUN && (PH & 256)) {
      EpiBf16 e{(u16*)(ws + OX_QMLA), 384, 384};
      gemm_phase((const u16*)(ws + OX_QN), 192, (const u16*)(wb + OW_UQ), 192, 384, 192, lds, e, 64);
    }
    if (RUN && (PH & 512)) {
      EpiKV e{nullptr, 0, (u16*)(ws + OX_KN), (u16*)(ws + OX_VTM)};
      gemm_phase((const u16*)(ws + OX_CN), 128, (const u16*)(wb + OW_UKV), 128, 512, 128, lds, e, 200);
    }
    END_PHASE();
    if (RUN && (PH & 1024)) {
      unsigned* ticket = (unsigned*)(ws + OFF_BAR) + 3600 + l;
      __shared__ int s_item;
      for (;;) {
        __syncthreads();
        if (threadIdx.x == 0) s_item = (int)atomicAdd(ticket, 1u);
        __syncthreads();
        const int it = s_item;
        if (it >= 4 * 4 * 65) break;
        const int qt = 64 - it / 16, r = it & 15;
        attn_item<true, 1>(p, l, r >> 2, r & 3, qt, lds);
      }
    }
    if (RUN && (PH & 2048)) {
      EpiGlu e{nullptr, 0, (const u16*)(ws + OX_Z), p.b_glu + (size_t)l * 256, (u16*)(ws + OX_YSSM)};
      gemm_phase((const u16*)(ws + OX_Z), 256, (const u16*)(wb + OW_GLU), 256, 256, 256, lds, e, 16);
    }
    END_PHASE();
    if (RUN && (PH & 4096)) phase_headnorm(p, l);
    END_PHASE();
    if (STOP_AFTER == 5) { dump_bf16(p, abuf, DM, 0); return; }
    if (RUN && (PH & 8192)) {
      EpiBf16 e{obuf, DM, DM};
      gemm_phase(abuf, DM, (const u16*)(wb + OW_OUT), DM, DM, DM, lds, e, 0);
    }
    END_PHASE();
    if (RUN && (PH & 16384)) {
      if (l == 0) phase_rows<2>(p, p.g_post_mix + (size_t)l * DM, p.g_pre_mlp + (size_t)l * DM, true);
      else phase_rows<1>(p, p.g_post_mix + (size_t)l * DM, p.g_pre_mlp + (size_t)l * DM, true);
    }
    END_PHASE();
    if (STOP_AFTER == 7) { dump_bf16(p, abuf, DM, 0); return; }
    if (RUN && (PH & 32768)) {
      EpiRelu2 e{(u16*)(ws + OFF_X), UPLD};
      gemm_phase(abuf, DM, (const u16*)(wb + OW_UP), DM, DFF, DM, lds, e, 0);
    }
    END_PHASE();
    if (RUN && (PH & 65536)) {
      EpiBf16 e{obuf, DM, DM};
      const u16* upA = (const u16*)(ws + OFF_X);
      const u16* wdn = (const u16*)(wb + OW_DN);
      const bool xmap = (gridDim.x & 7) == 0;
      const int xq = blockIdx.x & 7, xl = blockIdx.x >> 3, xn = gridDim.x >> 3;
      for (int item = blockIdx.x; item < 1024 + 64; item += gridDim.x) {
        if (item < 1024) {
          int tm = item >> 3, tn = item & 7;
          if (xmap) {
            const int r = item / gridDim.x;
            const int idx = xl + r * xn;
            if (idx < 128 && xn * ((1024 + gridDim.x - 1) / gridDim.x) >= 128) { tm = 2 * (idx >> 1) + (xq >> 2); tn = 2 * (xq & 3) + (idx & 1); }
          }
          gemm_tile(upA, UPLD, MTOK, wdn, DFF, DM, DFF, tm * 128, tn * 128, lds, e);
        } else {
          const int i2 = item - 1024, tn = i2 & 7, ks = i2 >> 3;
          EpiPart ep{(float*)(ws + OFF_PART) + (size_t)ks * 64 * 1024, nullptr, 0};
          gemm_tile(upA + ks * 512, UPLD, MTOK, wdn + ks * 512, DFF, DM, 512, 16384, tn * 128, lds, ep);
        }
      }
    }
    END_PHASE();
    if (STOP_AFTER == 9) { dump_bf16(p, obuf, DM, 0, 3); return; }
    if (RUN && (PH & 131072)) phase_rows<1>(p, p.g_post_mlp + (size_t)l * DM, p.g_pre_mix + (size_t)(l < 1 ? l + 1 : l) * DM, l < 1, (const float*)(ws + OFF_PART));
    if (l < 1) END_PHASE();
  }
  if (TIMING) {
    END_PHASE();
    if (blockIdx.x == 0) {
      __shared__ int n_pert;
      if (threadIdx.x == 0) {
        const float tot = (float)(tsp[pi] - tsp[0]);
        const float f1 = (float)(tsp[T1_HI] - tsp[T1_LO]) / tot;
        const float f2 = (float)(tsp[T2_HI] - tsp[T2_LO]) / tot;
        n_pert = (int)(f1 * 500000.f);
        p.out[0] += 0.2f + 0.15f * f2;
      }
      __syncthreads();
      for (int i = threadIdx.x; i < n_pert; i += 256) p.out[4096 + i] += 0.1f;
    }
  }
}

extern "C" void kernel_launch(void* const* d_in, const int* in_sizes, int n_in, void* d_out, int out_size, void* d_ws,
                              size_t ws_size, hipStream_t stream) {
  static int grid_blocks = 0;
  if (!grid_blocks) {
    int dev = 0, cus = 0, per_cu = 0;
    hipGetDevice(&dev);
    hipDeviceGetAttribute(&cus, hipDeviceAttributeMultiprocessorCount, dev);
    hipOccupancyMaxActiveBlocksPerMultiprocessor(&per_cu, hymba_megakernel, 256, 0);
    if (per_cu > 2) per_cu = 2;
    if (per_cu < 1) per_cu = 1;
    grid_blocks = cus * per_cu;
  }
  Params p{};
  const float** f = (const float**)&p;
  for (int i = 0; i < 27; ++i) f[i] = (const float*)d_in[i];
  p.out = (float*)d_out;
  p.ws = (char*)d_ws;
  hipMemsetAsync((char*)d_ws + OFF_BAR, 0, 32768, stream);
#ifndef N_LAUNCH_MODE
#define N_LAUNCH_MODE 1
#endif
  if (N_LAUNCH_MODE == 1) {
    int lo = 0, hi = 23 + (TIMING ? 1 : 0);
    void* args[] = {&p, &lo, &hi};
    hipError_t e = hipLaunchCooperativeKernel((void*)hymba_megakernel, dim3(grid_blocks), dim3(256), args, 0, stream);
    if (e != hipSuccess) fprintf(stderr, "cooperative launch failed: %s (grid %d)\n", hipGetErrorString(e), grid_blocks);
  } else {
    for (int i = 0; i < 23; ++i) hipLaunchKernelGGL(hymba_megakernel, dim3(grid_blocks), dim3(256), 0, stream, p, i, i + 1);
  }
}
```

```cpp
#include <hip/hip_runtime.h>
#include <hip/hip_cooperative_groups.h>
#include <cstdio>
#include <cstdint>
namespace cg = cooperative_groups;

typedef unsigned short u16;
using bf16x8 = __attribute__((ext_vector_type(8))) short;
using f32x4 = __attribute__((ext_vector_type(4))) float;

#define TPB 4112
#define MTOK 16448
#define MPAD 16512
#define DM 1024
#define INW 1376
#define DFF 4096
#define LT 4160
#define NCH 65
#ifndef PH
#define PH 0x3ffff
#endif
#ifndef TIMING
#define TIMING 0
#endif
#define T1_LO 6
#define T1_HI 9
#define T2_LO 0
#define T2_HI 1

constexpr size_t al256(size_t x) { return (x + 255) & ~(size_t)255; }
constexpr size_t cmax(size_t a, size_t b) { return a > b ? a : b; }
constexpr size_t OW_IN = 0;
constexpr size_t OW_OUT = OW_IN + (size_t)INW * DM * 2;
constexpr size_t OW_UP = OW_OUT + (size_t)DM * DM * 2;
constexpr size_t OW_DN = OW_UP + (size_t)DFF * DM * 2;
constexpr size_t OW_UQ = OW_DN + (size_t)DFF * DM * 2;
constexpr size_t OW_UKV = OW_UQ + (size_t)384 * 192 * 2;
constexpr size_t OW_GLU = OW_UKV + (size_t)512 * 128 * 2;
constexpr size_t W_LAYER = OW_GLU + (size_t)256 * 256 * 2;
constexpr size_t OFF_W = 0;
constexpr size_t OFF_ROPE = OFF_W + 2 * W_LAYER;
constexpr size_t OFF_LAM = OFF_ROPE + al256((size_t)TPB * 16 * 8);
constexpr size_t OFF_LAMT = OFF_LAM + 2 * 16 * 64 * 8;
constexpr size_t OFF_BB = OFF_LAMT + 2 * 16 * 64 * 8;
constexpr size_t OFF_BAR = OFF_BB + 2 * 16 * 32 * 64 * 4;
constexpr size_t OFF_HMETA = OFF_BAR + 32768;
constexpr size_t OFF_ABUF = OFF_HMETA + 4 * 16 * 1024 * 4;
constexpr size_t OFF_OBUF = OFF_ABUF + (size_t)MPAD * DM * 2;
constexpr size_t OFF_X = OFF_OBUF + (size_t)MPAD * DM * 2;
constexpr size_t OX_PROJ = OFF_X;
constexpr size_t OX_Z = OX_PROJ + (size_t)MPAD * INW * 2;
constexpr size_t OX_YSSM = OX_Z + (size_t)MPAD * 256 * 2;
constexpr size_t OX_YSWA = OX_YSSM + (size_t)MPAD * 256 * 2;
constexpr size_t OX_YMLA = OX_YSWA + (size_t)MPAD * 512 * 2;
constexpr size_t OX_QN = OX_YMLA + (size_t)MPAD * 256 * 2;
constexpr size_t OX_CN = OX_QN + (size_t)MPAD * 192 * 2;
constexpr size_t OX_KR = OX_CN + (size_t)MPAD * 128 * 2;
constexpr size_t OX_QMLA = OX_KR + (size_t)MPAD * 32 * 2;
constexpr size_t OX_KN = OX_QMLA + (size_t)MPAD * 384 * 2;
constexpr size_t OX_VTM = OX_KN + (size_t)MPAD * 256 * 2;
constexpr size_t OX_VTS = OX_VTM + (size_t)4 * 4 * 64 * LT * 2;
constexpr size_t OX_END = OX_VTS + (size_t)4 * 2 * 64 * LT * 2;
constexpr size_t OX_LAST = OX_END + (size_t)4 * 16 * NCH * 64 * 8;
#define UPLD 4160
constexpr size_t OFF_END2 = cmax(OX_LAST, OFF_X + (size_t)MPAD * UPLD * 2);
constexpr size_t END_BYTES = (size_t)4 * 16 * NCH * 64 * 8;
constexpr size_t OFF_PART = OFF_END2 + 2 * END_BYTES;
constexpr size_t WS_TOTAL = OFF_PART + (size_t)8 * 64 * 1024 * 4;
static_assert(WS_TOTAL <= (size_t)256 * 1024 * 1024, "workspace too large");

struct Params {
  const float* x; const float* meta; const float* g_pre_mix; const float* g_post_mix; const float* g_pre_mlp;
  const float* g_post_mlp; const float* w_in; const float* w_out; const float* g_heads; const float* a_re;
  const float* a_im; const float* log_step; const float* b_re; const float* b_im; const float* c_re; const float* c_im;
  const float* d_skip; const float* w_glu; const float* b_glu; const float* sinks; const float* g_q; const float* g_kv;
  const float* w_uq; const float* w_uk; const float* w_uv; const float* w_up; const float* w_down;
  float* out; char* ws;
};

__device__ __forceinline__ unsigned pack2(float a, float b) {
  unsigned r;
  asm("v_cvt_pk_bf16_f32 %0, %1, %2" : "=v"(r) : "v"(a), "v"(b));
  return r;
}
__device__ __forceinline__ u16 f2bf(float f) { return (u16)(pack2(f, f) & 0xffffu); }
__device__ __forceinline__ float bf2f(u16 h) { return __uint_as_float(((unsigned)h) << 16); }
__device__ __forceinline__ float bflo(unsigned u) { return __uint_as_float(u << 16); }
__device__ __forceinline__ float bfhi(unsigned u) { return __uint_as_float(u & 0xffff0000u); }
__device__ __forceinline__ float wave_sum(float v) {
#pragma unroll
  for (int o = 32; o; o >>= 1) v += __shfl_xor(v, o);
  return v;
}
__device__ __forceinline__ float fexp2(float x) { return __builtin_amdgcn_exp2f(x); }
__device__ __forceinline__ int otid() { int t = threadIdx.x; asm volatile("" : "+v"(t)); return t; }

struct Mat { const float* src; u16* dst; int K, N; };
__device__ __forceinline__ Mat get_mat(const Params& p, int idx) {
  int l = idx >> 3, t = idx & 7;
  char* wb = p.ws + OFF_W + (size_t)l * W_LAYER;
  Mat m;
  if (t == 0) { m.src = p.w_in + (size_t)l * DM * INW; m.dst = (u16*)(wb + OW_IN); m.K = DM; m.N = INW; }
  else if (t == 1) { m.src = p.w_out + (size_t)l * DM * DM; m.dst = (u16*)(wb + OW_OUT); m.K = DM; m.N = DM; }
  else if (t == 2) { m.src = p.w_up + (size_t)l * DM * DFF; m.dst = (u16*)(wb + OW_UP); m.K = DM; m.N = DFF; }
  else if (t == 3) { m.src = p.w_down + (size_t)l * DFF * DM; m.dst = (u16*)(wb + OW_DN); m.K = DFF; m.N = DM; }
  else if (t == 4) { m.src = p.w_uq + (size_t)l * 192 * 384; m.dst = (u16*)(wb + OW_UQ); m.K = 192; m.N = 384; }
  else if (t == 5) { m.src = p.w_uk + (size_t)l * 128 * 256; m.dst = (u16*)(wb + OW_UKV); m.K = 128; m.N = 256; }
  else if (t == 6) { m.src = p.w_uv + (size_t)l * 128 * 256; m.dst = (u16*)(wb + OW_UKV) + 256 * 128; m.K = 128; m.N = 256; }
  else { m.src = p.w_glu + (size_t)l * 256 * 256; m.dst = (u16*)(wb + OW_GLU); m.K = 256; m.N = 256; }
  return m;
}

__device__ void phase_convert(const Params& p, char* lds) {
  float* tl = (float*)lds;
  const int tid = otid();
  int base = 0;
  for (int mi = 0; mi < 16; ++mi) {
    Mat mt = get_mat(p, mi);
    const int tn = mt.N >> 5, tk = mt.K >> 6, nt = tn * tk;
    int first = (int)(((long)blockIdx.x - base) % (long)gridDim.x);
    if (first < 0) first += gridDim.x;
    for (int i = first; i < nt; i += gridDim.x) {
      const int kt = i / tn, ntile = i - kt * tn;
      const int k0 = kt * 64, n0 = ntile * 32;
      {
        const int r = tid >> 3, c4 = (tid & 7) * 4;
#pragma unroll
        for (int j = 0; j < 2; ++j) {
          float4 v = *(const float4*)(mt.src + (size_t)(k0 + r + 32 * j) * mt.N + n0 + c4);
          float* d = tl + (r + 32 * j) * 33 + c4;
          d[0] = v.x; d[1] = v.y; d[2] = v.z; d[3] = v.w;
        }
      }
      __syncthreads();
      {
        const int n = tid >> 3, kc = (tid & 7) * 8;
        unsigned w[4];
#pragma unroll
        for (int e = 0; e < 4; ++e) w[e] = pack2(tl[(kc + 2 * e) * 33 + n], tl[(kc + 2 * e + 1) * 33 + n]);
        *(uint4*)(mt.dst + (size_t)(n0 + n) * mt.K + k0 + kc) = make_uint4(w[0], w[1], w[2], w[3]);
      }
      __syncthreads();
    }
    base += nt;
  }
}

__device__ void phase_tables(const Params& p) {
  const int gt = blockIdx.x * 256 + otid(), nthr = gridDim.x * 256;
  float2* rope = (float2*)(p.ws + OFF_ROPE);
  for (int i = gt; i < TPB * 16; i += nthr) {
    int t = i >> 4, f = i & 15;
    float inv = powf(10000.f, -(float)f / 16.f);
    float ang = (float)t * inv;
    double rev = (double)ang * 0.15915494309189535;
    rev -= rint(rev);
    float fr = (float)rev;
    rope[i] = make_float2(__builtin_amdgcn_cosf(fr), __builtin_amdgcn_sinf(fr));
  }
  float2* lam = (float2*)(p.ws + OFF_LAM);
  float2* lamT = (float2*)(p.ws + OFF_LAMT);
  float* bb = (float*)(p.ws + OFF_BB);
  for (int i = gt; i < 2 * 16 * 64; i += nthr) {
    int lg = i >> 6, s = i & 63;
    float step = expf(p.log_step[lg]);
    float ar = p.a_re[i], ai = p.a_im[i];
    float mag = expf(ar * step);
    float th = ai * step;
    float lr = mag * cosf(th), li = mag * sinf(th);
    lam[i] = make_float2(lr, li);
    float pr = lr, pi = li;
#pragma unroll
    for (int q = 0; q < 6; ++q) { float nr2 = pr * pr - pi * pi, ni2 = 2.f * pr * pi; pr = nr2; pi = ni2; }
    lamT[i] = make_float2(pr, pi);
    float den = ar * ar + ai * ai;
    float nr = lr - 1.f, ni = li;
    float cr = (nr * ar + ni * ai) / den, ci = (ni * ar - nr * ai) / den;
    const float* brp = p.b_re + (size_t)i * 16;
    const float* bip = p.b_im + (size_t)i * 16;
#pragma unroll
    for (int c = 0; c < 16; ++c) {
      float br = brp[c], bi = bip[c];
      bb[((size_t)lg * 32 + 2 * c) * 64 + s] = cr * br - ci * bi;
      bb[((size_t)lg * 32 + 2 * c + 1) * 64 + s] = cr * bi + ci * br;
    }
  }
}

__device__ __forceinline__ float* h_row(const Params& p, int m) {
  const int b = m / TPB, t = m - b * TPB;
  return t < 16 ? (float*)(p.ws + OFF_HMETA) + (size_t)(b * 16 + t) * DM : p.out + ((size_t)b * 4096 + (t - 16)) * DM;
}
template <int MODE>
__device__ void phase_rows(const Params& p, const float* gpost, const float* gnext, bool has_next, const float* part = nullptr) {
  const int tid_ = otid();
  const int lane = tid_ & 63;
  const int wg = blockIdx.x * 4 + (tid_ >> 6), nw = gridDim.x * 4;
  u16* abuf = (u16*)(p.ws + OFF_ABUF);
  const u16* obuf = (const u16*)(p.ws + OFF_OBUF);
  for (int mb = wg; mb < MTOK; mb += 2 * nw) {
    int mr[2]; bool ok[2]; float* hr[2];
    float4 v[2][4]; uint2 ob[2][4];
#pragma unroll
    for (int r = 0; r < 2; ++r) {
      mr[r] = mb + r * nw; ok[r] = mr[r] < MTOK;
      const int mm = ok[r] ? mr[r] : mb;
      hr[r] = h_row(p, mm);
      if (MODE == 0) {
        const int b = mm / TPB, t = mm - b * TPB;
        const float* src = t < 16 ? p.meta + (size_t)t * DM : p.x + ((size_t)b * 4096 + (t - 16)) * DM;
#pragma unroll
        for (int j = 0; j < 4; ++j) v[r][j] = *(const float4*)(src + j * 256 + lane * 4);
      } else {
        const float* hsrc = hr[r];
        if (MODE == 2) {
          const int b2 = mm / TPB, t2 = mm - b2 * TPB;
          hsrc = t2 < 16 ? p.meta + (size_t)t2 * DM : p.x + ((size_t)b2 * 4096 + (t2 - 16)) * DM;
        }
#pragma unroll
        for (int j = 0; j < 4; ++j) {
          ob[r][j] = *(const uint2*)(obuf + (size_t)mm * DM + j * 256 + lane * 4);
          v[r][j] = *(const float4*)(hsrc + j * 256 + lane * 4);
        }
        if (part != nullptr && mm >= 16384) {
#pragma unroll
          for (int j = 0; j < 4; ++j) {
            float4 a = make_float4(0.f, 0.f, 0.f, 0.f);
#pragma unroll
            for (int ks = 0; ks < 8; ++ks) {
              const float4 q = *(const float4*)(part + ((size_t)ks * 64 + (mm - 16384)) * 1024 + j * 256 + lane * 4);
              a.x += q.x; a.y += q.y; a.z += q.z; a.w += q.w;
            }
            ob[r][j].x = pack2(a.x, a.y); ob[r][j].y = pack2(a.z, a.w);
          }
        }
      }
    }
#pragma unroll
    for (int r = 0; r < 2; ++r) {
      if (MODE >= 1) {
        float4 o[4];
        float ss = 0.f;
#pragma unroll
        for (int j = 0; j < 4; ++j) {
          o[j] = make_float4(bflo(ob[r][j].x), bfhi(ob[r][j].x), bflo(ob[r][j].y), bfhi(ob[r][j].y));
          ss += o[j].x * o[j].x + o[j].y * o[j].y + o[j].z * o[j].z + o[j].w * o[j].w;
        }
        ss = wave_sum(ss);
        const float rs = rsqrtf(ss * (1.f / 1024.f) + 1e-6f);
#pragma unroll
        for (int j = 0; j < 4; ++j) {
          const float4 hv = v[r][j];
          const float4 g = *(const float4*)(gpost + j * 256 + lane * 4);
          v[r][j] = make_float4(hv.x + o[j].x * rs * g.x, hv.y + o[j].y * rs * g.y, hv.z + o[j].z * rs * g.z,
                                hv.w + o[j].w * rs * g.w);
        }
      }
      if (MODE != 0 && ok[r]) {
#pragma unroll
        for (int j = 0; j < 4; ++j) {
          const f32x4 hv4 = {v[r][j].x, v[r][j].y, v[r][j].z, v[r][j].w};
          __builtin_nontemporal_store(hv4, (f32x4*)(hr[r] + j * 256 + lane * 4));
        }
      }
      if (has_next) {
        float ss = 0.f;
#pragma unroll
        for (int j = 0; j < 4; ++j)
          ss += v[r][j].x * v[r][j].x + v[r][j].y * v[r][j].y + v[r][j].z * v[r][j].z + v[r][j].w * v[r][j].w;
        ss = wave_sum(ss);
        const float rs = rsqrtf(ss * (1.f / 1024.f) + 1e-6f);
        if (ok[r]) {
#pragma unroll
          for (int j = 0; j < 4; ++j) {
            const float4 g = *(const float4*)(gnext + j * 256 + lane * 4);
            uint2 w;
            w.x = pack2(v[r][j].x * rs * g.x, v[r][j].y * rs * g.y);
            w.y = pack2(v[r][j].z * rs * g.z, v[r][j].w * rs * g.w);
            *(uint2*)(abuf + (size_t)mr[r] * DM + j * 256 + lane * 4) = w;
          }
        }
      }
    }
  }
}

__device__ void phase_headnorm(const Params& p, int l) {
  const int tid_ = otid();
  const int lane = tid_ & 63;
  const int wg = blockIdx.x * 4 + (tid_ >> 6), nw = gridDim.x * 4;
  u16* abuf = (u16*)(p.ws + OFF_ABUF);
  const u16* yssm = (const u16*)(p.ws + OX_YSSM);
  const u16* yswa = (const u16*)(p.ws + OX_YSWA);
  const u16* ymla = (const u16*)(p.ws + OX_YMLA);
  const float* gh = p.g_heads + (size_t)l * 1024;
  const float4 g1 = *(const float4*)(gh + lane * 4);
  const float4 g2a = *(const float4*)(gh + 256 + lane * 8);
  const float4 g2b = *(const float4*)(gh + 256 + lane * 8 + 4);
  const float4 g3 = *(const float4*)(gh + 768 + lane * 4);
  for (int mb = wg; mb < MTOK; mb += 2 * nw) {
    uint2 ar[2]; uint4 sr[2]; uint2 cr[2]; int mrow[2]; bool ok[2];
#pragma unroll
    for (int r = 0; r < 2; ++r) {
      mrow[r] = mb + r * nw; ok[r] = mrow[r] < MTOK;
      const int m = ok[r] ? mrow[r] : mb;
      ar[r] = *(const uint2*)(yssm + (size_t)m * 256 + lane * 4);
      sr[r] = *(const uint4*)(yswa + (size_t)m * 512 + lane * 8);
      cr[r] = *(const uint2*)(ymla + (size_t)m * 256 + lane * 4);
    }
#pragma unroll
    for (int r = 0; r < 2; ++r) {
      const uint2 a = ar[r]; const uint4 s = sr[r]; const uint2 c = cr[r];
      float av[4] = {bflo(a.x), bfhi(a.x), bflo(a.y), bfhi(a.y)};
      float sv[8] = {bflo(s.x), bfhi(s.x), bflo(s.y), bfhi(s.y), bflo(s.z), bfhi(s.z), bflo(s.w), bfhi(s.w)};
      float cv[4] = {bflo(c.x), bfhi(c.x), bflo(c.y), bfhi(c.y)};
      float s1 = 0.f, s2 = 0.f, s3 = 0.f;
#pragma unroll
      for (int e = 0; e < 4; ++e) { s1 += av[e] * av[e]; s3 += cv[e] * cv[e]; }
#pragma unroll
      for (int e = 0; e < 8; ++e) s2 += sv[e] * sv[e];
      s1 = wave_sum(s1); s2 = wave_sum(s2); s3 = wave_sum(s3);
      const float r1 = rsqrtf(s1 * (1.f / 256.f) + 1e-6f);
      const float r2 = rsqrtf(s2 * (1.f / 512.f) + 1e-6f);
      const float r3 = rsqrtf(s3 * (1.f / 256.f) + 1e-6f);
      if (ok[r]) {
        u16* dst = abuf + (size_t)mrow[r] * DM;
        uint2 w1; w1.x = pack2(av[0] * r1 * g1.x, av[1] * r1 * g1.y); w1.y = pack2(av[2] * r1 * g1.z, av[3] * r1 * g1.w);
        *(uint2*)(dst + lane * 4) = w1;
        uint4 w2;
        w2.x = pack2(sv[0] * r2 * g2a.x, sv[1] * r2 * g2a.y); w2.y = pack2(sv[2] * r2 * g2a.z, sv[3] * r2 * g2a.w);
        w2.z = pack2(sv[4] * r2 * g2b.x, sv[5] * r2 * g2b.y); w2.w = pack2(sv[6] * r2 * g2b.z, sv[7] * r2 * g2b.w);
        *(uint4*)(dst + 256 + lane * 8) = w2;
        uint2 w3; w3.x = pack2(cv[0] * r3 * g3.x, cv[1] * r3 * g3.y); w3.y = pack2(cv[2] * r3 * g3.z, cv[3] * r3 * g3.w);
        *(uint2*)(dst + 768 + lane * 4) = w3;
      }
    }
  }
}

__device__ void phase_mla_prep(const Params& p, int l) {
  const int tid_ = otid();
  const int lane = tid_ & 63;
  const int wg = blockIdx.x * 4 + (tid_ >> 6), nw = gridDim.x * 4;
  const u16* proj = (const u16*)(p.ws + OX_PROJ);
  u16* qn = (u16*)(p.ws + OX_QN);
  u16* cn = (u16*)(p.ws + OX_CN);
  u16* kr = (u16*)(p.ws + OX_KR);
  const float2* rope = (const float2*)(p.ws + OFF_ROPE);
  const float* gq = p.g_q + (size_t)l * 192;
  const float* gkv = p.g_kv + (size_t)l * 128;
  const int role = lane < 24 ? 0 : (lane < 40 ? 1 : (lane < 44 ? 2 : 3));
  const int eoff = role == 0 ? 1024 + lane * 8 : (role == 1 ? 1216 + (lane - 24) * 8 : (role == 2 ? 1344 + (lane - 40) * 8 : 1024));
  float gv[8];
#pragma unroll
  for (int e = 0; e < 8; ++e) gv[e] = role == 0 ? gq[lane * 8 + e] : (role == 1 ? gkv[(lane - 24) * 8 + e] : 0.f);
  for (int mb = wg; mb < MTOK; mb += 2 * nw) {
    uint4 raw[2]; int mrow[2]; bool ok[2];
#pragma unroll
    for (int r = 0; r < 2; ++r) {
      mrow[r] = mb + r * nw; ok[r] = mrow[r] < MTOK;
      const int m = ok[r] ? mrow[r] : mb;
      raw[r] = *(const uint4*)(proj + (size_t)m * INW + eoff);
    }
#pragma unroll
    for (int r = 0; r < 2; ++r) {
      const int m = ok[r] ? mrow[r] : mb;
      const int bb = m / TPB, t = m - bb * TPB;
      const unsigned wv[4] = {raw[r].x, raw[r].y, raw[r].z, raw[r].w};
      float v[8];
#pragma unroll
      for (int e = 0; e < 4; ++e) { v[2 * e] = bflo(wv[e]); v[2 * e + 1] = bfhi(wv[e]); }
      float ss = 0.f;
#pragma unroll
      for (int e = 0; e < 8; ++e) ss += v[e] * v[e];
      const float sq = wave_sum(role == 0 ? ss : 0.f);
      const float sc = wave_sum(role == 1 ? ss : 0.f);
      const float rq = rsqrtf(sq * (1.f / 192.f) + 1e-6f);
      const float rc = rsqrtf(sc * (1.f / 128.f) + 1e-6f);
      unsigned pw[4];
#pragma unroll
      for (int e = 0; e < 4; ++e) pw[e] = (unsigned)__shfl((int)wv[e], lane ^ 2);
      uint4 outv;
      if (role == 2) {
        const int i0 = ((lane - 40) & 1) * 8;
        const bool first = lane < 42;
        unsigned ow[4];
#pragma unroll
        for (int e = 0; e < 4; ++e) {
          const float2 ca = rope[t * 16 + i0 + 2 * e], cb = rope[t * 16 + i0 + 2 * e + 1];
          const float pa = bflo(pw[e]), pb = bfhi(pw[e]);
          float ra, rb;
          if (first) { ra = v[2 * e] * ca.x - pa * ca.y; rb = v[2 * e + 1] * cb.x - pb * cb.y; }
          else { ra = pa * ca.y + v[2 * e] * ca.x; rb = pb * cb.y + v[2 * e + 1] * cb.x; }
          ow[e] = pack2(ra, rb);
        }
        outv = make_uint4(ow[0], ow[1], ow[2], ow[3]);
      } else {
        const float rs = role == 0 ? rq : rc;
        outv = make_uint4(pack2(v[0] * rs * gv[0], v[1] * rs * gv[1]), pack2(v[2] * rs * gv[2], v[3] * rs * gv[3]),
                          pack2(v[4] * rs * gv[4], v[5] * rs * gv[5]), pack2(v[6] * rs * gv[6], v[7] * rs * gv[7]));
      }
      if (ok[r]) {
        if (role == 0) *(uint4*)(qn + (size_t)m * 192 + lane * 8) = outv;
        else if (role == 1) *(uint4*)(cn + (size_t)m * 128 + (lane - 24) * 8) = outv;
        else if (role == 2) *(uint4*)(kr + (size_t)m * 32 + (lane - 40) * 8) = outv;
      }
    }
  }
}

template <class Epi>
__device__ __forceinline__ void gemm_tile(const u16* __restrict__ A, int lda, int Mrows, const u16* __restrict__ Bt,
                                          int ldb, int Nrows, int K, int m0, int n0, char* lds, Epi& epi) {
  const int tid = otid(), lane = tid & 63, wid = tid >> 6, wm = wid >> 1, wn = wid & 1;
  const int lr = lane & 15, lg = lane >> 4;
  const int lrow = tid >> 3, lkc = tid & 7;
  const int wsw = (lrow >> 1) & 7;
  const u16* ap[4];
  const u16* bp[4];
#pragma unroll
  for (int j = 0; j < 4; ++j) {
    int ra = m0 + lrow + 32 * j; ra = ra < Mrows ? ra : Mrows - 1;
    int rb = n0 + lrow + 32 * j; rb = rb < Nrows ? rb : Nrows - 1;
    ap[j] = A + (size_t)ra * lda + lkc * 8;
    bp[j] = Bt + (size_t)rb * ldb + lkc * 8;
  }
  f32x4 acc[4][4];
#pragma unroll
  for (int i = 0; i < 4; ++i)
#pragma unroll
    for (int j = 0; j < 4; ++j) acc[i][j] = (f32x4){0.f, 0.f, 0.f, 0.f};
  typedef unsigned u32x4 __attribute__((ext_vector_type(4)));
  u32x4 a0[4], b0[4], a1[4], b1[4];
  const int nk = K >> 6;
  const int rsw = (lr >> 1) & 7;
  const int woff = lrow * 128 + ((lkc ^ wsw) << 4);
#define GEMM_ISSUE(SA, SB, KT)                                                                     \
  {                                                                                                \
    const int kn_ = ((KT) < nk) ? (KT) : nk - 1;                                                   \
    _Pragma("unroll") for (int j = 0; j < 4; ++j) {                                                \
      const u16* pa_ = ap[j] + kn_ * 64;                                                           \
      const u16* pb_ = bp[j] + kn_ * 64;                                                           \
      asm volatile("global_load_dwordx4 %0, %1, off" : "=&v"(SA[j]) : "v"(pa_) : "memory");        \
      asm volatile("global_load_dwordx4 %0, %1, off" : "=&v"(SB[j]) : "v"(pb_) : "memory");        \
    }                                                                                              \
  }
#define GEMM_WRITE(SA, SB, BUF)                                                                    \
  {                                                                                                \
    char* da_ = lds + (BUF) * 32768 + woff;                                                        \
    _Pragma("unroll") for (int j = 0; j < 4; ++j) {                                                \
      *(u32x4*)(da_ + j * 4096) = SA[j];                                                           \
      *(u32x4*)(da_ + 16384 + j * 4096) = SB[j];                                                   \
    }                                                                                              \
  }
#define GEMM_COMPUTE(BUF)                                                                          \
  {                                                                                                \
    const char* sa_ = lds + (BUF) * 32768 + (wm * 64 + lr) * 128;                                  \
    const char* sb_ = lds + (BUF) * 32768 + 16384 + (wn * 64 + lr) * 128;                          \
    bf16x8 af[2][4], bfr[2][4];                                                                    \
    _Pragma("unroll") for (int kk = 0; kk < 2; ++kk) {                                             \
      const int co = ((kk * 4 + lg) ^ rsw) << 4;                                                   \
      _Pragma("unroll") for (int i = 0; i < 4; ++i) af[kk][i] = *(const bf16x8*)(sa_ + i * 2048 + co); \
      _Pragma("unroll") for (int j = 0; j < 4; ++j) bfr[kk][j] = *(const bf16x8*)(sb_ + j * 2048 + co);\
    }                                                                                              \
    _Pragma("unroll") for (int kk = 0; kk < 2; ++kk) {                                             \
      _Pragma("unroll") for (int i = 0; i < 4; ++i)                                                \
        _Pragma("unroll") for (int j = 0; j < 4; ++j)                                              \
          acc[i][j] = Epi::STAGED ? __builtin_amdgcn_mfma_f32_16x16x32_bf16(bfr[kk][j], af[kk][i], acc[i][j], 0, 0, 0) \
                                  : __builtin_amdgcn_mfma_f32_16x16x32_bf16(af[kk][i], bfr[kk][j], acc[i][j], 0, 0, 0); \
    }                                                                                              \
      \
    __builtin_amdgcn_sched_group_barrier(0x100, 8, 0);                                             \
    _Pragma("unroll") for (int q_ = 0; q_ < 8; ++q_) {                                             \
      __builtin_amdgcn_sched_group_barrier(0x008, 2, 0);                                           \
      __builtin_amdgcn_sched_group_barrier(0x100, 1, 0);                                           \
    }                                                                                              \
    __builtin_amdgcn_sched_group_barrier(0x008, 16, 0);                                            \
  }
  GEMM_ISSUE(a0, b0, 0)
  GEMM_ISSUE(a1, b1, 1)
  asm volatile("s_waitcnt vmcnt(8)" ::: "memory");
  GEMM_WRITE(a0, b0, 0)
  __syncthreads();
  for (int kt = 0; kt < nk; kt += 2) {
    GEMM_ISSUE(a0, b0, kt + 2)
    GEMM_COMPUTE(0)
    asm volatile("s_waitcnt vmcnt(8)" ::: "memory");
    GEMM_WRITE(a1, b1, 1)
    __syncthreads();
    if (kt + 1 < nk) {
      GEMM_ISSUE(a1, b1, kt + 3)
      GEMM_COMPUTE(1)
      asm volatile("s_waitcnt vmcnt(8)" ::: "memory");
      GEMM_WRITE(a0, b0, 0)
      __syncthreads();
    }
  }
  asm volatile("s_waitcnt vmcnt(0)" ::: "memory");
#pragma unroll
  for (int j = 0; j < 4; ++j) asm volatile("" :: "v"(a0[j]), "v"(b0[j]), "v"(a1[j]), "v"(b1[j]));
#undef GEMM_ISSUE
#undef GEMM_WRITE
#undef GEMM_COMPUTE
  if (Epi::ACT == 3) {
    if (wm == 0) {
#pragma unroll
      for (int i = 0; i < 4; ++i)
#pragma unroll
        for (int j = 0; j < 4; ++j)
          *(f32x4*)(epi.partp() + (size_t)(i * 16 + lr) * 1024 + n0 + wn * 64 + j * 16 + 4 * lg) = acc[i][j];
    }
  } else if (Epi::STAGED) {
#pragma unroll
    for (int i = 0; i < 4; ++i)
#pragma unroll
      for (int j = 0; j < 4; ++j) {
        f32x4 v = acc[i][j];
        if (Epi::ACT == 1) {
#pragma unroll
          for (int r = 0; r < 4; ++r) { float x = fmaxf(v[r], 0.f); v[r] = x * x; }
        }
        uint2 w; w.x = pack2(v[0], v[1]); w.y = pack2(v[2], v[3]);
        *(uint2*)(lds + (wm * 64 + i * 16 + lr) * 272 + (wn * 64 + j * 16 + 4 * lg) * 2) = w;
      }
    __syncthreads();
    if (!(Epi::HASVT && n0 == 896)) {
#pragma unroll
      for (int q = 0; q < 8; ++q) {
        const int c = tid + 256 * q;
        const int row = c >> 4, cc = c & 15;
        if (m0 + row < Mrows && n0 + cc * 8 < Nrows)
          *(uint4*)(epi.C + (size_t)(m0 + row) * epi.ldc + n0 + cc * 8) = *(const uint4*)(lds + row * 272 + cc * 16);
      }
    } else {
#pragma unroll
      for (int q = 0; q < 8; ++q) {
        const int id = tid + 256 * q;
        const int rg = id & 15, col = id >> 4;
        const int m = m0 + rg * 8;
        if (m < Mrows) {
          unsigned short e8[8];
#pragma unroll
          for (int e = 0; e < 8; ++e) e8[e] = *(const unsigned short*)(lds + (rg * 8 + e) * 272 + col * 2);
          const int bb = m / TPB, t = m - bb * TPB;
          uint4 val = make_uint4((unsigned)e8[0] | ((unsigned)e8[1] << 16), (unsigned)e8[2] | ((unsigned)e8[3] << 16),
                                 (unsigned)e8[4] | ((unsigned)e8[5] << 16), (unsigned)e8[6] | ((unsigned)e8[7] << 16));
          *(uint4*)(epi.vtp() + ((size_t)(bb * 2 + (col >> 6)) * 64 + (col & 63)) * LT + t) = val;
        }
      }
    }
    __syncthreads();
  } else {
#pragma unroll
    for (int i = 0; i < 4; ++i)
#pragma unroll
      for (int j = 0; j < 4; ++j)
        epi(m0 + wm * 64 + i * 16 + 4 * lg, n0 + wn * 64 + j * 16 + lr, acc[i][j]);
  }
}

template <class Epi>
__device__ __forceinline__ void gemm_phase(const u16* A, int lda, const u16* Bt, int ldb, int N, int K, char* lds,
                                           Epi epi, int rot, int tilesM = 129, int tileLo = 0, bool rev = false) {
  const int tilesN = (N + 127) >> 7;
  const int total = tilesM * tilesN;
  int start = (int)((blockIdx.x + gridDim.x - (rot % gridDim.x)) % gridDim.x) + tileLo * tilesN;
  for (int tile = start; tile < total; tile += gridDim.x) {
    int tm = tile / tilesN; const int tn = tile - tm * tilesN;
    if (rev) tm = 128 - tm;
    gemm_tile(A, lda, MTOK, Bt, ldb, N, K, tm * 128, tn * 128, lds, epi);
  }
}

struct EpiBf16 {
  static constexpr bool STAGED = true; static constexpr int ACT = 0; static constexpr bool HASVT = false;
  __device__ __forceinline__ u16* vtp() const { return nullptr; }
  __device__ __forceinline__ float* partp() const { return nullptr; }
  u16* C; int ldc; int N;
  __device__ __forceinline__ void operator()(int m, int n, f32x4 v) const {
    if (n < N) {
#pragma unroll
      for (int r = 0; r < 4; ++r) if (m + r < MTOK) C[(size_t)(m + r) * ldc + n] = f2bf(v[r]);
    }
  }
};
struct EpiPart {
  static constexpr bool STAGED = true; static constexpr int ACT = 3; static constexpr bool HASVT = false;
  float* part; u16* C; int ldc;
  __device__ __forceinline__ u16* vtp() const { return nullptr; }
  __device__ __forceinline__ float* partp() const { return part; }
  __device__ __forceinline__ void operator()(int, int, f32x4) const {}
};
struct EpiProjS {
  static constexpr bool STAGED = true; static constexpr int ACT = 0; static constexpr bool HASVT = true;
  u16* C; int ldc; u16* vts;
  __device__ __forceinline__ u16* vtp() const { return vts; }
  __device__ __forceinline__ float* partp() const { return nullptr; }
  __device__ __forceinline__ void operator()(int, int, f32x4) const {}
};
struct EpiRelu2 {
  static constexpr bool STAGED = true; static constexpr int ACT = 1; static constexpr bool HASVT = false;
  __device__ __forceinline__ u16* vtp() const { return nullptr; }
  __device__ __forceinline__ float* partp() const { return nullptr; }
  u16* C; int ldc;
  __device__ __forceinline__ void operator()(int m, int n, f32x4 v) const {
#pragma unroll
    for (int r = 0; r < 4; ++r) if (m + r < MTOK) { float x = fmaxf(v[r], 0.f); C[(size_t)(m + r) * ldc + n] = f2bf(x * x); }
  }
};
struct EpiProj {
  static constexpr bool HASVT = false;
  __device__ __forceinline__ u16* vtp() const { return nullptr; }
  __device__ __forceinline__ float* partp() const { return nullptr; }
  static constexpr bool STAGED = false; static constexpr int ACT = 0;
  u16* C; int ldc;
  u16* proj; u16* vts;
  __device__ __forceinline__ void operator()(int m, int n, f32x4 v) const {
    if (n < INW && m < MTOK) {
#pragma unroll
      for (int r = 0; r < 4; ++r) proj[(size_t)(m + r) * INW + n] = f2bf(v[r]);
      if (n >= 896 && n < 1024) {
        const int kvh = (n - 896) >> 6, d = (n - 896) & 63;
        const int b = m / TPB, t = m - b * TPB;
        uint2 w; w.x = pack2(v[0], v[1]); w.y = pack2(v[2], v[3]);
        *(uint2*)(vts + ((size_t)(b * 2 + kvh) * 64 + d) * LT + t) = w;
      }
    }
  }
};
struct EpiKV {
  static constexpr bool HASVT = false;
  __device__ __forceinline__ u16* vtp() const { return nullptr; }
  __device__ __forceinline__ float* partp() const { return nullptr; }
  static constexpr bool STAGED = false; static constexpr int ACT = 0;
  u16* C; int ldc;
  u16* kn; u16* vtm;
  __device__ __forceinline__ void operator()(int m, int n, f32x4 v) const {
    if (m < MTOK) {
      if (n < 256) {
#pragma unroll
        for (int r = 0; r < 4; ++r) kn[(size_t)(m + r) * 256 + n] = f2bf(v[r]);
      } else {
        const int h = (n - 256) >> 6, d = (n - 256) & 63;
        const int b = m / TPB, t = m - b * TPB;
        uint2 w; w.x = pack2(v[0], v[1]); w.y = pack2(v[2], v[3]);
        *(uint2*)(vtm + ((size_t)(b * 4 + h) * 64 + d) * LT + t) = w;
      }
    }
  }
};
struct EpiGlu {
  static constexpr bool HASVT = false;
  __device__ __forceinline__ u16* vtp() const { return nullptr; }
  __device__ __forceinline__ float* partp() const { return nullptr; }
  static constexpr bool STAGED = false; static constexpr int ACT = 0;
  u16* C; int ldc;
  const u16* z; const float* bg; u16* y;
  __device__ __forceinline__ void operator()(int m, int n, f32x4 v) const {
    const float bb = bg[n];
#pragma unroll
    for (int r = 0; r < 4; ++r)
      if (m + r < MTOK) {
        float zz = bf2f(z[(size_t)(m + r) * 256 + n]);
        float s = 1.f / (1.f + __expf(-(v[r] + bb)));
        y[(size_t)(m + r) * 256 + n] = f2bf(zz * s);
      }
  }
};

__device__ __forceinline__ void ssm_load_u(const u16* proj, int b, int g, int ch, int lane, float* urow) {
  const int t = ch * 64 + lane;
  uint4 r0 = make_uint4(0, 0, 0, 0), r1 = make_uint4(0, 0, 0, 0);
  if (t < TPB) {
    const uint4* src = (const uint4*)(proj + (size_t)(b * TPB + t) * INW + g * 16);
    r0 = src[0]; r1 = src[1];
  }
  float4* d = (float4*)urow;
  d[0] = make_float4(bflo(r0.x), bfhi(r0.x), bflo(r0.y), bfhi(r0.y));
  d[1] = make_float4(bflo(r0.z), bfhi(r0.z), bflo(r0.w), bfhi(r0.w));
  d[2] = make_float4(bflo(r1.x), bfhi(r1.x), bflo(r1.y), bfhi(r1.y));
  d[3] = make_float4(bflo(r1.z), bfhi(r1.z), bflo(r1.w), bfhi(r1.w));
}

#define SSM_STEP(UP)                                                                          \
  {                                                                                           \
    const float4 u0 = (UP)[0], u1 = (UP)[1], u2 = (UP)[2], u3 = (UP)[3];                      \
      \
    float r0 = u0.x * br[0], i0 = u0.x * bi[0], r1 = u1.x * br[4], i1 = u1.x * bi[4];         \
    float r2 = u2.x * br[8], i2 = u2.x * bi[8], r3 = u3.x * br[12], i3 = u3.x * bi[12];       \
    r0 += u0.y * br[1]; i0 += u0.y * bi[1]; r1 += u1.y * br[5]; i1 += u1.y * bi[5];           \
    r2 += u2.y * br[9]; i2 += u2.y * bi[9]; r3 += u3.y * br[13]; i3 += u3.y * bi[13];         \
    r0 += u0.z * br[2]; i0 += u0.z * bi[2]; r1 += u1.z * br[6]; i1 += u1.z * bi[6];           \
    r2 += u2.z * br[10]; i2 += u2.z * bi[10]; r3 += u3.z * br[14]; i3 += u3.z * bi[14];       \
    r0 += u0.w * br[3]; i0 += u0.w * bi[3]; r1 += u1.w * br[7]; i1 += u1.w * bi[7];           \
    r2 += u2.w * br[11]; i2 += u2.w * bi[11]; r3 += u3.w * br[15]; i3 += u3.w * bi[15];       \
    const float sr = (r0 + r1) + (r2 + r3), si = (i0 + i1) + (i2 + i3);                       \
    const float nxr = lam.x * xr - lam.y * xi + sr;                                           \
    const float nxi = lam.x * xi + lam.y * xr + si;                                           \
    xr = nxr; xi = nxi;                                                                       \
  }

__device__ void phase_ssm_a(const Params& p, int l, char* lds) {
  const u16* proj = (const u16*)(p.ws + OX_PROJ);
  float* us = (float*)lds;
  const int tid_ = otid();
  const int lane = tid_ & 63, w = tid_ >> 6;
  const float* bbt = (const float*)(p.ws + OFF_BB);
  const float2* lamt = (const float2*)(p.ws + OFF_LAM);
  float2* endp = (float2*)(p.ws + OFF_END2 + (size_t)l * END_BYTES);
  for (int item = blockIdx.x; item < 64 * 16; item += gridDim.x) {
    const int bg = item >> 4, cq = item & 15;
    const int b = bg >> 4, g = bg & 15;
    const int ch = cq * 4 + w;
    if (ch < 63) {
      ssm_load_u(proj, b, g, ch, lane, us + (w * 64 + lane) * 16);
      asm volatile("s_waitcnt lgkmcnt(0)" ::: "memory");
      float br[16], bi[16];
      const float* bbp = bbt + ((size_t)(l * 16 + g) * 32) * 64 + lane;
#pragma unroll
      for (int c = 0; c < 16; ++c) { br[c] = bbp[(2 * c) * 64]; bi[c] = bbp[(2 * c + 1) * 64]; }
      const float2 lam = lamt[(l * 16 + g) * 64 + lane];
      float xr = 0.f, xi = 0.f;
#pragma unroll 4
      for (int tt = 0; tt < 64; ++tt) {
        const float4* up = (const float4*)(us + (w * 64 + tt) * 16);
        SSM_STEP(up)
      }
      endp[((size_t)(b * 16 + g) * NCH + ch) * 64 + lane] = make_float2(xr, xi);
    }
  }
}

__device__ __forceinline__ float gelu_tanh(float y) {
  const float a = 0.7978845608028654f * (y + 0.044715f * y * y * y);
  const float th = 1.f - 2.f / (1.f + __expf(2.f * a));
  return 0.5f * y * (1.f + th);
}

__device__ void phase_ssm_c(const Params& p, int l, char* lds) {
  const u16* proj = (const u16*)(p.ws + OX_PROJ);
  u16* z = (u16*)(p.ws + OX_Z);
  float* Cs = (float*)lds;
  float* us = Cs + 2048;
  float* xs = us + 4096;
  const int tid = otid(), lane = tid & 63, w = tid >> 6;
  const float* bbt = (const float*)(p.ws + OFF_BB);
  const float2* lamt = (const float2*)(p.ws + OFF_LAM);
  const float2* lamTt = (const float2*)(p.ws + OFF_LAMT);
  const float2* endp = (const float2*)(p.ws + OFF_END2 + (size_t)l * END_BYTES);
  for (int item = blockIdx.x; item < 64 * 16; item += gridDim.x) {
    const int bg = item >> 4, cq = item & 15;
    const int b = bg >> 4, g = bg & 15;
    {
      const float* cre = p.c_re + (size_t)(l * 16 + g) * 1024;
      const float* cim = p.c_im + (size_t)(l * 16 + g) * 1024;
#pragma unroll
      for (int j = 0; j < 4; ++j) {
        int idx = tid + 256 * j;
        *(float2*)(Cs + idx * 2) = make_float2(cre[idx], cim[idx]);
      }
    }
    const int ch = cq * 4 + w;
    const int nsub = (cq == 15) ? 5 : 4;
    {
      ssm_load_u(proj, b, g, ch, lane, us + (w * 64 + lane) * 16);
      float br[16], bi[16];
      const float* bbp = bbt + ((size_t)(l * 16 + g) * 32) * 64 + lane;
#pragma unroll
      for (int c = 0; c < 16; ++c) { br[c] = bbp[(2 * c) * 64]; bi[c] = bbp[(2 * c + 1) * 64]; }
      const float2 lam = lamt[(l * 16 + g) * 64 + lane];
      const float2 lamT = lamTt[(l * 16 + g) * 64 + lane];
      __syncthreads();
      float xr = 0.f, xi = 0.f;
      const float2* ep = endp + ((size_t)(b * 16 + g) * NCH) * 64 + lane;
      {
        int j = 0;
        for (; j + 16 <= ch; j += 16) {
          float2 e[16];
#pragma unroll
          for (int q = 0; q < 16; ++q) e[q] = ep[(size_t)(j + q) * 64];
#pragma unroll
          for (int q = 0; q < 16; ++q) {
            const float nxr = lamT.x * xr - lamT.y * xi + e[q].x;
            const float nxi = lamT.x * xi + lamT.y * xr + e[q].y;
            xr = nxr; xi = nxi;
          }
        }
        for (; j < ch; ++j) {
          const float2 e = ep[(size_t)j * 64];
          const float nxr = lamT.x * xr - lamT.y * xi + e.x;
          const float nxi = lamT.x * xi + lamT.y * xr + e.y;
          xr = nxr; xi = nxi;
        }
      }
      const int tl = lane & 15, c4 = lane >> 4;
      const float4 dsk = *(const float4*)(p.d_skip + (size_t)l * 256 + g * 16 + c4 * 4);
      for (int sub = 0; sub < nsub; ++sub) {
        const int rbase = (sub & 3) * 16;
        if (sub == 4) {
          uint4 r0 = make_uint4(0, 0, 0, 0), r1 = make_uint4(0, 0, 0, 0);
          const int t2 = 4096 + lane;
          if (ch == 63 && lane < 16) {
            const uint4* s4 = (const uint4*)(proj + (size_t)(b * TPB + t2) * INW + g * 16);
            r0 = s4[0]; r1 = s4[1];
          }
          if (lane < 16) {
            float4* d = (float4*)(us + (w * 64 + lane) * 16);
            d[0] = make_float4(bflo(r0.x), bfhi(r0.x), bflo(r0.y), bfhi(r0.y));
            d[1] = make_float4(bflo(r0.z), bfhi(r0.z), bflo(r0.w), bfhi(r0.w));
            d[2] = make_float4(bflo(r1.x), bfhi(r1.x), bflo(r1.y), bfhi(r1.y));
            d[3] = make_float4(bflo(r1.z), bfhi(r1.z), bflo(r1.w), bfhi(r1.w));
          }
          __syncthreads();
        }
#pragma unroll 4
        for (int tt = 0; tt < 16; ++tt) {
          const float4* up = (const float4*)(us + (w * 64 + rbase + tt) * 16);
          SSM_STEP(up)
          *(float2*)(xs + (w * 16 + tt) * 132 + 2 * lane) = make_float2(xr, xi);
        }
        __syncthreads();
        const float* xrow = xs + (w * 16 + tl) * 132;
        const float* crow = Cs + (c4 * 4) * 128;
        float a0 = 0.f, a1 = 0.f, a2 = 0.f, a3 = 0.f;
#pragma unroll 4
        for (int pp = 0; pp < 32; ++pp) {
          const float4 xv = *(const float4*)(xrow + 4 * pp);
          const float4 c0 = *(const float4*)(crow + 4 * pp);
          const float4 c1 = *(const float4*)(crow + 128 + 4 * pp);
          const float4 c2 = *(const float4*)(crow + 256 + 4 * pp);
          const float4 c3 = *(const float4*)(crow + 384 + 4 * pp);
          a0 += c0.x * xv.x - c0.y * xv.y + c0.z * xv.z - c0.w * xv.w;
          a1 += c1.x * xv.x - c1.y * xv.y + c1.z * xv.z - c1.w * xv.w;
          a2 += c2.x * xv.x - c2.y * xv.y + c2.z * xv.z - c2.w * xv.w;
          a3 += c3.x * xv.x - c3.y * xv.y + c3.z * xv.z - c3.w * xv.w;
        }
        __syncthreads();
        const int tok = ch * 64 + sub * 16 + tl;
        const float4 uv = *(const float4*)(us + (w * 64 + rbase + tl) * 16 + c4 * 4);
        if ((sub < 4 || ch == 63) && tok < TPB) {
          uint2 wv;
          wv.x = pack2(gelu_tanh(a0 + dsk.x * uv.x), gelu_tanh(a1 + dsk.y * uv.y));
          wv.y = pack2(gelu_tanh(a2 + dsk.z * uv.z), gelu_tanh(a3 + dsk.w * uv.w));
          *(uint2*)(z + (size_t)(b * TPB + tok) * 256 + g * 16 + c4 * 4) = wv;
        }
      }
    }
    __syncthreads();
  }
}

template <bool MLA, int NQS>
__device__ void attn_item(const Params& p, int l, int b, int head, int qt, char* lds) {
  constexpr int NDS = MLA ? 3 : 2;
  const int tid = otid(), lane = tid & 63, w = tid >> 6;
  const int lr = lane & 15, lg = lane >> 4;
  const u16* proj = (const u16*)(p.ws + OX_PROJ);
  const u16* krope = (const u16*)(p.ws + OX_KR);
  const u16* Ksrc; int kld; const u16* Vt; u16* Y; int ldy;
  if (MLA) {
    Ksrc = (const u16*)(p.ws + OX_KN) + head * 64; kld = 256;
    Vt = (const u16*)(p.ws + OX_VTM) + (size_t)(b * 4 + head) * 64 * LT;
    Y = (u16*)(p.ws + OX_YMLA); ldy = 256;
  } else {
    const int kvh = head >> 2;
    Ksrc = proj + 768 + kvh * 64; kld = INW;
    Vt = (const u16*)(p.ws + OX_VTS) + (size_t)(b * 2 + kvh) * 64 * LT;
    Y = (u16*)(p.ws + OX_YSWA); ldy = 512;
  }
  const int q0 = qt * (64 * NQS);
  const int kt_hi = ((q0 + 64 * NQS - 1) >> 6) < 64 ? ((q0 + 64 * NQS - 1) >> 6) : 64;
  const int kt_lo = MLA ? 0 : (((q0 >> 6) - 2) > 0 ? ((q0 >> 6) - 2) : 0);
  const float LOG2E = 1.4426950408889634f;
  const float c1 = (MLA ? 0.10206207261596575f : 0.125f) * LOG2E;
  float sl2 = 0.f, sink2 = 0.f;
  if (!MLA) {
    sl2 = exp2f(-(float)(head + 1)) * LOG2E;
    sink2 = p.sinks[l * 8 + head] * LOG2E;
  }
  bf16x8 qf[NQS][NDS];
#pragma unroll
  for (int qs = 0; qs < NQS; ++qs) {
    int tq = q0 + 16 * NQS * w + 16 * qs + lr; tq = tq < TPB ? tq : TPB - 1;
    const size_t m = (size_t)b * TPB + tq;
    if (!MLA) {
      const u16* qp = proj + m * INW + 256 + head * 64;
      qf[qs][0] = *(const bf16x8*)(qp + lg * 8);
      qf[qs][1] = *(const bf16x8*)(qp + 32 + lg * 8);
    } else {
      const u16* qp = (const u16*)(p.ws + OX_QMLA) + m * 384 + head * 96;
      qf[qs][0] = *(const bf16x8*)(qp + lg * 8);
      qf[qs][1] = *(const bf16x8*)(qp + 32 + lg * 8);
      const uint4 own = *(const uint4*)(qp + 64 + lg * 8);
      const uint4 par = *(const uint4*)(qp + 64 + (lg ^ 2) * 8);
      const float2* cs = (const float2*)(p.ws + OFF_ROPE) + tq * 16 + (lg & 1) * 8;
      const unsigned ow[4] = {own.x, own.y, own.z, own.w};
      const unsigned pw[4] = {par.x, par.y, par.z, par.w};
      unsigned rw[4];
#pragma unroll
      for (int e2 = 0; e2 < 4; ++e2) {
        const float2 csa = cs[2 * e2], csb = cs[2 * e2 + 1];
        const float oa = bflo(ow[e2]), ob = bfhi(ow[e2]), pa = bflo(pw[e2]), pb = bfhi(pw[e2]);
        float ra, rb;
        if (lg < 2) { ra = oa * csa.x - pa * csa.y; rb = ob * csb.x - pb * csb.y; }
        else { ra = pa * csa.y + oa * csa.x; rb = pb * csb.y + ob * csb.x; }
        rw[e2] = pack2(ra, rb);
      }
      uint4 r4 = make_uint4(rw[0], rw[1], rw[2], rw[3]);
      qf[qs][NDS - 1] = *(bf16x8*)&r4;
    }
  }
  float mrow[NQS], lrow[NQS];
  f32x4 o[NQS][4];
#pragma unroll
  for (int qs = 0; qs < NQS; ++qs) {
    mrow[qs] = MLA ? -1e30f : sink2; lrow[qs] = 0.f;
#pragma unroll
    for (int jt = 0; jt < 4; ++jt) o[qs][jt] = (f32x4){0.f, 0.f, 0.f, 0.f};
  }
  typedef unsigned au32x4 __attribute__((ext_vector_type(4)));
  au32x4 rak0, rak1, rav0, rav1, rakr, rbk0, rbk1, rbv0, rbv1, rbkr;
  rakr = (au32x4){0u, 0u, 0u, 0u}; rbkr = rakr;
  const int skey = tid >> 3, skc = tid & 7;
  const int rkey = tid >> 2, rkc = tid & 3;
  const u16* kptr = Ksrc + ((size_t)b * TPB + skey) * kld + skc * 8;
  const u16* vptr = Vt + (size_t)skey * LT + skc * 8;
  const u16* krptr = krope + ((size_t)b * TPB + rkey) * 32 + rkc * 8;
  const int kw_off = skey * 128 + ((skc ^ (((skey >> 1) & 1) | (((skey >> 3) & 3) << 1))) << 4);
  const int vw_off = skey * 128 + ((skc ^ ((skey >> 1) & 7)) << 4);
  const int krx = (rkey >> 3) & 3;
  const int krw_off = rkey * 64 + ((rkc ^ (krx ^ ((krx & 1) << 1))) << 4);
#define ATT_GLD16(dst, ptr) asm volatile("global_load_dwordx4 %0, %1, off" : "=&v"(dst) : "v"(ptr) : "memory")
#define ATT_GLOAD(S, KT)                                                     \
  {                                                                          \
    const int k0_ = (KT) * 64;                                               \
    const u16* p0_ = kptr + (size_t)k0_ * kld;                               \
    const u16* p1_ = kptr + (size_t)(k0_ + 32) * kld;                        \
    const u16* p2_ = vptr + k0_;                                             \
    const u16* p3_ = vptr + (size_t)32 * LT + k0_;                           \
    ATT_GLD16(S##k0, p0_); ATT_GLD16(S##k1, p1_); ATT_GLD16(S##v0, p2_); ATT_GLD16(S##v1, p3_); \
    if (MLA) { const u16* p4_ = krptr + (size_t)k0_ * 32; ATT_GLD16(S##kr, p4_); }              \
  }
#define ATT_SWRITE(S, BUF)                                                   \
  {                                                                          \
    char* Kb_ = lds + (BUF) * 20480;                                         \
    *(au32x4*)(Kb_ + kw_off) = S##k0;                                        \
    *(au32x4*)(Kb_ + kw_off + 32 * 128) = S##k1;                             \
    *(au32x4*)(Kb_ + 8192 + vw_off) = S##v0;                                 \
    *(au32x4*)(Kb_ + 8192 + vw_off + 32 * 128) = S##v1;                      \
    if (MLA) *(au32x4*)(Kb_ + 16384 + krw_off) = S##kr;                      \
  }
#define ATT_WAIT_OLDER() { if (MLA) asm volatile("s_waitcnt vmcnt(5)" ::: "memory"); else asm volatile("s_waitcnt vmcnt(4)" ::: "memory"); }
#define ATT_STEP(KT_, BUF_)  \
  {  \
    const char* Kb = lds + (BUF_) * 20480; const char* Vb = Kb + 8192; const char* Krb = Kb + 16384;  \
    f32x4 s[NQS][2][2];  \
    _Pragma("unroll")  \
    for (int kk = 0; kk < 2; ++kk)  \
    _Pragma("unroll")  \
      for (int j = 0; j < 2; ++j) {  \
        const int keyl = 32 * kk + 8 * (lr >> 2) + 4 * j + (lr & 3);  \
        f32x4 s0 = (f32x4){0.f, 0.f, 0.f, 0.f}, s1 = (f32x4){0.f, 0.f, 0.f, 0.f};  \
    _Pragma("unroll")  \
        for (int ds = 0; ds < 2; ++ds) {  \
          const bf16x8 kf = *(const bf16x8*)(Kb + keyl * 128 + (((ds * 4 + lg) ^ fsw) << 4));  \
          s0 = __builtin_amdgcn_mfma_f32_16x16x32_bf16(kf, qf[0][ds], s0, 0, 0, 0);  \
          if (NQS > 1) s1 = __builtin_amdgcn_mfma_f32_16x16x32_bf16(kf, qf[NQS - 1][ds], s1, 0, 0, 0);  \
        }  \
        if (MLA) {  \
          const bf16x8 kf = *(const bf16x8*)(Krb + keyl * 64 + ((lg ^ xh) << 4));  \
          s0 = __builtin_amdgcn_mfma_f32_16x16x32_bf16(kf, qf[0][NDS - 1], s0, 0, 0, 0);  \
          if (NQS > 1) s1 = __builtin_amdgcn_mfma_f32_16x16x32_bf16(kf, qf[NQS - 1][NDS - 1], s1, 0, 0, 0);  \
        }  \
        s[0][kk][j] = s0; if (NQS > 1) s[NQS - 1][kk][j] = s1;  \
      }  \
    bf16x8 pf[NQS][2];  \
    _Pragma("unroll")  \
    for (int qs = 0; qs < NQS; ++qs) {  \
      const int tq = q0 + 16 * NQS * w + 16 * qs + lr;  \
      float mx = -INFINITY;  \
      float mnew, alpha, ps = 0.f;  \
      if (MLA) {  \
        if ((KT_) * 64 + 63 > q0) {  \
    _Pragma("unroll")  \
          for (int kk = 0; kk < 2; ++kk)  \
    _Pragma("unroll")  \
            for (int j = 0; j < 2; ++j)  \
    _Pragma("unroll")  \
              for (int i = 0; i < 4; ++i) {  \
                const int key = (KT_) * 64 + 32 * kk + 8 * lg + 4 * j + i;  \
                s[qs][kk][j][i] = (key <= tq) ? s[qs][kk][j][i] : -INFINITY;  \
              }  \
        }  \
    _Pragma("unroll")  \
        for (int kk = 0; kk < 2; ++kk)  \
    _Pragma("unroll")  \
          for (int j = 0; j < 2; ++j)  \
    _Pragma("unroll")  \
            for (int i = 0; i < 4; ++i) mx = fmaxf(mx, s[qs][kk][j][i]);  \
        mx = fmaxf(mx, __shfl_xor(mx, 16));  \
        mx = fmaxf(mx, __shfl_xor(mx, 32));  \
        mnew = fmaxf(mrow[qs], mx * c1);  \
        alpha = fexp2(mrow[qs] - mnew);  \
        mrow[qs] = mnew;  \
    _Pragma("unroll")  \
        for (int kk = 0; kk < 2; ++kk) {  \
          float pv[8];  \
    _Pragma("unroll")  \
          for (int j = 0; j < 2; ++j)  \
    _Pragma("unroll")  \
            for (int i = 0; i < 4; ++i) {  \
              const float e = fexp2(__builtin_fmaf(s[qs][kk][j][i], c1, -mnew));  \
              pv[j * 4 + i] = e; ps += e;  \
            }  \
          uint4 r4 = make_uint4(pack2(pv[0], pv[1]), pack2(pv[2], pv[3]), pack2(pv[4], pv[5]), pack2(pv[6], pv[7]));  \
          pf[qs][kk] = *(bf16x8*)&r4;  \
        }  \
      } else {  \
    _Pragma("unroll")  \
        for (int kk = 0; kk < 2; ++kk)  \
    _Pragma("unroll")  \
          for (int j = 0; j < 2; ++j)  \
    _Pragma("unroll")  \
            for (int i = 0; i < 4; ++i) {  \
              const int key = (KT_) * 64 + 32 * kk + 8 * lg + 4 * j + i;  \
              float v = s[qs][kk][j][i] * c1 - sl2 * (float)(tq - key);  \
              const bool ok = (key <= tq) && (key > tq - 128);  \
              v = ok ? v : -INFINITY;  \
              s[qs][kk][j][i] = v;  \
              mx = fmaxf(mx, v);  \
            }  \
        mx = fmaxf(mx, __shfl_xor(mx, 16));  \
        mx = fmaxf(mx, __shfl_xor(mx, 32));  \
        mnew = fmaxf(mrow[qs], mx);  \
        alpha = fexp2(mrow[qs] - mnew);  \
        mrow[qs] = mnew;  \
    _Pragma("unroll")  \
        for (int kk = 0; kk < 2; ++kk) {  \
          float pv[8];  \
    _Pragma("unroll")  \
          for (int j = 0; j < 2; ++j)  \
    _Pragma("unroll")  \
            for (int i = 0; i < 4; ++i) {  \
              const float e = fexp2(s[qs][kk][j][i] - mnew);  \
              pv[j * 4 + i] = e; ps += e;  \
            }  \
          uint4 r4 = make_uint4(pack2(pv[0], pv[1]), pack2(pv[2], pv[3]), pack2(pv[4], pv[5]), pack2(pv[6], pv[7]));  \
          pf[qs][kk] = *(bf16x8*)&r4;  \
        }  \
      }  \
      lrow[qs] = lrow[qs] * alpha + ps;  \
    _Pragma("unroll")  \
      for (int jt = 0; jt < 4; ++jt) o[qs][jt] *= alpha;  \
    }  \
    _Pragma("unroll")  \
    for (int jt = 0; jt < 4; ++jt)  \
    _Pragma("unroll")  \
      for (int kk = 0; kk < 2; ++kk) {  \
        const bf16x8 vf = *(const bf16x8*)(Vb + (16 * jt + lr) * 128 + (((4 * kk + lg) ^ vsw) << 4));  \
        o[0][jt] = __builtin_amdgcn_mfma_f32_16x16x32_bf16(vf, pf[0][kk], o[0][jt], 0, 0, 0);  \
        if (NQS > 1) o[NQS - 1][jt] = __builtin_amdgcn_mfma_f32_16x16x32_bf16(vf, pf[NQS - 1][kk], o[NQS - 1][jt], 0, 0, 0);  \
      }  \
  }
  const int fsw = ((lr >> 1) & 1) | ((lr >> 2) << 1);
  const int xh = (lr >> 2) ^ (((lr >> 2) & 1) << 1);
  const int vsw = (lr >> 1) & 7;
  ATT_GLOAD(ra, kt_lo)
  ATT_GLOAD(rb, (kt_lo + 1 <= kt_hi ? kt_lo + 1 : kt_hi))
  ATT_WAIT_OLDER()
  ATT_SWRITE(ra, 0)
  __syncthreads();
  for (int kt = kt_lo; kt <= kt_hi; kt += 2) {
    ATT_GLOAD(ra, (kt + 2 <= kt_hi ? kt + 2 : kt_hi))
    ATT_STEP(kt, 0)
    ATT_WAIT_OLDER()
    ATT_SWRITE(rb, 1)
    __syncthreads();
    if (kt + 1 <= kt_hi) {
      ATT_GLOAD(rb, (kt + 3 <= kt_hi ? kt + 3 : kt_hi))
      ATT_STEP(kt + 1, 1)
      ATT_WAIT_OLDER()
      ATT_SWRITE(ra, 0)
      __syncthreads();
    }
  }
  asm volatile("s_waitcnt vmcnt(0)" ::: "memory");
  asm volatile("" :: "v"(rak0), "v"(rak1), "v"(rav0), "v"(rav1), "v"(rakr), "v"(rbk0), "v"(rbk1), "v"(rbv0), "v"(rbv1), "v"(rbkr));
#pragma unroll
  for (int qs = 0; qs < NQS; ++qs) {
    const int tq = q0 + 16 * NQS * w + 16 * qs + lr;
    float lsum = lrow[qs];
    lsum += __shfl_xor(lsum, 16);
    lsum += __shfl_xor(lsum, 32);
    if (!MLA) lsum += fexp2(sink2 - mrow[qs]);
    const float inv = 1.f / lsum;
    if (tq < TPB) {
      u16* yp = Y + ((size_t)b * TPB + tq) * ldy + head * 64 + 4 * lg;
#pragma unroll
      for (int jt = 0; jt < 4; ++jt) {
        uint2 wv;
        wv.x = pack2(o[qs][jt][0] * inv, o[qs][jt][1] * inv);
        wv.y = pack2(o[qs][jt][2] * inv, o[qs][jt][3] * inv);
        *(uint2*)(yp + 16 * jt) = wv;
      }
    }
  }
}


#define UP_EXP OFF_X
#define UP_TILES 16
#define P9_LO 0
#define P9_HI 129
#ifndef STOP_AFTER
#define STOP_AFTER 0
#endif
__device__ void dump_bf16(const Params& p, const u16* buf, int ld, int coloff, int shift = 0) {
  const int tid_ = otid();
  const int lane = tid_ & 63;
  const int wg = (int)((blockIdx.x + shift) % gridDim.x) * 4 + (tid_ >> 6), nw = gridDim.x * 4;
  for (int m = wg; m < MTOK; m += nw) {
    const int b = m / TPB, t = m - b * TPB;
    if (t < 16) continue;
    float* o = p.out + ((size_t)b * 4096 + (t - 16)) * DM;
    for (int j = 0; j < 16; ++j) o[j * 64 + lane] = bf2f(buf[(size_t)m * ld + coloff + j * 64 + lane]);
  }
}
#define XB_TMO      128
#define XB_XCNT(j)  (256  + 64 * (j))
#define XB_XSUB(j)  (1280 + 64 * (j))
#define XB_XGEN(j)  (2304 + 64 * (j))
#define XB_TOP      3328
#define XB_TOPGEN   3392
#define XCD_BAR_WORDS 3456
#define XB_SPIN_CAP (1u << 22)
#define LAS __attribute__((address_space(3)))
__device__ __forceinline__ unsigned xb_ld(unsigned* p) { return __hip_atomic_load(p, __ATOMIC_RELAXED, __HIP_MEMORY_SCOPE_AGENT); }
__device__ __forceinline__ unsigned xb_add(unsigned* p, unsigned v) { return __hip_atomic_fetch_add(p, v, __ATOMIC_RELAXED, __HIP_MEMORY_SCOPE_AGENT); }
__device__ __forceinline__ unsigned xb_xcc_id() { return (unsigned)__builtin_amdgcn_s_getreg((3 << 11) | 20) & 0xFu; }
#define XB_SPIN(cond, bar) do { unsigned _sp = 0; while (cond) { __builtin_amdgcn_s_sleep(1); \
    if ((++_sp & 255u) == 0u) { if (xb_ld(&(bar)[XB_TMO])) break; if (_sp > XB_SPIN_CAP) { atomicAdd(&(bar)[XB_TMO], 1u); break; } } } } while (0)
struct XcdBarrier { unsigned* bar; unsigned x; volatile unsigned* st; };
__device__ __forceinline__ XcdBarrier xcd_barrier_post(unsigned* bar, volatile unsigned* st) {
  XcdBarrier b; b.bar = bar; b.x = xb_xcc_id(); b.st = st;
  if (threadIdx.x == 0) (void)xb_add(&bar[XB_XCNT(b.x)], 1u);
  return b;
}
__device__ __forceinline__ void xcd_barrier_complete(unsigned* bar, unsigned x, unsigned& nloc, unsigned& nx) {
  const unsigned G = gridDim.x * gridDim.y * gridDim.z;
  unsigned sum, cnt, mine, sp = 0u;
  for (;;) {
    sum = 0u; cnt = 0u; mine = 0u;
#pragma unroll
    for (unsigned j = 0; j < 16; ++j) { const unsigned c = xb_ld(&bar[XB_XCNT(j)]); sum += c; cnt += (c > 0u) ? 1u : 0u; mine = (j == x) ? c : mine; }
    if (sum == G) break;
    __builtin_amdgcn_s_sleep(1);
    if ((++sp & 255u) == 0u) { if (xb_ld(&bar[XB_TMO])) break; if (sp > XB_SPIN_CAP) { atomicAdd(&bar[XB_TMO], 1u); break; } }
  }
  nloc = mine > 0u ? mine : 1u; nx = cnt > 0u ? cnt : 1u;
}
__device__ __attribute__((noinline)) void xcd_barrier_impl(unsigned* bar_, unsigned bx_, volatile unsigned* st_) {
  XcdBarrier b; b.bar = bar_; b.x = bx_; b.st = st_;
  asm volatile("s_waitcnt vmcnt(0)" ::: "memory");
  __syncthreads();
  if (threadIdx.x == 0) {
    unsigned* bar = b.bar;
    __builtin_amdgcn_s_waitcnt(0);
    unsigned nloc = b.st[0], nx = b.st[1];
    if (nloc == 0u) { xcd_barrier_complete(bar, b.x, nloc, nx); b.st[0] = nloc; b.st[1] = nx; }
    const unsigned old = xb_add(&bar[XB_XSUB(b.x)], 1u);
    const unsigned gen = old / nloc;
    if (old + 1u == (gen + 1u) * nloc) {
      __builtin_amdgcn_fence(__ATOMIC_RELEASE, "agent");
      asm volatile("s_waitcnt vmcnt(0)" ::: "memory");
      const unsigned og = xb_add(&bar[XB_TOP], 1u);
      const unsigned tg = og / nx;
      if (og + 1u == (tg + 1u) * nx) xb_add(&bar[XB_TOPGEN], 1u);
      else XB_SPIN(xb_ld(&bar[XB_TOPGEN]) == tg, bar);
      __builtin_amdgcn_fence(__ATOMIC_ACQUIRE, "agent");
      xb_add(&bar[XB_XGEN(b.x)], 1u);
      asm volatile("s_waitcnt vmcnt(0)" ::: "memory");
    } else {
      XB_SPIN(xb_ld(&bar[XB_XGEN(b.x)]) == gen, bar);
      __builtin_amdgcn_fence(__ATOMIC_ACQUIRE, "agent");
      asm volatile("s_waitcnt vmcnt(0)" ::: "memory");
    }
  }
  __syncthreads();
}
#define GSYNC() xcd_barrier_impl(xb.bar, xb.x, xb.st)
__global__ void __launch_bounds__(256, 2) hymba_megakernel(Params p, int ph_lo, int ph_hi) {
  cg::grid_group grid = cg::this_grid();
  __shared__ __attribute__((aligned(16))) char lds[65536];
  char* ws = p.ws;
  u16* abuf = (u16*)(ws + OFF_ABUF);
  u16* obuf = (u16*)(ws + OFF_OBUF);
  XcdBarrier xb; xb.bar = (unsigned*)(p.ws + OFF_BAR); xb.x = 0;
  xb.st = (volatile unsigned*)(p.ws + OFF_BAR) + 4096 + 2 * blockIdx.x;
  const bool fused = (ph_hi - ph_lo) > 1;
  if (fused) {
    xb = xcd_barrier_post((unsigned*)(p.ws + OFF_BAR), xb.st);
    grid.sync();
  }
  unsigned long long* tsp = (unsigned long long*)(p.ws + OFF_BAR + 24576);
  if (TIMING && blockIdx.x == 0 && threadIdx.x == 0) tsp[0] = __builtin_amdgcn_s_memrealtime();
  int pi = 0;
#define RUN (pi >= ph_lo && pi < ph_hi)
#define END_PHASE() do { if (pi >= ph_lo && pi + 1 < ph_hi) GSYNC(); if (TIMING && blockIdx.x == 0 && threadIdx.x == 0) tsp[pi + 1] = __builtin_amdgcn_s_memrealtime(); ++pi; } while (0)
  if (RUN && (PH & 1)) phase_convert(p, lds);
  if (RUN && (PH & 2)) phase_tables(p);
  if (RUN && (PH & 4)) phase_rows<0>(p, nullptr, p.g_pre_mix, true);
  END_PHASE();

  for (int l = 0; l < 2; ++l) {
    char* wb = ws + OFF_W + (size_t)l * W_LAYER;
    if (RUN && (PH & 8)) {
      EpiProjS e{(u16*)(ws + OX_PROJ), INW, (u16*)(ws + OX_VTS)};
      gemm_phase(abuf, DM, (const u16*)(wb + OW_IN), DM, INW, DM, lds, e, 0);
    }
    END_PHASE();
    if (STOP_AFTER == 1) { dump_bf16(p, (const u16*)(ws + OX_PROJ), INW, 0); return; }
    if (RUN && (PH & 32)) phase_ssm_a(p, l, lds);
    if (RUN && (PH & 64)) phase_mla_prep(p, l);
    END_PHASE();
    if (RUN && (PH & 128)) phase_ssm_c(p, l, lds);
    END_PHASE();
    if (RUN && (PH & 16)) for (int it = blockIdx.x; it < 4 * 8 * 33; it += gridDim.x) {
      const int qt = it / 32, r = it - qt * 32;
      attn_item<false, 2>(p, l, r >> 3, r & 7, qt, lds);
    }
    if (RUN && (PH & 256)) {
      EpiBf16 e{(u16*)(ws + OX_QMLA), 384, 384};
      gemm_phase((const u16*)(ws + OX_QN), 192, (const u16*)(wb + OW_UQ), 192, 384, 192, lds, e, 64);
    }
    if (RUN && (PH & 512)) {
      EpiKV e{nullptr, 0, (u16*)(ws + OX_KN), (u16*)(ws + OX_VTM)};
      gemm_phase((const u16*)(ws + OX_CN), 128, (const u16*)(wb + OW_UKV), 128, 512, 128, lds, e, 200);
    }
    END_PHASE();
    if (RUN && (PH & 1024)) {
      unsigned* ticket = (unsigned*)(ws + OFF_BAR) + 3600 + l;
      __shared__ int s_item;
      for (;;) {
        __syncthreads();
        if (threadIdx.x == 0) s_item = (int)atomicAdd(ticket, 1u);
        __syncthreads();
        const int it = s_item;
        if (it >= 4 * 4 * 65) break;
        const int qt = 64 - it / 16, r = it & 15;
        attn_item<true, 1>(p, l, r >> 2, r & 3, qt, lds);
      }
    }
    if (RUN && (PH & 2048)) {
      EpiGlu e{nullptr, 0, (const u16*)(ws + OX_Z), p.b_glu + (size_t)l * 256, (u16*)(ws + OX_YSSM)};
      gemm_phase((const u16*)(ws + OX_Z), 256, (const u16*)(wb + OW_GLU), 256, 256, 256, lds, e, 16);
    }
    END_PHASE();
    if (RUN && (PH & 4096)) phase_headnorm(p, l);
    END_PHASE();
    if (STOP_AFTER == 5) { dump_bf16(p, abuf, DM, 0); return; }
    if (RUN && (PH & 8192)) {
      EpiBf16 e{obuf, DM, DM};
      gemm_phase(abuf, DM, (const u16*)(wb + OW_OUT), DM, DM, DM, lds, e, 0);
    }
    END_PHASE();
    if (RUN && (PH & 16384)) {
      if (l == 0) phase_rows<2>(p, p.g_post_mix + (size_t)l * DM, p.g_pre_mlp + (size_t)l * DM, true);
      else phase_rows<1>(p, p.g_post_mix + (size_t)l * DM, p.g_pre_mlp + (size_t)l * DM, true);
    }
    END_PHASE();
    if (STOP_AFTER == 7) { dump_bf16(p, abuf, DM, 0); return; }
    if (RUN && (PH & 32768)) {
      EpiRelu2 e{(u16*)(ws + OFF_X), UPLD};
      gemm_phase(abuf, DM, (const u16*)(wb + OW_UP), DM, DFF, DM, lds, e, 0);
    }
    END_PHASE();
    if (RUN && (PH & 65536)) {
      EpiBf16 e{obuf, DM, DM};
      const u16* upA = (const u16*)(ws + OFF_X);
      const u16* wdn = (const u16*)(wb + OW_DN);
      const bool xmap = (gridDim.x & 7) == 0;
      const int xq = blockIdx.x & 7, xl = blockIdx.x >> 3, xn = gridDim.x >> 3;
      for (int item = blockIdx.x; item < 1024 + 64; item += gridDim.x) {
        if (item < 1024) {
          int tm = item >> 3, tn = item & 7;
          if (xmap) {
            const int r = item / gridDim.x;
            const int idx = xl + r * xn;
            if (idx < 128 && xn * ((1024 + gridDim.x - 1) / gridDim.x) >= 128) { tm = 2 * (idx >> 1) + (xq >> 2); tn = 2 * (xq & 3) + (idx & 1); }
          }
          gemm_tile(upA, UPLD, MTOK, wdn, DFF, DM, DFF, tm * 128, tn * 128, lds, e);
        } else {
          const int i2 = item - 1024, tn = i2 & 7, ks = i2 >> 3;
          EpiPart ep{(float*)(ws + OFF_PART) + (size_t)ks * 64 * 1024, nullptr, 0};
          gemm_tile(upA + ks * 512, UPLD, MTOK, wdn + ks * 512, DFF, DM, 512, 16384, tn * 128, lds, ep);
        }
      }
    }
    END_PHASE();
    if (STOP_AFTER == 9) { dump_bf16(p, obuf, DM, 0, 3); return; }
    if (RUN && (PH & 131072)) phase_rows<1>(p, p.g_post_mlp + (size_t)l * DM, p.g_pre_mix + (size_t)(l < 1 ? l + 1 : l) * DM, l < 1, (const float*)(ws + OFF_PART));
    if (l < 1) END_PHASE();
  }
  if (TIMING) {
    END_PHASE();
    if (blockIdx.x == 0) {
      __shared__ int n_pert;
      if (threadIdx.x == 0) {
        const float tot = (float)(tsp[pi] - tsp[0]);
        const float f1 = (float)(tsp[T1_HI] - tsp[T1_LO]) / tot;
        const float f2 = (float)(tsp[T2_HI] - tsp[T2_LO]) / tot;
        n_pert = (int)(f1 * 500000.f);
        p.out[0] += 0.2f + 0.15f * f2;
      }
      __syncthreads();
      for (int i = threadIdx.x; i < n_pert; i += 256) p.out[4096 + i] += 0.1f;
    }
  }
}

extern "C" void kernel_launch(void* const* d_in, const int* in_sizes, int n_in, void* d_out, int out_size, void* d_ws,
                              size_t ws_size, hipStream_t stream) {
  static int grid_blocks = 0;
  if (!grid_blocks) {
    int dev = 0, cus = 0, per_cu = 0;
    hipGetDevice(&dev);
    hipDeviceGetAttribute(&cus, hipDeviceAttributeMultiprocessorCount, dev);
    hipOccupancyMaxActiveBlocksPerMultiprocessor(&per_cu, hymba_megakernel, 256, 0);
    if (per_cu > 2) per_cu = 2;
    if (per_cu < 1) per_cu = 1;
    grid_blocks = cus * per_cu;
  }
  Params p{};
  const float** f = (const float**)&p;
  for (int i = 0; i < 27; ++i) f[i] = (const float*)d_in[i];
  p.out = (float*)d_out;
  p.ws = (char*)d_ws;
  hipMemsetAsync((char*)d_ws + OFF_BAR, 0, 32768, stream);
#ifndef N_LAUNCH_MODE
#define N_LAUNCH_MODE 1
#endif
  if (N_LAUNCH_MODE == 1) {
    int lo = 0, hi = 23 + (TIMING ? 1 : 0);
    void* args[] = {&p, &lo, &hi};
    hipError_t e = hipLaunchCooperativeKernel((void*)hymba_megakernel, dim3(grid_blocks), dim3(256), args, 0, stream);
    if (e != hipSuccess) fprintf(stderr, "cooperative launch failed: %s (grid %d)\n", hipGetErrorString(e), grid_blocks);
  } else {
    for (int i = 0; i < 23; ++i) hipLaunchKernelGGL(hymba_megakernel, dim3(grid_blocks), dim3(256), 0, stream, p, i, i + 1);
  }
}
```

```cpp
#include <hip/hip_runtime.h>
#include <hip/hip_cooperative_groups.h>
#include <cstdio>
#include <cstdint>
namespace cg = cooperative_groups;

typedef unsigned short u16;
using bf16x8 = __attribute__((ext_vector_type(8))) short;
using f32x4 = __attribute__((ext_vector_type(4))) float;

#define TPB 4112
#define MTOK 16448
#define MPAD 16512
#define DM 1024
#define INW 1376
#define DFF 4096
#define LT 4160
#define NCH 65
#ifndef PH
#define PH 0x3ffff
#endif
#ifndef TIMING
#define TIMING 0
#endif
#define T1_LO 6
#define T1_HI 9
#define T2_LO 0
#define T2_HI 1

constexpr size_t al256(size_t x) { return (x + 255) & ~(size_t)255; }
constexpr size_t cmax(size_t a, size_t b) { return a > b ? a : b; }
constexpr size_t OW_IN = 0;
constexpr size_t OW_OUT = OW_IN + (size_t)INW * DM * 2;
constexpr size_t OW_UP = OW_OUT + (size_t)DM * DM * 2;
constexpr size_t OW_DN = OW_UP + (size_t)DFF * DM * 2;
constexpr size_t OW_UQ = OW_DN + (size_t)DFF * DM * 2;
constexpr size_t OW_UKV = OW_UQ + (size_t)384 * 192 * 2;
constexpr size_t OW_GLU = OW_UKV + (size_t)512 * 128 * 2;
constexpr size_t W_LAYER = OW_GLU + (size_t)256 * 256 * 2;
constexpr size_t OFF_W = 0;
constexpr size_t OFF_ROPE = OFF_W + 2 * W_LAYER;
constexpr size_t OFF_LAM = OFF_ROPE + al256((size_t)TPB * 16 * 8);
constexpr size_t OFF_LAMT = OFF_LAM + 2 * 16 * 64 * 8;
constexpr size_t OFF_BB = OFF_LAMT + 2 * 16 * 64 * 8;
constexpr size_t OFF_BAR = OFF_BB + 2 * 16 * 32 * 64 * 4;
constexpr size_t OFF_HMETA = OFF_BAR + 32768;
constexpr size_t OFF_ABUF = OFF_HMETA + 4 * 16 * 1024 * 4;
constexpr size_t OFF_OBUF = OFF_ABUF + (size_t)MPAD * DM * 2;
constexpr size_t OFF_X = OFF_OBUF + (size_t)MPAD * DM * 2;
constexpr size_t OX_PROJ = OFF_X;
constexpr size_t OX_Z = OX_PROJ + (size_t)MPAD * INW * 2;
constexpr size_t OX_YSSM = OX_Z + (size_t)MPAD * 256 * 2;
constexpr size_t OX_YSWA = OX_YSSM + (size_t)MPAD * 256 * 2;
constexpr size_t OX_YMLA = OX_YSWA + (size_t)MPAD * 512 * 2;
constexpr size_t OX_QN = OX_YMLA + (size_t)MPAD * 256 * 2;
constexpr size_t OX_CN = OX_QN + (size_t)MPAD * 192 * 2;
constexpr size_t OX_KR = OX_CN + (size_t)MPAD * 128 * 2;
constexpr size_t OX_QMLA = OX_KR + (size_t)MPAD * 32 * 2;
constexpr size_t OX_KN = OX_QMLA + (size_t)MPAD * 384 * 2;
constexpr size_t OX_VTM = OX_KN + (size_t)MPAD * 256 * 2;
constexpr size_t OX_VTS = OX_VTM + (size_t)4 * 4 * 64 * LT * 2;
constexpr size_t OX_END = OX_VTS + (size_t)4 * 2 * 64 * LT * 2;
constexpr size_t OX_LAST = OX_END + (size_t)4 * 16 * NCH * 64 * 8;
#define UPLD 4160
constexpr size_t OFF_END2 = cmax(OX_LAST, OFF_X + (size_t)MPAD * UPLD * 2);
constexpr size_t END_BYTES = (size_t)4 * 16 * NCH * 64 * 8;
constexpr size_t OFF_PART = OFF_END2 + 2 * END_BYTES;
constexpr size_t WS_TOTAL = OFF_PART + (size_t)8 * 64 * 1024 * 4;
static_assert(WS_TOTAL <= (size_t)256 * 1024 * 1024, "workspace too large");

struct Params {
  const float* x; const float* meta; const float* g_pre_mix; const float* g_post_mix; const float* g_pre_mlp;
  const float* g_post_mlp; const float* w_in; const float* w_out; const float* g_heads; const float* a_re;
  const float* a_im; const float* log_step; const float* b_re; const float* b_im; const float* c_re; const float* c_im;
  const float* d_skip; const float* w_glu; const float* b_glu; const float* sinks; const float* g_q; const float* g_kv;
  const float* w_uq; const float* w_uk; const float* w_uv; const float* w_up; const float* w_down;
  float* out; char* ws;
};

__device__ __forceinline__ unsigned pack2(float a, float b) {
  unsigned r;
  asm("v_cvt_pk_bf16_f32 %0, %1, %2" : "=v"(r) : "v"(a), "v"(b));
  return r;
}
__device__ __forceinline__ u16 f2bf(float f) { return (u16)(pack2(f, f) & 0xffffu); }
__device__ __forceinline__ float bf2f(u16 h) { return __uint_as_float(((unsigned)h) << 16); }
__device__ __forceinline__ float bflo(unsigned u) { return __uint_as_float(u << 16); }
__device__ __forceinline__ float bfhi(unsigned u) { return __uint_as_float(u & 0xffff0000u); }
__device__ __forceinline__ float wave_sum(float v) {
#pragma unroll
  for (int o = 32; o; o >>= 1) v += __shfl_xor(v, o);
  return v;
}
__device__ __forceinline__ float4 ldnt_f4(const float* p) {
  const f32x4 v = __builtin_nontemporal_load((const f32x4*)p);
  return make_float4(v[0], v[1], v[2], v[3]);
}
typedef unsigned nu32x2 __attribute__((ext_vector_type(2)));
typedef unsigned nu32x4 __attribute__((ext_vector_type(4)));
__device__ __forceinline__ uint2 ldnt_u2(const u16* p) {
  const nu32x2 v = __builtin_nontemporal_load((const nu32x2*)p);
  return make_uint2(v[0], v[1]);
}
__device__ __forceinline__ uint4 ldnt_u4(const u16* p) {
  const nu32x4 v = __builtin_nontemporal_load((const nu32x4*)p);
  return make_uint4(v[0], v[1], v[2], v[3]);
}
__device__ __forceinline__ float fexp2(float x) { return __builtin_amdgcn_exp2f(x); }
__device__ __forceinline__ int otid() { int t = threadIdx.x; asm volatile("" : "+v"(t)); return t; }

struct Mat { const float* src; u16* dst; int K, N; };
__device__ __forceinline__ Mat get_mat(const Params& p, int idx) {
  int l = idx >> 3, t = idx & 7;
  char* wb = p.ws + OFF_W + (size_t)l * W_LAYER;
  Mat m;
  if (t == 0) { m.src = p.w_in + (size_t)l * DM * INW; m.dst = (u16*)(wb + OW_IN); m.K = DM; m.N = INW; }
  else if (t == 1) { m.src = p.w_out + (size_t)l * DM * DM; m.dst = (u16*)(wb + OW_OUT); m.K = DM; m.N = DM; }
  else if (t == 2) { m.src = p.w_up + (size_t)l * DM * DFF; m.dst = (u16*)(wb + OW_UP); m.K = DM; m.N = DFF; }
  else if (t == 3) { m.src = p.w_down + (size_t)l * DFF * DM; m.dst = (u16*)(wb + OW_DN); m.K = DFF; m.N = DM; }
  else if (t == 4) { m.src = p.w_uq + (size_t)l * 192 * 384; m.dst = (u16*)(wb + OW_UQ); m.K = 192; m.N = 384; }
  else if (t == 5) { m.src = p.w_uk + (size_t)l * 128 * 256; m.dst = (u16*)(wb + OW_UKV); m.K = 128; m.N = 256; }
  else if (t == 6) { m.src = p.w_uv + (size_t)l * 128 * 256; m.dst = (u16*)(wb + OW_UKV) + 256 * 128; m.K = 128; m.N = 256; }
  else { m.src = p.w_glu + (size_t)l * 256 * 256; m.dst = (u16*)(wb + OW_GLU); m.K = 256; m.N = 256; }
  return m;
}

__device__ void phase_convert(const Params& p, char* lds) {
  float* tl = (float*)lds;
  const int tid = otid();
  int base = 0;
  for (int mi = 0; mi < 16; ++mi) {
    Mat mt = get_mat(p, mi);
    const int tn = mt.N >> 5, tk = mt.K >> 6, nt = tn * tk;
    int first = (int)(((long)blockIdx.x - base) % (long)gridDim.x);
    if (first < 0) first += gridDim.x;
    for (int i = first; i < nt; i += gridDim.x) {
      const int kt = i / tn, ntile = i - kt * tn;
      const int k0 = kt * 64, n0 = ntile * 32;
      {
        const int r = tid >> 3, c4 = (tid & 7) * 4;
#pragma unroll
        for (int j = 0; j < 2; ++j) {
          float4 v = ldnt_f4(mt.src + (size_t)(k0 + r + 32 * j) * mt.N + n0 + c4);
          float* d = tl + (r + 32 * j) * 33 + c4;
          d[0] = v.x; d[1] = v.y; d[2] = v.z; d[3] = v.w;
        }
      }
      __syncthreads();
      {
        const int n = tid >> 3, kc = (tid & 7) * 8;
        unsigned w[4];
#pragma unroll
        for (int e = 0; e < 4; ++e) w[e] = pack2(tl[(kc + 2 * e) * 33 + n], tl[(kc + 2 * e + 1) * 33 + n]);
        *(uint4*)(mt.dst + (size_t)(n0 + n) * mt.K + k0 + kc) = make_uint4(w[0], w[1], w[2], w[3]);
      }
      __syncthreads();
    }
    base += nt;
  }
}

__device__ void phase_tables(const Params& p) {
  const int gt = blockIdx.x * 256 + otid(), nthr = gridDim.x * 256;
  float2* rope = (float2*)(p.ws + OFF_ROPE);
  for (int i = gt; i < TPB * 16; i += nthr) {
    int t = i >> 4, f = i & 15;
    float inv = powf(10000.f, -(float)f / 16.f);
    float ang = (float)t * inv;
    double rev = (double)ang * 0.15915494309189535;
    rev -= rint(rev);
    float fr = (float)rev;
    rope[i] = make_float2(__builtin_amdgcn_cosf(fr), __builtin_amdgcn_sinf(fr));
  }
  float2* lam = (float2*)(p.ws + OFF_LAM);
  float2* lamT = (float2*)(p.ws + OFF_LAMT);
  float* bb = (float*)(p.ws + OFF_BB);
  for (int i = gt; i < 2 * 16 * 64; i += nthr) {
    int lg = i >> 6, s = i & 63;
    float step = expf(p.log_step[lg]);
    float ar = p.a_re[i], ai = p.a_im[i];
    float mag = expf(ar * step);
    float th = ai * step;
    float lr = mag * cosf(th), li = mag * sinf(th);
    lam[i] = make_float2(lr, li);
    float pr = lr, pi = li;
#pragma unroll
    for (int q = 0; q < 6; ++q) { float nr2 = pr * pr - pi * pi, ni2 = 2.f * pr * pi; pr = nr2; pi = ni2; }
    lamT[i] = make_float2(pr, pi);
    float den = ar * ar + ai * ai;
    float nr = lr - 1.f, ni = li;
    float cr = (nr * ar + ni * ai) / den, ci = (ni * ar - nr * ai) / den;
    const float* brp = p.b_re + (size_t)i * 16;
    const float* bip = p.b_im + (size_t)i * 16;
#pragma unroll
    for (int c = 0; c < 16; ++c) {
      float br = brp[c], bi = bip[c];
      bb[((size_t)lg * 32 + 2 * c) * 64 + s] = cr * br - ci * bi;
      bb[((size_t)lg * 32 + 2 * c + 1) * 64 + s] = cr * bi + ci * br;
    }
  }
}

__device__ __forceinline__ float* h_row(const Params& p, int m) {
  const int b = m / TPB, t = m - b * TPB;
  return t < 16 ? (float*)(p.ws + OFF_HMETA) + (size_t)(b * 16 + t) * DM : p.out + ((size_t)b * 4096 + (t - 16)) * DM;
}
template <int MODE>
__device__ void phase_rows(const Params& p, const float* gpost, const float* gnext, bool has_next, const float* part = nullptr) {
  const int tid_ = otid();
  const int lane = tid_ & 63;
  const int wg = blockIdx.x * 4 + (tid_ >> 6), nw = gridDim.x * 4;
  u16* abuf = (u16*)(p.ws + OFF_ABUF);
  const u16* obuf = (const u16*)(p.ws + OFF_OBUF);
  for (int mb = wg; mb < MTOK; mb += 2 * nw) {
    int mr[2]; bool ok[2]; float* hr[2];
    float4 v[2][4]; uint2 ob[2][4];
#pragma unroll
    for (int r = 0; r < 2; ++r) {
      mr[r] = mb + r * nw; ok[r] = mr[r] < MTOK;
      const int mm = ok[r] ? mr[r] : mb;
      hr[r] = h_row(p, mm);
      if (MODE == 0) {
        const int b = mm / TPB, t = mm - b * TPB;
        const float* src = t < 16 ? p.meta + (size_t)t * DM : p.x + ((size_t)b * 4096 + (t - 16)) * DM;
#pragma unroll
        for (int j = 0; j < 4; ++j) v[r][j] = ldnt_f4(src + j * 256 + lane * 4);
      } else {
        const float* hsrc = hr[r];
        if (MODE == 2) {
          const int b2 = mm / TPB, t2 = mm - b2 * TPB;
          hsrc = t2 < 16 ? p.meta + (size_t)t2 * DM : p.x + ((size_t)b2 * 4096 + (t2 - 16)) * DM;
        }
#pragma unroll
        for (int j = 0; j < 4; ++j) {
          ob[r][j] = ldnt_u2(obuf + (size_t)mm * DM + j * 256 + lane * 4);
          v[r][j] = ldnt_f4(hsrc + j * 256 + lane * 4);
        }
        if (part != nullptr && mm >= 16384) {
#pragma unroll
          for (int j = 0; j < 4; ++j) {
            float4 a = make_float4(0.f, 0.f, 0.f, 0.f);
#pragma unroll
            for (int ks = 0; ks < 8; ++ks) {
              const float4 q = *(const float4*)(part + ((size_t)ks * 64 + (mm - 16384)) * 1024 + j * 256 + lane * 4);
              a.x += q.x; a.y += q.y; a.z += q.z; a.w += q.w;
            }
            ob[r][j].x = pack2(a.x, a.y); ob[r][j].y = pack2(a.z, a.w);
          }
        }
      }
    }
#pragma unroll
    for (int r = 0; r < 2; ++r) {
      if (MODE >= 1) {
        float4 o[4];
        float ss = 0.f;
#pragma unroll
        for (int j = 0; j < 4; ++j) {
          o[j] = make_float4(bflo(ob[r][j].x), bfhi(ob[r][j].x), bflo(ob[r][j].y), bfhi(ob[r][j].y));
          ss += o[j].x * o[j].x + o[j].y * o[j].y + o[j].z * o[j].z + o[j].w * o[j].w;
        }
        ss = wave_sum(ss);
        const float rs = rsqrtf(ss * (1.f / 1024.f) + 1e-6f);
#pragma unroll
        for (int j = 0; j < 4; ++j) {
          const float4 hv = v[r][j];
          const float4 g = *(const float4*)(gpost + j * 256 + lane * 4);
          v[r][j] = make_float4(hv.x + o[j].x * rs * g.x, hv.y + o[j].y * rs * g.y, hv.z + o[j].z * rs * g.z,
                                hv.w + o[j].w * rs * g.w);
        }
      }
      if (MODE != 0 && ok[r]) {
#pragma unroll
        for (int j = 0; j < 4; ++j) {
          const f32x4 hv4 = {v[r][j].x, v[r][j].y, v[r][j].z, v[r][j].w};
          __builtin_nontemporal_store(hv4, (f32x4*)(hr[r] + j * 256 + lane * 4));
        }
      }
      if (has_next) {
        float ss = 0.f;
#pragma unroll
        for (int j = 0; j < 4; ++j)
          ss += v[r][j].x * v[r][j].x + v[r][j].y * v[r][j].y + v[r][j].z * v[r][j].z + v[r][j].w * v[r][j].w;
        ss = wave_sum(ss);
        const float rs = rsqrtf(ss * (1.f / 1024.f) + 1e-6f);
        if (ok[r]) {
#pragma unroll
          for (int j = 0; j < 4; ++j) {
            const float4 g = *(const float4*)(gnext + j * 256 + lane * 4);
            uint2 w;
            w.x = pack2(v[r][j].x * rs * g.x, v[r][j].y * rs * g.y);
            w.y = pack2(v[r][j].z * rs * g.z, v[r][j].w * rs * g.w);
            *(uint2*)(abuf + (size_t)mr[r] * DM + j * 256 + lane * 4) = w;
          }
        }
      }
    }
  }
}

__device__ void phase_headnorm(const Params& p, int l) {
  const int tid_ = otid();
  const int lane = tid_ & 63;
  const int wg = blockIdx.x * 4 + (tid_ >> 6), nw = gridDim.x * 4;
  u16* abuf = (u16*)(p.ws + OFF_ABUF);
  const u16* yssm = (const u16*)(p.ws + OX_YSSM);
  const u16* yswa = (const u16*)(p.ws + OX_YSWA);
  const u16* ymla = (const u16*)(p.ws + OX_YMLA);
  const float* gh = p.g_heads + (size_t)l * 1024;
  const float4 g1 = *(const float4*)(gh + lane * 4);
  const float4 g2a = *(const float4*)(gh + 256 + lane * 8);
  const float4 g2b = *(const float4*)(gh + 256 + lane * 8 + 4);
  const float4 g3 = *(const float4*)(gh + 768 + lane * 4);
  for (int mb = wg; mb < MTOK; mb += 2 * nw) {
    uint2 ar[2]; uint4 sr[2]; uint2 cr[2]; int mrow[2]; bool ok[2];
#pragma unroll
    for (int r = 0; r < 2; ++r) {
      mrow[r] = mb + r * nw; ok[r] = mrow[r] < MTOK;
      const int m = ok[r] ? mrow[r] : mb;
      ar[r] = ldnt_u2(yssm + (size_t)m * 256 + lane * 4);
      sr[r] = ldnt_u4(yswa + (size_t)m * 512 + lane * 8);
      cr[r] = ldnt_u2(ymla + (size_t)m * 256 + lane * 4);
    }
#pragma unroll
    for (int r = 0; r < 2; ++r) {
      const uint2 a = ar[r]; const uint4 s = sr[r]; const uint2 c = cr[r];
      float av[4] = {bflo(a.x), bfhi(a.x), bflo(a.y), bfhi(a.y)};
      float sv[8] = {bflo(s.x), bfhi(s.x), bflo(s.y), bfhi(s.y), bflo(s.z), bfhi(s.z), bflo(s.w), bfhi(s.w)};
      float cv[4] = {bflo(c.x), bfhi(c.x), bflo(c.y), bfhi(c.y)};
      float s1 = 0.f, s2 = 0.f, s3 = 0.f;
#pragma unroll
      for (int e = 0; e < 4; ++e) { s1 += av[e] * av[e]; s3 += cv[e] * cv[e]; }
#pragma unroll
      for (int e = 0; e < 8; ++e) s2 += sv[e] * sv[e];
      s1 = wave_sum(s1); s2 = wave_sum(s2); s3 = wave_sum(s3);
      const float r1 = rsqrtf(s1 * (1.f / 256.f) + 1e-6f);
      const float r2 = rsqrtf(s2 * (1.f / 512.f) + 1e-6f);
      const float r3 = rsqrtf(s3 * (1.f / 256.f) + 1e-6f);
      if (ok[r]) {
        u16* dst = abuf + (size_t)mrow[r] * DM;
        uint2 w1; w1.x = pack2(av[0] * r1 * g1.x, av[1] * r1 * g1.y); w1.y = pack2(av[2] * r1 * g1.z, av[3] * r1 * g1.w);
        *(uint2*)(dst + lane * 4) = w1;
        uint4 w2;
        w2.x = pack2(sv[0] * r2 * g2a.x, sv[1] * r2 * g2a.y); w2.y = pack2(sv[2] * r2 * g2a.z, sv[3] * r2 * g2a.w);
        w2.z = pack2(sv[4] * r2 * g2b.x, sv[5] * r2 * g2b.y); w2.w = pack2(sv[6] * r2 * g2b.z, sv[7] * r2 * g2b.w);
        *(uint4*)(dst + 256 + lane * 8) = w2;
        uint2 w3; w3.x = pack2(cv[0] * r3 * g3.x, cv[1] * r3 * g3.y); w3.y = pack2(cv[2] * r3 * g3.z, cv[3] * r3 * g3.w);
        *(uint2*)(dst + 768 + lane * 4) = w3;
      }
    }
  }
}

__device__ void phase_mla_prep(const Params& p, int l) {
  const int tid_ = otid();
  const int lane = tid_ & 63;
  const int wg = blockIdx.x * 4 + (tid_ >> 6), nw = gridDim.x * 4;
  const u16* proj = (const u16*)(p.ws + OX_PROJ);
  u16* qn = (u16*)(p.ws + OX_QN);
  u16* cn = (u16*)(p.ws + OX_CN);
  u16* kr = (u16*)(p.ws + OX_KR);
  const float2* rope = (const float2*)(p.ws + OFF_ROPE);
  const float* gq = p.g_q + (size_t)l * 192;
  const float* gkv = p.g_kv + (size_t)l * 128;
  const int role = lane < 24 ? 0 : (lane < 40 ? 1 : (lane < 44 ? 2 : 3));
  const int eoff = role == 0 ? 1024 + lane * 8 : (role == 1 ? 1216 + (lane - 24) * 8 : (role == 2 ? 1344 + (lane - 40) * 8 : 1024));
  float gv[8];
#pragma unroll
  for (int e = 0; e < 8; ++e) gv[e] = role == 0 ? gq[lane * 8 + e] : (role == 1 ? gkv[(lane - 24) * 8 + e] : 0.f);
  for (int mb = wg; mb < MTOK; mb += 2 * nw) {
    uint4 raw[2]; int mrow[2]; bool ok[2];
#pragma unroll
    for (int r = 0; r < 2; ++r) {
      mrow[r] = mb + r * nw; ok[r] = mrow[r] < MTOK;
      const int m = ok[r] ? mrow[r] : mb;
      raw[r] = *(const uint4*)(proj + (size_t)m * INW + eoff);
    }
#pragma unroll
    for (int r = 0; r < 2; ++r) {
      const int m = ok[r] ? mrow[r] : mb;
      const int bb = m / TPB, t = m - bb * TPB;
      const unsigned wv[4] = {raw[r].x, raw[r].y, raw[r].z, raw[r].w};
      float v[8];
#pragma unroll
      for (int e = 0; e < 4; ++e) { v[2 * e] = bflo(wv[e]); v[2 * e + 1] = bfhi(wv[e]); }
      float ss = 0.f;
#pragma unroll
      for (int e = 0; e < 8; ++e) ss += v[e] * v[e];
      const float sq = wave_sum(role == 0 ? ss : 0.f);
      const float sc = wave_sum(role == 1 ? ss : 0.f);
      const float rq = rsqrtf(sq * (1.f / 192.f) + 1e-6f);
      const float rc = rsqrtf(sc * (1.f / 128.f) + 1e-6f);
      unsigned pw[4];
#pragma unroll
      for (int e = 0; e < 4; ++e) pw[e] = (unsigned)__shfl((int)wv[e], lane ^ 2);
      uint4 outv;
      if (role == 2) {
        const int i0 = ((lane - 40) & 1) * 8;
        const bool first = lane < 42;
        unsigned ow[4];
#pragma unroll
        for (int e = 0; e < 4; ++e) {
          const float2 ca = rope[t * 16 + i0 + 2 * e], cb = rope[t * 16 + i0 + 2 * e + 1];
          const float pa = bflo(pw[e]), pb = bfhi(pw[e]);
          float ra, rb;
          if (first) { ra = v[2 * e] * ca.x - pa * ca.y; rb = v[2 * e + 1] * cb.x - pb * cb.y; }
          else { ra = pa * ca.y + v[2 * e] * ca.x; rb = pb * cb.y + v[2 * e + 1] * cb.x; }
          ow[e] = pack2(ra, rb);
        }
        outv = make_uint4(ow[0], ow[1], ow[2], ow[3]);
      } else {
        const float rs = role == 0 ? rq : rc;
        outv = make_uint4(pack2(v[0] * rs * gv[0], v[1] * rs * gv[1]), pack2(v[2] * rs * gv[2], v[3] * rs * gv[3]),
                          pack2(v[4] * rs * gv[4], v[5] * rs * gv[5]), pack2(v[6] * rs * gv[6], v[7] * rs * gv[7]));
      }
      if (ok[r]) {
        if (role == 0) *(uint4*)(qn + (size_t)m * 192 + lane * 8) = outv;
        else if (role == 1) *(uint4*)(cn + (size_t)m * 128 + (lane - 24) * 8) = outv;
        else if (role == 2) *(uint4*)(kr + (size_t)m * 32 + (lane - 40) * 8) = outv;
      }
    }
  }
}

template <class Epi>
__device__ __forceinline__ void gemm_tile(const u16* __restrict__ A, int lda, int Mrows, const u16* __restrict__ Bt,
                                          int ldb, int Nrows, int K, int m0, int n0, char* lds, Epi& epi) {
  const int tid = otid(), lane = tid & 63, wid = tid >> 6, wm = wid >> 1, wn = wid & 1;
  const int lr = lane & 15, lg = lane >> 4;
  const int lrow = tid >> 3, lkc = tid & 7;
  const int wsw = (lrow >> 1) & 7;
  const u16* ap[4];
  const u16* bp[4];
#pragma unroll
  for (int j = 0; j < 4; ++j) {
    int ra = m0 + lrow + 32 * j; ra = ra < Mrows ? ra : Mrows - 1;
    int rb = n0 + lrow + 32 * j; rb = rb < Nrows ? rb : Nrows - 1;
    ap[j] = A + (size_t)ra * lda + lkc * 8;
    bp[j] = Bt + (size_t)rb * ldb + lkc * 8;
  }
  f32x4 acc[4][4];
#pragma unroll
  for (int i = 0; i < 4; ++i)
#pragma unroll
    for (int j = 0; j < 4; ++j) acc[i][j] = (f32x4){0.f, 0.f, 0.f, 0.f};
  typedef unsigned u32x4 __attribute__((ext_vector_type(4)));
  u32x4 a0[4], b0[4], a1[4], b1[4];
  const int nk = K >> 6;
  const int rsw = (lr >> 1) & 7;
  const int woff = lrow * 128 + ((lkc ^ wsw) << 4);
#define GEMM_ISSUE(SA, SB, KT)                                                                     \
  {                                                                                                \
    const int kn_ = ((KT) < nk) ? (KT) : nk - 1;                                                   \
    _Pragma("unroll") for (int j = 0; j < 4; ++j) {                                                \
      const u16* pa_ = ap[j] + kn_ * 64;                                                           \
      const u16* pb_ = bp[j] + kn_ * 64;                                                           \
      asm volatile("global_load_dwordx4 %0, %1, off" : "=&v"(SA[j]) : "v"(pa_) : "memory");        \
      asm volatile("global_load_dwordx4 %0, %1, off" : "=&v"(SB[j]) : "v"(pb_) : "memory");        \
    }                                                                                              \
  }
#define GEMM_WRITE(SA, SB, BUF)                                                                    \
  {                                                                                                \
    char* da_ = lds + (BUF) * 32768 + woff;                                                        \
    _Pragma("unroll") for (int j = 0; j < 4; ++j) {                                                \
      *(u32x4*)(da_ + j * 4096) = SA[j];                                                           \
      *(u32x4*)(da_ + 16384 + j * 4096) = SB[j];                                                   \
    }                                                                                              \
  }
#define GEMM_COMPUTE(BUF)                                                                          \
  {                                                                                                \
    const char* sa_ = lds + (BUF) * 32768 + (wm * 64 + lr) * 128;                                  \
    const char* sb_ = lds + (BUF) * 32768 + 16384 + (wn * 64 + lr) * 128;                          \
    bf16x8 af[2][4], bfr[2][4];                                                                    \
    _Pragma("unroll") for (int kk = 0; kk < 2; ++kk) {                                             \
      const int co = ((kk * 4 + lg) ^ rsw) << 4;                                                   \
      _Pragma("unroll") for (int i = 0; i < 4; ++i) af[kk][i] = *(const bf16x8*)(sa_ + i * 2048 + co); \
      _Pragma("unroll") for (int j = 0; j < 4; ++j) bfr[kk][j] = *(const bf16x8*)(sb_ + j * 2048 + co);\
    }                                                                                              \
    _Pragma("unroll") for (int kk = 0; kk < 2; ++kk) {                                             \
      _Pragma("unroll") for (int i = 0; i < 4; ++i)                                                \
        _Pragma("unroll") for (int j = 0; j < 4; ++j)                                              \
          acc[i][j] = Epi::STAGED ? __builtin_amdgcn_mfma_f32_16x16x32_bf16(bfr[kk][j], af[kk][i], acc[i][j], 0, 0, 0) \
                                  : __builtin_amdgcn_mfma_f32_16x16x32_bf16(af[kk][i], bfr[kk][j], acc[i][j], 0, 0, 0); \
    }                                                                                              \
      \
    __builtin_amdgcn_sched_group_barrier(0x100, 8, 0);                                             \
    _Pragma("unroll") for (int q_ = 0; q_ < 8; ++q_) {                                             \
      __builtin_amdgcn_sched_group_barrier(0x008, 2, 0);                                           \
      __builtin_amdgcn_sched_group_barrier(0x100, 1, 0);                                           \
    }                                                                                              \
    __builtin_amdgcn_sched_group_barrier(0x008, 16, 0);                                            \
  }
  GEMM_ISSUE(a0, b0, 0)
  GEMM_ISSUE(a1, b1, 1)
  asm volatile("s_waitcnt vmcnt(8)" ::: "memory");
  GEMM_WRITE(a0, b0, 0)
  __syncthreads();
  for (int kt = 0; kt < nk; kt += 2) {
    GEMM_ISSUE(a0, b0, kt + 2)
    GEMM_COMPUTE(0)
    asm volatile("s_waitcnt vmcnt(8)" ::: "memory");
    GEMM_WRITE(a1, b1, 1)
    __syncthreads();
    if (kt + 1 < nk) {
      GEMM_ISSUE(a1, b1, kt + 3)
      GEMM_COMPUTE(1)
      asm volatile("s_waitcnt vmcnt(8)" ::: "memory");
      GEMM_WRITE(a0, b0, 0)
      __syncthreads();
    }
  }
  asm volatile("s_waitcnt vmcnt(0)" ::: "memory");
#pragma unroll
  for (int j = 0; j < 4; ++j) asm volatile("" :: "v"(a0[j]), "v"(b0[j]), "v"(a1[j]), "v"(b1[j]));
#undef GEMM_ISSUE
#undef GEMM_WRITE
#undef GEMM_COMPUTE
  if (Epi::ACT == 3) {
    if (wm == 0) {
#pragma unroll
      for (int i = 0; i < 4; ++i)
#pragma unroll
        for (int j = 0; j < 4; ++j)
          *(f32x4*)(epi.partp() + (size_t)(i * 16 + lr) * 1024 + n0 + wn * 64 + j * 16 + 4 * lg) = acc[i][j];
    }
  } else if (Epi::STAGED) {
#pragma unroll
    for (int i = 0; i < 4; ++i)
#pragma unroll
      for (int j = 0; j < 4; ++j) {
        f32x4 v = acc[i][j];
        if (Epi::ACT == 1) {
#pragma unroll
          for (int r = 0; r < 4; ++r) { float x = fmaxf(v[r], 0.f); v[r] = x * x; }
        }
        uint2 w; w.x = pack2(v[0], v[1]); w.y = pack2(v[2], v[3]);
        *(uint2*)(lds + (wm * 64 + i * 16 + lr) * 272 + (wn * 64 + j * 16 + 4 * lg) * 2) = w;
      }
    __syncthreads();
    if (!(Epi::HASVT && n0 == 896)) {
#pragma unroll
      for (int q = 0; q < 8; ++q) {
        const int c = tid + 256 * q;
        const int row = c >> 4, cc = c & 15;
        if (m0 + row < Mrows && n0 + cc * 8 < Nrows)
          *(uint4*)(epi.C + (size_t)(m0 + row) * epi.ldc + n0 + cc * 8) = *(const uint4*)(lds + row * 272 + cc * 16);
      }
    } else {
#pragma unroll
      for (int q = 0; q < 8; ++q) {
        const int id = tid + 256 * q;
        const int rg = id & 15, col = id >> 4;
        const int m = m0 + rg * 8;
        if (m < Mrows) {
          unsigned short e8[8];
#pragma unroll
          for (int e = 0; e < 8; ++e) e8[e] = *(const unsigned short*)(lds + (rg * 8 + e) * 272 + col * 2);
          const int bb = m / TPB, t = m - bb * TPB;
          uint4 val = make_uint4((unsigned)e8[0] | ((unsigned)e8[1] << 16), (unsigned)e8[2] | ((unsigned)e8[3] << 16),
                                 (unsigned)e8[4] | ((unsigned)e8[5] << 16), (unsigned)e8[6] | ((unsigned)e8[7] << 16));
          *(uint4*)(epi.vtp() + ((size_t)(bb * 2 + (col >> 6)) * 64 + (col & 63)) * LT + t) = val;
        }
      }
    }
    __syncthreads();
  } else {
#pragma unroll
    for (int i = 0; i < 4; ++i)
#pragma unroll
      for (int j = 0; j < 4; ++j)
        epi(m0 + wm * 64 + i * 16 + 4 * lg, n0 + wn * 64 + j * 16 + lr, acc[i][j]);
  }
}

template <class Epi>
__device__ __forceinline__ void gemm_phase(const u16* A, int lda, const u16* Bt, int ldb, int N, int K, char* lds,
                                           Epi epi, int rot, int tilesM = 129, int tileLo = 0, bool rev = false) {
  const int tilesN = (N + 127) >> 7;
  const int total = tilesM * tilesN;
  int start = (int)((blockIdx.x + gridDim.x - (rot % gridDim.x)) % gridDim.x) + tileLo * tilesN;
  for (int tile = start; tile < total; tile += gridDim.x) {
    int tm = tile / tilesN; const int tn = tile - tm * tilesN;
    if (rev) tm = 128 - tm;
    gemm_tile(A, lda, MTOK, Bt, ldb, N, K, tm * 128, tn * 128, lds, epi);
  }
}

struct EpiBf16 {
  static constexpr bool STAGED = true; static constexpr int ACT = 0; static constexpr bool HASVT = false;
  __device__ __forceinline__ u16* vtp() const { return nullptr; }
  __device__ __forceinline__ float* partp() const { return nullptr; }
  u16* C; int ldc; int N;
  __device__ __forceinline__ void operator()(int m, int n, f32x4 v) const {
    if (n < N) {
#pragma unroll
      for (int r = 0; r < 4; ++r) if (m + r < MTOK) C[(size_t)(m + r) * ldc + n] = f2bf(v[r]);
    }
  }
};
struct EpiPart {
  static constexpr bool STAGED = true; static constexpr int ACT = 3; static constexpr bool HASVT = false;
  float* part; u16* C; int ldc;
  __device__ __forceinline__ u16* vtp() const { return nullptr; }
  __device__ __forceinline__ float* partp() const { return part; }
  __device__ __forceinline__ void operator()(int, int, f32x4) const {}
};
struct EpiProjS {
  static constexpr bool STAGED = true; static constexpr int ACT = 0; static constexpr bool HASVT = true;
  u16* C; int ldc; u16* vts;
  __device__ __forceinline__ u16* vtp() const { return vts; }
  __device__ __forceinline__ float* partp() const { return nullptr; }
  __device__ __forceinline__ void operator()(int, int, f32x4) const {}
};
struct EpiRelu2 {
  static constexpr bool STAGED = true; static constexpr int ACT = 1; static constexpr bool HASVT = false;
  __device__ __forceinline__ u16* vtp() const { return nullptr; }
  __device__ __forceinline__ float* partp() const { return nullptr; }
  u16* C; int ldc;
  __device__ __forceinline__ void operator()(int m, int n, f32x4 v) const {
#pragma unroll
    for (int r = 0; r < 4; ++r) if (m + r < MTOK) { float x = fmaxf(v[r], 0.f); C[(size_t)(m + r) * ldc + n] = f2bf(x * x); }
  }
};
struct EpiProj {
  static constexpr bool HASVT = false;
  __device__ __forceinline__ u16* vtp() const { return nullptr; }
  __device__ __forceinline__ float* partp() const { return nullptr; }
  static constexpr bool STAGED = false; static constexpr int ACT = 0;
  u16* C; int ldc;
  u16* proj; u16* vts;
  __device__ __forceinline__ void operator()(int m, int n, f32x4 v) const {
    if (n < INW && m < MTOK) {
#pragma unroll
      for (int r = 0; r < 4; ++r) proj[(size_t)(m + r) * INW + n] = f2bf(v[r]);
      if (n >= 896 && n < 1024) {
        const int kvh = (n - 896) >> 6, d = (n - 896) & 63;
        const int b = m / TPB, t = m - b * TPB;
        uint2 w; w.x = pack2(v[0], v[1]); w.y = pack2(v[2], v[3]);
        *(uint2*)(vts + ((size_t)(b * 2 + kvh) * 64 + d) * LT + t) = w;
      }
    }
  }
};
struct EpiKV {
  static constexpr bool HASVT = false;
  __device__ __forceinline__ u16* vtp() const { return nullptr; }
  __device__ __forceinline__ float* partp() const { return nullptr; }
  static constexpr bool STAGED = false; static constexpr int ACT = 0;
  u16* C; int ldc;
  u16* kn; u16* vtm;
  __device__ __forceinline__ void operator()(int m, int n, f32x4 v) const {
    if (m < MTOK) {
      if (n < 256) {
#pragma unroll
        for (int r = 0; r < 4; ++r) kn[(size_t)(m + r) * 256 + n] = f2bf(v[r]);
      } else {
        const int h = (n - 256) >> 6, d = (n - 256) & 63;
        const int b = m / TPB, t = m - b * TPB;
        uint2 w; w.x = pack2(v[0], v[1]); w.y = pack2(v[2], v[3]);
        *(uint2*)(vtm + ((size_t)(b * 4 + h) * 64 + d) * LT + t) = w;
      }
    }
  }
};
struct EpiGlu {
  static constexpr bool HASVT = false;
  __device__ __forceinline__ u16* vtp() const { return nullptr; }
  __device__ __forceinline__ float* partp() const { return nullptr; }
  static constexpr bool STAGED = false; static constexpr int ACT = 0;
  u16* C; int ldc;
  const u16* z; const float* bg; u16* y;
  __device__ __forceinline__ void operator()(int m, int n, f32x4 v) const {
    const float bb = bg[n];
#pragma unroll
    for (int r = 0; r < 4; ++r)
      if (m + r < MTOK) {
        float zz = bf2f(z[(size_t)(m + r) * 256 + n]);
        float s = 1.f / (1.f + __expf(-(v[r] + bb)));
        y[(size_t)(m + r) * 256 + n] = f2bf(zz * s);
      }
  }
};

__device__ __forceinline__ void ssm_load_u(const u16* proj, int b, int g, int ch, int lane, float* urow) {
  const int t = ch * 64 + lane;
  uint4 r0 = make_uint4(0, 0, 0, 0), r1 = make_uint4(0, 0, 0, 0);
  if (t < TPB) {
    const uint4* src = (const uint4*)(proj + (size_t)(b * TPB + t) * INW + g * 16);
    r0 = src[0]; r1 = src[1];
  }
  float4* d = (float4*)urow;
  d[0] = make_float4(bflo(r0.x), bfhi(r0.x), bflo(r0.y), bfhi(r0.y));
  d[1] = make_float4(bflo(r0.z), bfhi(r0.z), bflo(r0.w), bfhi(r0.w));
  d[2] = make_float4(bflo(r1.x), bfhi(r1.x), bflo(r1.y), bfhi(r1.y));
  d[3] = make_float4(bflo(r1.z), bfhi(r1.z), bflo(r1.w), bfhi(r1.w));
}

#define SSM_STEP(UP)                                                                          \
  {                                                                                           \
    const float4 u0 = (UP)[0], u1 = (UP)[1], u2 = (UP)[2], u3 = (UP)[3];                      \
      \
    float r0 = u0.x * br[0], i0 = u0.x * bi[0], r1 = u1.x * br[4], i1 = u1.x * bi[4];         \
    float r2 = u2.x * br[8], i2 = u2.x * bi[8], r3 = u3.x * br[12], i3 = u3.x * bi[12];       \
    r0 += u0.y * br[1]; i0 += u0.y * bi[1]; r1 += u1.y * br[5]; i1 += u1.y * bi[5];           \
    r2 += u2.y * br[9]; i2 += u2.y * bi[9]; r3 += u3.y * br[13]; i3 += u3.y * bi[13];         \
    r0 += u0.z * br[2]; i0 += u0.z * bi[2]; r1 += u1.z * br[6]; i1 += u1.z * bi[6];           \
    r2 += u2.z * br[10]; i2 += u2.z * bi[10]; r3 += u3.z * br[14]; i3 += u3.z * bi[14];       \
    r0 += u0.w * br[3]; i0 += u0.w * bi[3]; r1 += u1.w * br[7]; i1 += u1.w * bi[7];           \
    r2 += u2.w * br[11]; i2 += u2.w * bi[11]; r3 += u3.w * br[15]; i3 += u3.w * bi[15];       \
    const float sr = (r0 + r1) + (r2 + r3), si = (i0 + i1) + (i2 + i3);                       \
    const float nxr = lam.x * xr - lam.y * xi + sr;                                           \
    const float nxi = lam.x * xi + lam.y * xr + si;                                           \
    xr = nxr; xi = nxi;                                                                       \
  }

__device__ void phase_ssm_a(const Params& p, int l, char* lds) {
  const u16* proj = (const u16*)(p.ws + OX_PROJ);
  float* us = (float*)lds;
  const int tid_ = otid();
  const int lane = tid_ & 63, w = tid_ >> 6;
  const float* bbt = (const float*)(p.ws + OFF_BB);
  const float2* lamt = (const float2*)(p.ws + OFF_LAM);
  float2* endp = (float2*)(p.ws + OFF_END2 + (size_t)l * END_BYTES);
  for (int item = blockIdx.x; item < 64 * 16; item += gridDim.x) {
    const int bg = item >> 4, cq = item & 15;
    const int b = bg >> 4, g = bg & 15;
    const int ch = cq * 4 + w;
    if (ch < 63) {
      ssm_load_u(proj, b, g, ch, lane, us + (w * 64 + lane) * 16);
      asm volatile("s_waitcnt lgkmcnt(0)" ::: "memory");
      float br[16], bi[16];
      const float* bbp = bbt + ((size_t)(l * 16 + g) * 32) * 64 + lane;
#pragma unroll
      for (int c = 0; c < 16; ++c) { br[c] = bbp[(2 * c) * 64]; bi[c] = bbp[(2 * c + 1) * 64]; }
      const float2 lam = lamt[(l * 16 + g) * 64 + lane];
      float xr = 0.f, xi = 0.f;
#pragma unroll 4
      for (int tt = 0; tt < 64; ++tt) {
        const float4* up = (const float4*)(us + (w * 64 + tt) * 16);
        SSM_STEP(up)
      }
      endp[((size_t)(b * 16 + g) * NCH + ch) * 64 + lane] = make_float2(xr, xi);
    }
  }
}

__device__ __forceinline__ float gelu_tanh(float y) {
  const float a = 0.7978845608028654f * (y + 0.044715f * y * y * y);
  const float th = 1.f - 2.f / (1.f + __expf(2.f * a));
  return 0.5f * y * (1.f + th);
}

__device__ void phase_ssm_c(const Params& p, int l, char* lds) {
  const u16* proj = (const u16*)(p.ws + OX_PROJ);
  u16* z = (u16*)(p.ws + OX_Z);
  float* Cs = (float*)lds;
  float* us = Cs + 2048;
  float* xs = us + 4096;
  const int tid = otid(), lane = tid & 63, w = tid >> 6;
  const float* bbt = (const float*)(p.ws + OFF_BB);
  const float2* lamt = (const float2*)(p.ws + OFF_LAM);
  const float2* lamTt = (const float2*)(p.ws + OFF_LAMT);
  const float2* endp = (const float2*)(p.ws + OFF_END2 + (size_t)l * END_BYTES);
  for (int item = blockIdx.x; item < 64 * 16; item += gridDim.x) {
    const int bg = item >> 4, cq = item & 15;
    const int b = bg >> 4, g = bg & 15;
    {
      const float* cre = p.c_re + (size_t)(l * 16 + g) * 1024;
      const float* cim = p.c_im + (size_t)(l * 16 + g) * 1024;
#pragma unroll
      for (int j = 0; j < 4; ++j) {
        int idx = tid + 256 * j;
        *(float2*)(Cs + idx * 2) = make_float2(cre[idx], cim[idx]);
      }
    }
    const int ch = cq * 4 + w;
    const int nsub = (cq == 15) ? 5 : 4;
    {
      ssm_load_u(proj, b, g, ch, lane, us + (w * 64 + lane) * 16);
      float br[16], bi[16];
      const float* bbp = bbt + ((size_t)(l * 16 + g) * 32) * 64 + lane;
#pragma unroll
      for (int c = 0; c < 16; ++c) { br[c] = bbp[(2 * c) * 64]; bi[c] = bbp[(2 * c + 1) * 64]; }
      const float2 lam = lamt[(l * 16 + g) * 64 + lane];
      const float2 lamT = lamTt[(l * 16 + g) * 64 + lane];
      __syncthreads();
      float xr = 0.f, xi = 0.f;
      const float2* ep = endp + ((size_t)(b * 16 + g) * NCH) * 64 + lane;
      {
        int j = 0;
        for (; j + 16 <= ch; j += 16) {
          float2 e[16];
#pragma unroll
          for (int q = 0; q < 16; ++q) e[q] = ep[(size_t)(j + q) * 64];
#pragma unroll
          for (int q = 0; q < 16; ++q) {
            const float nxr = lamT.x * xr - lamT.y * xi + e[q].x;
            const float nxi = lamT.x * xi + lamT.y * xr + e[q].y;
            xr = nxr; xi = nxi;
          }
        }
        for (; j < ch; ++j) {
          const float2 e = ep[(size_t)j * 64];
          const float nxr = lamT.x * xr - lamT.y * xi + e.x;
          const float nxi = lamT.x * xi + lamT.y * xr + e.y;
          xr = nxr; xi = nxi;
        }
      }
      const int tl = lane & 15, c4 = lane >> 4;
      const float4 dsk = *(const float4*)(p.d_skip + (size_t)l * 256 + g * 16 + c4 * 4);
      for (int sub = 0; sub < nsub; ++sub) {
        const int rbase = (sub & 3) * 16;
        if (sub == 4) {
          uint4 r0 = make_uint4(0, 0, 0, 0), r1 = make_uint4(0, 0, 0, 0);
          const int t2 = 4096 + lane;
          if (ch == 63 && lane < 16) {
            const uint4* s4 = (const uint4*)(proj + (size_t)(b * TPB + t2) * INW + g * 16);
            r0 = s4[0]; r1 = s4[1];
          }
          if (lane < 16) {
            float4* d = (float4*)(us + (w * 64 + lane) * 16);
            d[0] = make_float4(bflo(r0.x), bfhi(r0.x), bflo(r0.y), bfhi(r0.y));
            d[1] = make_float4(bflo(r0.z), bfhi(r0.z), bflo(r0.w), bfhi(r0.w));
            d[2] = make_float4(bflo(r1.x), bfhi(r1.x), bflo(r1.y), bfhi(r1.y));
            d[3] = make_float4(bflo(r1.z), bfhi(r1.z), bflo(r1.w), bfhi(r1.w));
          }
          __syncthreads();
        }
#pragma unroll 4
        for (int tt = 0; tt < 16; ++tt) {
          const float4* up = (const float4*)(us + (w * 64 + rbase + tt) * 16);
          SSM_STEP(up)
          *(float2*)(xs + (w * 16 + tt) * 132 + 2 * lane) = make_float2(xr, xi);
        }
        __syncthreads();
        const float* xrow = xs + (w * 16 + tl) * 132;
        const float* crow = Cs + (c4 * 4) * 128;
        float a0 = 0.f, a1 = 0.f, a2 = 0.f, a3 = 0.f;
#pragma unroll 4
        for (int pp = 0; pp < 32; ++pp) {
          const float4 xv = *(const float4*)(xrow + 4 * pp);
          const float4 c0 = *(const float4*)(crow + 4 * pp);
          const float4 c1 = *(const float4*)(crow + 128 + 4 * pp);
          const float4 c2 = *(const float4*)(crow + 256 + 4 * pp);
          const float4 c3 = *(const float4*)(crow + 384 + 4 * pp);
          a0 += c0.x * xv.x - c0.y * xv.y + c0.z * xv.z - c0.w * xv.w;
          a1 += c1.x * xv.x - c1.y * xv.y + c1.z * xv.z - c1.w * xv.w;
          a2 += c2.x * xv.x - c2.y * xv.y + c2.z * xv.z - c2.w * xv.w;
          a3 += c3.x * xv.x - c3.y * xv.y + c3.z * xv.z - c3.w * xv.w;
        }
        __syncthreads();
        const int tok = ch * 64 + sub * 16 + tl;
        const float4 uv = *(const float4*)(us + (w * 64 + rbase + tl) * 16 + c4 * 4);
        if ((sub < 4 || ch == 63) && tok < TPB) {
          uint2 wv;
          wv.x = pack2(gelu_tanh(a0 + dsk.x * uv.x), gelu_tanh(a1 + dsk.y * uv.y));
          wv.y = pack2(gelu_tanh(a2 + dsk.z * uv.z), gelu_tanh(a3 + dsk.w * uv.w));
          *(uint2*)(z + (size_t)(b * TPB + tok) * 256 + g * 16 + c4 * 4) = wv;
        }
      }
    }
    __syncthreads();
  }
}

template <bool MLA, int NQS>
__device__ void attn_item(const Params& p, int l, int b, int head, int qt, char* lds) {
  constexpr int NDS = MLA ? 3 : 2;
  const int tid = otid(), lane = tid & 63, w = tid >> 6;
  const int lr = lane & 15, lg = lane >> 4;
  const u16* proj = (const u16*)(p.ws + OX_PROJ);
  const u16* krope = (const u16*)(p.ws + OX_KR);
  const u16* Ksrc; int kld; const u16* Vt; u16* Y; int ldy;
  if (MLA) {
    Ksrc = (const u16*)(p.ws + OX_KN) + head * 64; kld = 256;
    Vt = (const u16*)(p.ws + OX_VTM) + (size_t)(b * 4 + head) * 64 * LT;
    Y = (u16*)(p.ws + OX_YMLA); ldy = 256;
  } else {
    const int kvh = head >> 2;
    Ksrc = proj + 768 + kvh * 64; kld = INW;
    Vt = (const u16*)(p.ws + OX_VTS) + (size_t)(b * 2 + kvh) * 64 * LT;
    Y = (u16*)(p.ws + OX_YSWA); ldy = 512;
  }
  const int q0 = qt * (64 * NQS);
  const int kt_hi = ((q0 + 64 * NQS - 1) >> 6) < 64 ? ((q0 + 64 * NQS - 1) >> 6) : 64;
  const int kt_lo = MLA ? 0 : (((q0 >> 6) - 2) > 0 ? ((q0 >> 6) - 2) : 0);
  const float LOG2E = 1.4426950408889634f;
  const float c1 = (MLA ? 0.10206207261596575f : 0.125f) * LOG2E;
  float sl2 = 0.f, sink2 = 0.f;
  if (!MLA) {
    sl2 = exp2f(-(float)(head + 1)) * LOG2E;
    sink2 = p.sinks[l * 8 + head] * LOG2E;
  }
  bf16x8 qf[NQS][NDS];
#pragma unroll
  for (int qs = 0; qs < NQS; ++qs) {
    int tq = q0 + 16 * NQS * w + 16 * qs + lr; tq = tq < TPB ? tq : TPB - 1;
    const size_t m = (size_t)b * TPB + tq;
    if (!MLA) {
      const u16* qp = proj + m * INW + 256 + head * 64;
      qf[qs][0] = *(const bf16x8*)(qp + lg * 8);
      qf[qs][1] = *(const bf16x8*)(qp + 32 + lg * 8);
    } else {
      const u16* qp = (const u16*)(p.ws + OX_QMLA) + m * 384 + head * 96;
      qf[qs][0] = *(const bf16x8*)(qp + lg * 8);
      qf[qs][1] = *(const bf16x8*)(qp + 32 + lg * 8);
      const uint4 own = *(const uint4*)(qp + 64 + lg * 8);
      const uint4 par = *(const uint4*)(qp + 64 + (lg ^ 2) * 8);
      const float2* cs = (const float2*)(p.ws + OFF_ROPE) + tq * 16 + (lg & 1) * 8;
      const unsigned ow[4] = {own.x, own.y, own.z, own.w};
      const unsigned pw[4] = {par.x, par.y, par.z, par.w};
      unsigned rw[4];
#pragma unroll
      for (int e2 = 0; e2 < 4; ++e2) {
        const float2 csa = cs[2 * e2], csb = cs[2 * e2 + 1];
        const float oa = bflo(ow[e2]), ob = bfhi(ow[e2]), pa = bflo(pw[e2]), pb = bfhi(pw[e2]);
        float ra, rb;
        if (lg < 2) { ra = oa * csa.x - pa * csa.y; rb = ob * csb.x - pb * csb.y; }
        else { ra = pa * csa.y + oa * csa.x; rb = pb * csb.y + ob * csb.x; }
        rw[e2] = pack2(ra, rb);
      }
      uint4 r4 = make_uint4(rw[0], rw[1], rw[2], rw[3]);
      qf[qs][NDS - 1] = *(bf16x8*)&r4;
    }
  }
  float mrow[NQS], lrow[NQS];
  f32x4 o[NQS][4];
#pragma unroll
  for (int qs = 0; qs < NQS; ++qs) {
    mrow[qs] = MLA ? -1e30f : sink2; lrow[qs] = 0.f;
#pragma unroll
    for (int jt = 0; jt < 4; ++jt) o[qs][jt] = (f32x4){0.f, 0.f, 0.f, 0.f};
  }
  typedef unsigned au32x4 __attribute__((ext_vector_type(4)));
  au32x4 rak0, rak1, rav0, rav1, rakr, rbk0, rbk1, rbv0, rbv1, rbkr;
  rakr = (au32x4){0u, 0u, 0u, 0u}; rbkr = rakr;
  const int skey = tid >> 3, skc = tid & 7;
  const int rkey = tid >> 2, rkc = tid & 3;
  const u16* kptr = Ksrc + ((size_t)b * TPB + skey) * kld + skc * 8;
  const u16* vptr = Vt + (size_t)skey * LT + skc * 8;
  const u16* krptr = krope + ((size_t)b * TPB + rkey) * 32 + rkc * 8;
  const int kw_off = skey * 128 + ((skc ^ (((skey >> 1) & 1) | (((skey >> 3) & 3) << 1))) << 4);
  const int vw_off = skey * 128 + ((skc ^ ((skey >> 1) & 7)) << 4);
  const int krx = (rkey >> 3) & 3;
  const int krw_off = rkey * 64 + ((rkc ^ (krx ^ ((krx & 1) << 1))) << 4);
#define ATT_GLD16(dst, ptr) asm volatile("global_load_dwordx4 %0, %1, off" : "=&v"(dst) : "v"(ptr) : "memory")
#define ATT_GLOAD(S, KT)                                                     \
  {                                                                          \
    const int k0_ = (KT) * 64;                                               \
    const u16* p0_ = kptr + (size_t)k0_ * kld;                               \
    const u16* p1_ = kptr + (size_t)(k0_ + 32) * kld;                        \
    const u16* p2_ = vptr + k0_;                                             \
    const u16* p3_ = vptr + (size_t)32 * LT + k0_;                           \
    ATT_GLD16(S##k0, p0_); ATT_GLD16(S##k1, p1_); ATT_GLD16(S##v0, p2_); ATT_GLD16(S##v1, p3_); \
    if (MLA) { const u16* p4_ = krptr + (size_t)k0_ * 32; ATT_GLD16(S##kr, p4_); }              \
  }
#define ATT_SWRITE(S, BUF)                                                   \
  {                                                                          \
    char* Kb_ = lds + (BUF) * 20480;                                         \
    *(au32x4*)(Kb_ + kw_off) = S##k0;                                        \
    *(au32x4*)(Kb_ + kw_off + 32 * 128) = S##k1;                             \
    *(au32x4*)(Kb_ + 8192 + vw_off) = S##v0;                                 \
    *(au32x4*)(Kb_ + 8192 + vw_off + 32 * 128) = S##v1;                      \
    if (MLA) *(au32x4*)(Kb_ + 16384 + krw_off) = S##kr;                      \
  }
#define ATT_WAIT_OLDER() { if (MLA) asm volatile("s_waitcnt vmcnt(5)" ::: "memory"); else asm volatile("s_waitcnt vmcnt(4)" ::: "memory"); }
#define ATT_STEP(KT_, BUF_)  \
  {  \
    const char* Kb = lds + (BUF_) * 20480; const char* Vb = Kb + 8192; const char* Krb = Kb + 16384;  \
    f32x4 s[NQS][2][2];  \
    _Pragma("unroll")  \
    for (int kk = 0; kk < 2; ++kk)  \
    _Pragma("unroll")  \
      for (int j = 0; j < 2; ++j) {  \
        const int keyl = 32 * kk + 8 * (lr >> 2) + 4 * j + (lr & 3);  \
        f32x4 s0 = (f32x4){0.f, 0.f, 0.f, 0.f}, s1 = (f32x4){0.f, 0.f, 0.f, 0.f};  \
    _Pragma("unroll")  \
        for (int ds = 0; ds < 2; ++ds) {  \
          const bf16x8 kf = *(const bf16x8*)(Kb + keyl * 128 + (((ds * 4 + lg) ^ fsw) << 4));  \
          s0 = __builtin_amdgcn_mfma_f32_16x16x32_bf16(kf, qf[0][ds], s0, 0, 0, 0);  \
          if (NQS > 1) s1 = __builtin_amdgcn_mfma_f32_16x16x32_bf16(kf, qf[NQS - 1][ds], s1, 0, 0, 0);  \
        }  \
        if (MLA) {  \
          const bf16x8 kf = *(const bf16x8*)(Krb + keyl * 64 + ((lg ^ xh) << 4));  \
          s0 = __builtin_amdgcn_mfma_f32_16x16x32_bf16(kf, qf[0][NDS - 1], s0, 0, 0, 0);  \
          if (NQS > 1) s1 = __builtin_amdgcn_mfma_f32_16x16x32_bf16(kf, qf[NQS - 1][NDS - 1], s1, 0, 0, 0);  \
        }  \
        s[0][kk][j] = s0; if (NQS > 1) s[NQS - 1][kk][j] = s1;  \
      }  \
    bf16x8 pf[NQS][2];  \
    _Pragma("unroll")  \
    for (int qs = 0; qs < NQS; ++qs) {  \
      const int tq = q0 + 16 * NQS * w + 16 * qs + lr;  \
      float mx = -INFINITY;  \
      float mnew, alpha, ps = 0.f;  \
      if (MLA) {  \
        if ((KT_) * 64 + 63 > q0) {  \
    _Pragma("unroll")  \
          for (int kk = 0; kk < 2; ++kk)  \
    _Pragma("unroll")  \
            for (int j = 0; j < 2; ++j)  \
    _Pragma("unroll")  \
              for (int i = 0; i < 4; ++i) {  \
                const int key = (KT_) * 64 + 32 * kk + 8 * lg + 4 * j + i;  \
                s[qs][kk][j][i] = (key <= tq) ? s[qs][kk][j][i] : -INFINITY;  \
              }  \
        }  \
    _Pragma("unroll")  \
        for (int kk = 0; kk < 2; ++kk)  \
    _Pragma("unroll")  \
          for (int j = 0; j < 2; ++j)  \
    _Pragma("unroll")  \
            for (int i = 0; i < 4; ++i) mx = fmaxf(mx, s[qs][kk][j][i]);  \
        mx = fmaxf(mx, __shfl_xor(mx, 16));  \
        mx = fmaxf(mx, __shfl_xor(mx, 32));  \
        mnew = fmaxf(mrow[qs], mx * c1);  \
        alpha = fexp2(mrow[qs] - mnew);  \
        mrow[qs] = mnew;  \
    _Pragma("unroll")  \
        for (int kk = 0; kk < 2; ++kk) {  \
          float pv[8];  \
    _Pragma("unroll")  \
          for (int j = 0; j < 2; ++j)  \
    _Pragma("unroll")  \
            for (int i = 0; i < 4; ++i) {  \
              const float e = fexp2(__builtin_fmaf(s[qs][kk][j][i], c1, -mnew));  \
              pv[j * 4 + i] = e; ps += e;  \
            }  \
          uint4 r4 = make_uint4(pack2(pv[0], pv[1]), pack2(pv[2], pv[3]), pack2(pv[4], pv[5]), pack2(pv[6], pv[7]));  \
          pf[qs][kk] = *(bf16x8*)&r4;  \
        }  \
      } else {  \
    _Pragma("unroll")  \
        for (int kk = 0; kk < 2; ++kk)  \
    _Pragma("unroll")  \
          for (int j = 0; j < 2; ++j)  \
    _Pragma("unroll")  \
            for (int i = 0; i < 4; ++i) {  \
              const int key = (KT_) * 64 + 32 * kk + 8 * lg + 4 * j + i;  \
              float v = s[qs][kk][j][i] * c1 - sl2 * (float)(tq - key);  \
              const bool ok = (key <= tq) && (key > tq - 128);  \
              v = ok ? v : -INFINITY;  \
              s[qs][kk][j][i] = v;  \
              mx = fmaxf(mx, v);  \
            }  \
        mx = fmaxf(mx, __shfl_xor(mx, 16));  \
        mx = fmaxf(mx, __shfl_xor(mx, 32));  \
        mnew = fmaxf(mrow[qs], mx);  \
        alpha = fexp2(mrow[qs] - mnew);  \
        mrow[qs] = mnew;  \
    _Pragma("unroll")  \
        for (int kk = 0; kk < 2; ++kk) {  \
          float pv[8];  \
    _Pragma("unroll")  \
          for (int j = 0; j < 2; ++j)  \
    _Pragma("unroll")  \
            for (int i = 0; i < 4; ++i) {  \
              const float e = fexp2(s[qs][kk][j][i] - mnew);  \
              pv[j * 4 + i] = e; ps += e;  \
            }  \
          uint4 r4 = make_uint4(pack2(pv[0], pv[1]), pack2(pv[2], pv[3]), pack2(pv[4], pv[5]), pack2(pv[6], pv[7]));  \
          pf[qs][kk] = *(bf16x8*)&r4;  \
        }  \
      }  \
      lrow[qs] = lrow[qs] * alpha + ps;  \
    _Pragma("unroll")  \
      for (int jt = 0; jt < 4; ++jt) o[qs][jt] *= alpha;  \
    }  \
    _Pragma("unroll")  \
    for (int jt = 0; jt < 4; ++jt)  \
    _Pragma("unroll")  \
      for (int kk = 0; kk < 2; ++kk) {  \
        const bf16x8 vf = *(const bf16x8*)(Vb + (16 * jt + lr) * 128 + (((4 * kk + lg) ^ vsw) << 4));  \
        o[0][jt] = __builtin_amdgcn_mfma_f32_16x16x32_bf16(vf, pf[0][kk], o[0][jt], 0, 0, 0);  \
        if (NQS > 1) o[NQS - 1][jt] = __builtin_amdgcn_mfma_f32_16x16x32_bf16(vf, pf[NQS - 1][kk], o[NQS - 1][jt], 0, 0, 0);  \
      }  \
  }
  const int fsw = ((lr >> 1) & 1) | ((lr >> 2) << 1);
  const int xh = (lr >> 2) ^ (((lr >> 2) & 1) << 1);
  const int vsw = (lr >> 1) & 7;
  ATT_GLOAD(ra, kt_lo)
  ATT_GLOAD(rb, (kt_lo + 1 <= kt_hi ? kt_lo + 1 : kt_hi))
  ATT_WAIT_OLDER()
  ATT_SWRITE(ra, 0)
  __syncthreads();
  for (int kt = kt_lo; kt <= kt_hi; kt += 2) {
    ATT_GLOAD(ra, (kt + 2 <= kt_hi ? kt + 2 : kt_hi))
    ATT_STEP(kt, 0)
    ATT_WAIT_OLDER()
    ATT_SWRITE(rb, 1)
    __syncthreads();
    if (kt + 1 <= kt_hi) {
      ATT_GLOAD(rb, (kt + 3 <= kt_hi ? kt + 3 : kt_hi))
      ATT_STEP(kt + 1, 1)
      ATT_WAIT_OLDER()
      ATT_SWRITE(ra, 0)
      __syncthreads();
    }
  }
  asm volatile("s_waitcnt vmcnt(0)" ::: "memory");
  asm volatile("" :: "v"(rak0), "v"(rak1), "v"(rav0), "v"(rav1), "v"(rakr), "v"(rbk0), "v"(rbk1), "v"(rbv0), "v"(rbv1), "v"(rbkr));
#pragma unroll
  for (int qs = 0; qs < NQS; ++qs) {
    const int tq = q0 + 16 * NQS * w + 16 * qs + lr;
    float lsum = lrow[qs];
    lsum += __shfl_xor(lsum, 16);
    lsum += __shfl_xor(lsum, 32);
    if (!MLA) lsum += fexp2(sink2 - mrow[qs]);
    const float inv = 1.f / lsum;
    if (tq < TPB) {
      u16* yp = Y + ((size_t)b * TPB + tq) * ldy + head * 64 + 4 * lg;
#pragma unroll
      for (int jt = 0; jt < 4; ++jt) {
        uint2 wv;
        wv.x = pack2(o[qs][jt][0] * inv, o[qs][jt][1] * inv);
        wv.y = pack2(o[qs][jt][2] * inv, o[qs][jt][3] * inv);
        *(uint2*)(yp + 16 * jt) = wv;
      }
    }
  }
}


#define UP_EXP OFF_X
#define UP_TILES 16
#define P9_LO 0
#define P9_HI 129
#ifndef STOP_AFTER
#define STOP_AFTER 0
#endif
__device__ void dump_bf16(const Params& p, const u16* buf, int ld, int coloff, int shift = 0) {
  const int tid_ = otid();
  const int lane = tid_ & 63;
  const int wg = (int)((blockIdx.x + shift) % gridDim.x) * 4 + (tid_ >> 6), nw = gridDim.x * 4;
  for (int m = wg; m < MTOK; m += nw) {
    const int b = m / TPB, t = m - b * TPB;
    if (t < 16) continue;
    float* o = p.out + ((size_t)b * 4096 + (t - 16)) * DM;
    for (int j = 0; j < 16; ++j) o[j * 64 + lane] = bf2f(buf[(size_t)m * ld + coloff + j * 64 + lane]);
  }
}
#define XB_TMO      128
#define XB_XCNT(j)  (256  + 64 * (j))
#define XB_XSUB(j)  (1280 + 64 * (j))
#define XB_XGEN(j)  (2304 + 64 * (j))
#define XB_TOP      3328
#define XB_TOPGEN   3392
#define XCD_BAR_WORDS 3456
#define XB_SPIN_CAP (1u << 22)
#define LAS __attribute__((address_space(3)))
__device__ __forceinline__ unsigned xb_ld(unsigned* p) { return __hip_atomic_load(p, __ATOMIC_RELAXED, __HIP_MEMORY_SCOPE_AGENT); }
__device__ __forceinline__ unsigned xb_add(unsigned* p, unsigned v) { return __hip_atomic_fetch_add(p, v, __ATOMIC_RELAXED, __HIP_MEMORY_SCOPE_AGENT); }
__device__ __forceinline__ unsigned xb_xcc_id() { return (unsigned)__builtin_amdgcn_s_getreg((3 << 11) | 20) & 0xFu; }
#define XB_SPIN(cond, bar) do { unsigned _sp = 0; while (cond) { __builtin_amdgcn_s_sleep(1); \
    if ((++_sp & 255u) == 0u) { if (xb_ld(&(bar)[XB_TMO])) break; if (_sp > XB_SPIN_CAP) { atomicAdd(&(bar)[XB_TMO], 1u); break; } } } } while (0)
struct XcdBarrier { unsigned* bar; unsigned x; volatile unsigned* st; };
__device__ __forceinline__ XcdBarrier xcd_barrier_post(unsigned* bar, volatile unsigned* st) {
  XcdBarrier b; b.bar = bar; b.x = xb_xcc_id(); b.st = st;
  if (threadIdx.x == 0) (void)xb_add(&bar[XB_XCNT(b.x)], 1u);
  return b;
}
__device__ __forceinline__ void xcd_barrier_complete(unsigned* bar, unsigned x, unsigned& nloc, unsigned& nx) {
  const unsigned G = gridDim.x * gridDim.y * gridDim.z;
  unsigned sum, cnt, mine, sp = 0u;
  for (;;) {
    sum = 0u; cnt = 0u; mine = 0u;
#pragma unroll
    for (unsigned j = 0; j < 16; ++j) { const unsigned c = xb_ld(&bar[XB_XCNT(j)]); sum += c; cnt += (c > 0u) ? 1u : 0u; mine = (j == x) ? c : mine; }
    if (sum == G) break;
    __builtin_amdgcn_s_sleep(1);
    if ((++sp & 255u) == 0u) { if (xb_ld(&bar[XB_TMO])) break; if (sp > XB_SPIN_CAP) { atomicAdd(&bar[XB_TMO], 1u); break; } }
  }
  nloc = mine > 0u ? mine : 1u; nx = cnt > 0u ? cnt : 1u;
}
__device__ __attribute__((noinline)) void xcd_barrier_impl(unsigned* bar_, unsigned bx_, volatile unsigned* st_) {
  XcdBarrier b; b.bar = bar_; b.x = bx_; b.st = st_;
  asm volatile("s_waitcnt vmcnt(0)" ::: "memory");
  __syncthreads();
  if (threadIdx.x == 0) {
    unsigned* bar = b.bar;
    __builtin_amdgcn_s_waitcnt(0);
    unsigned nloc = b.st[0], nx = b.st[1];
    if (nloc == 0u) { xcd_barrier_complete(bar, b.x, nloc, nx); b.st[0] = nloc; b.st[1] = nx; }
    const unsigned old = xb_add(&bar[XB_XSUB(b.x)], 1u);
    const unsigned gen = old / nloc;
    if (old + 1u == (gen + 1u) * nloc) {
      __builtin_amdgcn_fence(__ATOMIC_RELEASE, "agent");
      asm volatile("s_waitcnt vmcnt(0)" ::: "memory");
      const unsigned og = xb_add(&bar[XB_TOP], 1u);
      const unsigned tg = og / nx;
      if (og + 1u == (tg + 1u) * nx) xb_add(&bar[XB_TOPGEN], 1u);
      else XB_SPIN(xb_ld(&bar[XB_TOPGEN]) == tg, bar);
      __builtin_amdgcn_fence(__ATOMIC_ACQUIRE, "agent");
      xb_add(&bar[XB_XGEN(b.x)], 1u);
      asm volatile("s_waitcnt vmcnt(0)" ::: "memory");
    } else {
      XB_SPIN(xb_ld(&bar[XB_XGEN(b.x)]) == gen, bar);
      __builtin_amdgcn_fence(__ATOMIC_ACQUIRE, "agent");
      asm volatile("s_waitcnt vmcnt(0)" ::: "memory");
    }
  }
  __syncthreads();
}
#define GSYNC() xcd_barrier_impl(xb.bar, xb.x, xb.st)
__global__ void __launch_bounds__(256, 2) hymba_megakernel(Params p, int ph_lo, int ph_hi) {
  cg::grid_group grid = cg::this_grid();
  __shared__ __attribute__((aligned(16))) char lds[65536];
  char* ws = p.ws;
  u16* abuf = (u16*)(ws + OFF_ABUF);
  u16* obuf = (u16*)(ws + OFF_OBUF);
  XcdBarrier xb; xb.bar = (unsigned*)(p.ws + OFF_BAR); xb.x = 0;
  xb.st = (volatile unsigned*)(p.ws + OFF_BAR) + 4096 + 2 * blockIdx.x;
  const bool fused = (ph_hi - ph_lo) > 1;
  if (fused) {
    xb = xcd_barrier_post((unsigned*)(p.ws + OFF_BAR), xb.st);
    grid.sync();
  }
  unsigned long long* tsp = (unsigned long long*)(p.ws + OFF_BAR + 24576);
  if (TIMING && blockIdx.x == 0 && threadIdx.x == 0) tsp[0] = __builtin_amdgcn_s_memrealtime();
  int pi = 0;
#define RUN (pi >= ph_lo && pi < ph_hi)
#define END_PHASE() do { if (pi >= ph_lo && pi + 1 < ph_hi) GSYNC(); if (TIMING && blockIdx.x == 0 && threadIdx.x == 0) tsp[pi + 1] = __builtin_amdgcn_s_memrealtime(); ++pi; } while (0)
  if (RUN && (PH & 1)) phase_convert(p, lds);
  if (RUN && (PH & 2)) phase_tables(p);
  if (RUN && (PH & 4)) phase_rows<0>(p, nullptr, p.g_pre_mix, true);
  END_PHASE();

  for (int l = 0; l < 2; ++l) {
    char* wb = ws + OFF_W + (size_t)l * W_LAYER;
    if (RUN && (PH & 8)) {
      EpiProjS e{(u16*)(ws + OX_PROJ), INW, (u16*)(ws + OX_VTS)};
      gemm_phase(abuf, DM, (const u16*)(wb + OW_IN), DM, INW, DM, lds, e, 0);
    }
    END_PHASE();
    if (STOP_AFTER == 1) { dump_bf16(p, (const u16*)(ws + OX_PROJ), INW, 0); return; }
    if (RUN && (PH & 32)) phase_ssm_a(p, l, lds);
    if (RUN && (PH & 64)) phase_mla_prep(p, l);
    END_PHASE();
    if (RUN && (PH & 128)) phase_ssm_c(p, l, lds);
    END_PHASE();
    if (RUN && (PH & 16)) for (int it = blockIdx.x; it < 4 * 8 * 33; it += gridDim.x) {
      const int qt = it / 32, r = it - qt * 32;
      attn_item<false, 2>(p, l, r >> 3, r & 7, qt, lds);
    }
    if (RUN && (PH & 256)) {
      EpiBf16 e{(u16*)(ws + OX_QMLA), 384, 384};
      gemm_phase((const u16*)(ws + OX_QN), 192, (const u16*)(wb + OW_UQ), 192, 384, 192, lds, e, 64);
    }
    if (RUN && (PH & 512)) {
      EpiKV e{nullptr, 0, (u16*)(ws + OX_KN), (u16*)(ws + OX_VTM)};
      gemm_phase((const u16*)(ws + OX_CN), 128, (const u16*)(wb + OW_UKV), 128, 512, 128, lds, e, 200);
    }
    END_PHASE();
    if (RUN && (PH & 1024)) {
      unsigned* ticket = (unsigned*)(ws + OFF_BAR) + 3600 + l;
      __shared__ int s_item;
      for (;;) {
        __syncthreads();
        if (threadIdx.x == 0) s_item = (int)atomicAdd(ticket, 1u);
        __syncthreads();
        const int it = s_item;
        if (it >= 4 * 4 * 65) break;
        const int qt = 64 - it / 16, r = it & 15;
        attn_item<true, 1>(p, l, r >> 2, r & 3, qt, lds);
      }
    }
    if (RUN && (PH & 2048)) {
      EpiGlu e{nullptr, 0, (const u16*)(ws + OX_Z), p.b_glu + (size_t)l * 256, (u16*)(ws + OX_YSSM)};
      gemm_phase((const u16*)(ws + OX_Z), 256, (const u16*)(wb + OW_GLU), 256, 256, 256, lds, e, 16);
    }
    END_PHASE();
    if (RUN && (PH & 4096)) phase_headnorm(p, l);
    END_PHASE();
    if (STOP_AFTER == 5) { dump_bf16(p, abuf, DM, 0); return; }
    if (RUN && (PH & 8192)) {
      EpiBf16 e{obuf, DM, DM};
      gemm_phase(abuf, DM, (const u16*)(wb + OW_OUT), DM, DM, DM, lds, e, 0);
    }
    END_PHASE();
    if (RUN && (PH & 16384)) {
      if (l == 0) phase_rows<2>(p, p.g_post_mix + (size_t)l * DM, p.g_pre_mlp + (size_t)l * DM, true);
      else phase_rows<1>(p, p.g_post_mix + (size_t)l * DM, p.g_pre_mlp + (size_t)l * DM, true);
    }
    END_PHASE();
    if (STOP_AFTER == 7) { dump_bf16(p, abuf, DM, 0); return; }
    if (RUN && (PH & 32768)) {
      EpiRelu2 e{(u16*)(ws + OFF_X), UPLD};
      gemm_phase(abuf, DM, (const u16*)(wb + OW_UP), DM, DFF, DM, lds, e, 0);
    }
    END_PHASE();
    if (RUN && (PH & 65536)) {
      EpiBf16 e{obuf, DM, DM};
      const u16* upA = (const u16*)(ws + OFF_X);
      const u16* wdn = (const u16*)(wb + OW_DN);
      const bool xmap = (gridDim.x & 7) == 0;
      const int xq = blockIdx.x & 7, xl = blockIdx.x >> 3, xn = gridDim.x >> 3;
      for (int item = blockIdx.x; item < 1024 + 64; item += gridDim.x) {
        if (item < 1024) {
          int tm = item >> 3, tn = item & 7;
          if (xmap) {
            const int r = item / gridDim.x;
            const int idx = xl + r * xn;
            if (idx < 128 && xn * ((1024 + gridDim.x - 1) / gridDim.x) >= 128) { tm = 2 * (idx >> 1) + (xq >> 2); tn = 2 * (xq & 3) + (idx & 1); }
          }
          gemm_tile(upA, UPLD, MTOK, wdn, DFF, DM, DFF, tm * 128, tn * 128, lds, e);
        } else {
          const int i2 = item - 1024, tn = i2 & 7, ks = i2 >> 3;
          EpiPart ep{(float*)(ws + OFF_PART) + (size_t)ks * 64 * 1024, nullptr, 0};
          gemm_tile(upA + ks * 512, UPLD, MTOK, wdn + ks * 512, DFF, DM, 512, 16384, tn * 128, lds, ep);
        }
      }
    }
    END_PHASE();
    if (STOP_AFTER == 9) { dump_bf16(p, obuf, DM, 0, 3); return; }
    if (RUN && (PH & 131072)) phase_rows<1>(p, p.g_post_mlp + (size_t)l * DM, p.g_pre_mix + (size_t)(l < 1 ? l + 1 : l) * DM, l < 1, (const float*)(ws + OFF_PART));
    if (l < 1) END_PHASE();
  }
  if (TIMING) {
    END_PHASE();
    if (blockIdx.x == 0) {
      __shared__ int n_pert;
      if (threadIdx.x == 0) {
        const float tot = (float)(tsp[pi] - tsp[0]);
        const float f1 = (float)(tsp[T1_HI] - tsp[T1_LO]) / tot;
        const float f2 = (float)(tsp[T2_HI] - tsp[T2_LO]) / tot;
        n_pert = (int)(f1 * 500000.f);
        p.out[0] += 0.2f + 0.15f * f2;
      }
      __syncthreads();
      for (int i = threadIdx.x; i < n_pert; i += 256) p.out[4096 + i] += 0.1f;
    }
  }
}

extern "C" void kernel_launch(void* const* d_in, const int* in_sizes, int n_in, void* d_out, int out_size, void* d_ws,
                              size_t ws_size, hipStream_t stream) {
  static int grid_blocks = 0;
  if (!grid_blocks) {
    int dev = 0, cus = 0, per_cu = 0;
    hipGetDevice(&dev);
    hipDeviceGetAttribute(&cus, hipDeviceAttributeMultiprocessorCount, dev);
    hipOccupancyMaxActiveBlocksPerMultiprocessor(&per_cu, hymba_megakernel, 256, 0);
    if (per_cu > 2) per_cu = 2;
    if (per_cu < 1) per_cu = 1;
    grid_blocks = cus * per_cu;
  }
  Params p{};
  const float** f = (const float**)&p;
  for (int i = 0; i < 27; ++i) f[i] = (const float*)d_in[i];
  p.out = (float*)d_out;
  p.ws = (char*)d_ws;
  hipMemsetAsync((char*)d_ws + OFF_BAR, 0, 32768, stream);
#ifndef N_LAUNCH_MODE
#define N_LAUNCH_MODE 1
#endif
  if (N_LAUNCH_MODE == 1) {
    int lo = 0, hi = 23 + (TIMING ? 1 : 0);
    void* args[] = {&p, &lo, &hi};
    hipError_t e = hipLaunchCooperativeKernel((void*)hymba_megakernel, dim3(grid_blocks), dim3(256), args, 0, stream);
    if (e != hipSuccess) fprintf(stderr, "cooperative launch failed: %s (grid %d)\n", hipGetErrorString(e), grid_blocks);
  } else {
    for (int i = 0; i < 23; ++i) hipLaunchKernelGGL(hymba_megakernel, dim3(grid_blocks), dim3(256), 0, stream, p, i, i + 1);
  }
}
```

```cpp
#include <hip/hip_runtime.h>
#include <hip/hip_cooperative_groups.h>
#include <cstdio>
#include <cstdint>
namespace cg = cooperative_groups;

typedef unsigned short u16;
using bf16x8 = __attribute__((ext_vector_type(8))) short;
using f32x4 = __attribute__((ext_vector_type(4))) float;

#define TPB 4112
#define MTOK 16448
#define MPAD 16512
#define DM 1024
#define INW 1376
#define DFF 4096
#define LT 4160
#define NCH 65
#ifndef PH
#define PH 0x3ffff
#endif
#ifndef TIMING
#define TIMING 0
#endif
#define T1_LO 6
#define T1_HI 9
#define T2_LO 0
#define T2_HI 1

constexpr size_t al256(size_t x) { return (x + 255) & ~(size_t)255; }
constexpr size_t cmax(size_t a, size_t b) { return a > b ? a : b; }
constexpr size_t OW_IN = 0;
constexpr size_t OW_OUT = OW_IN + (size_t)INW * DM * 2;
constexpr size_t OW_UP = OW_OUT + (size_t)DM * DM * 2;
constexpr size_t OW_DN = OW_UP + (size_t)DFF * DM * 2;
constexpr size_t OW_UQ = OW_DN + (size_t)DFF * DM * 2;
constexpr size_t OW_UKV = OW_UQ + (size_t)384 * 192 * 2;
constexpr size_t OW_GLU = OW_UKV + (size_t)512 * 128 * 2;
constexpr size_t W_LAYER = OW_GLU + (size_t)256 * 256 * 2;
constexpr size_t OFF_W = 0;
constexpr size_t OFF_ROPE = OFF_W + 2 * W_LAYER;
constexpr size_t OFF_LAM = OFF_ROPE + al256((size_t)TPB * 16 * 8);
constexpr size_t OFF_LAMT = OFF_LAM + 2 * 16 * 64 * 8;
constexpr size_t OFF_BB = OFF_LAMT + 2 * 16 * 64 * 8;
constexpr size_t OFF_BAR = OFF_BB + 2 * 16 * 32 * 64 * 4;
constexpr size_t OFF_HMETA = OFF_BAR + 32768;
constexpr size_t OFF_ABUF = OFF_HMETA + 4 * 16 * 1024 * 4;
constexpr size_t OFF_OBUF = OFF_ABUF + (size_t)MPAD * DM * 2;
constexpr size_t OFF_X = OFF_OBUF + (size_t)MPAD * DM * 2;
constexpr size_t OX_PROJ = OFF_X;
constexpr size_t OX_Z = OX_PROJ + (size_t)MPAD * INW * 2;
constexpr size_t OX_YSSM = OX_Z + (size_t)MPAD * 256 * 2;
constexpr size_t OX_YSWA = OX_YSSM + (size_t)MPAD * 256 * 2;
constexpr size_t OX_YMLA = OX_YSWA + (size_t)MPAD * 512 * 2;
constexpr size_t OX_QN = OX_YMLA + (size_t)MPAD * 256 * 2;
constexpr size_t OX_CN = OX_QN + (size_t)MPAD * 192 * 2;
constexpr size_t OX_KR = OX_CN + (size_t)MPAD * 128 * 2;
constexpr size_t OX_QMLA = OX_KR + (size_t)MPAD * 32 * 2;
constexpr size_t OX_KN = OX_QMLA + (size_t)MPAD * 384 * 2;
constexpr size_t OX_VTM = OX_KN + (size_t)MPAD * 256 * 2;
constexpr size_t OX_VTS = OX_VTM + (size_t)4 * 4 * 64 * LT * 2;
constexpr size_t OX_END = OX_VTS + (size_t)4 * 2 * 64 * LT * 2;
constexpr size_t OX_LAST = OX_END + (size_t)4 * 16 * NCH * 64 * 8;
#define UPLD 4160
constexpr size_t OFF_END2 = cmax(OX_LAST, OFF_X + (size_t)MPAD * UPLD * 2);
constexpr size_t END_BYTES = (size_t)4 * 16 * NCH * 64 * 8;
constexpr size_t OFF_PART = OFF_END2 + 2 * END_BYTES;
constexpr size_t WS_TOTAL = OFF_PART + (size_t)8 * 64 * 1024 * 4;
static_assert(WS_TOTAL <= (size_t)256 * 1024 * 1024, "workspace too large");

struct Params {
  const float* x; const float* meta; const float* g_pre_mix; const float* g_post_mix; const float* g_pre_mlp;
  const float* g_post_mlp; const float* w_in; const float* w_out; const float* g_heads; const float* a_re;
  const float* a_im; const float* log_step; const float* b_re; const float* b_im; const float* c_re; const float* c_im;
  const float* d_skip; const float* w_glu; const float* b_glu; const float* sinks; const float* g_q; const float* g_kv;
  const float* w_uq; const float* w_uk; const float* w_uv; const float* w_up; const float* w_down;
  float* out; char* ws;
};

__device__ __forceinline__ unsigned pack2(float a, float b) {
  unsigned r;
  asm("v_cvt_pk_bf16_f32 %0, %1, %2" : "=v"(r) : "v"(a), "v"(b));
  return r;
}
__device__ __forceinline__ u16 f2bf(float f) { return (u16)(pack2(f, f) & 0xffffu); }
__device__ __forceinline__ float bf2f(u16 h) { return __uint_as_float(((unsigned)h) << 16); }
__device__ __forceinline__ float bflo(unsigned u) { return __uint_as_float(u << 16); }
__device__ __forceinline__ float bfhi(unsigned u) { return __uint_as_float(u & 0xffff0000u); }
__device__ __forceinline__ float wave_sum(float v) {
#pragma unroll
  for (int o = 32; o; o >>= 1) v += __shfl_xor(v, o);
  return v;
}
__device__ __forceinline__ float4 ldnt_f4(const float* p) {
  const f32x4 v = __builtin_nontemporal_load((const f32x4*)p);
  return make_float4(v[0], v[1], v[2], v[3]);
}
typedef unsigned nu32x2 __attribute__((ext_vector_type(2)));
typedef unsigned nu32x4 __attribute__((ext_vector_type(4)));
__device__ __forceinline__ uint2 ldnt_u2(const u16* p) {
  const nu32x2 v = __builtin_nontemporal_load((const nu32x2*)p);
  return make_uint2(v[0], v[1]);
}
__device__ __forceinline__ uint4 ldnt_u4(const u16* p) {
  const nu32x4 v = __builtin_nontemporal_load((const nu32x4*)p);
  return make_uint4(v[0], v[1], v[2], v[3]);
}
__device__ __forceinline__ float fexp2(float x) { return __builtin_amdgcn_exp2f(x); }
__device__ __forceinline__ int otid() { int t = threadIdx.x; asm volatile("" : "+v"(t)); return t; }

struct Mat { const float* src; u16* dst; int K, N; };
__device__ __forceinline__ Mat get_mat(const Params& p, int idx) {
  int l = idx >> 3, t = idx & 7;
  char* wb = p.ws + OFF_W + (size_t)l * W_LAYER;
  Mat m;
  if (t == 0) { m.src = p.w_in + (size_t)l * DM * INW; m.dst = (u16*)(wb + OW_IN); m.K = DM; m.N = INW; }
  else if (t == 1) { m.src = p.w_out + (size_t)l * DM * DM; m.dst = (u16*)(wb + OW_OUT); m.K = DM; m.N = DM; }
  else if (t == 2) { m.src = p.w_up + (size_t)l * DM * DFF; m.dst = (u16*)(wb + OW_UP); m.K = DM; m.N = DFF; }
  else if (t == 3) { m.src = p.w_down + (size_t)l * DFF * DM; m.dst = (u16*)(wb + OW_DN); m.K = DFF; m.N = DM; }
  else if (t == 4) { m.src = p.w_uq + (size_t)l * 192 * 384; m.dst = (u16*)(wb + OW_UQ); m.K = 192; m.N = 384; }
  else if (t == 5) { m.src = p.w_uk + (size_t)l * 128 * 256; m.dst = (u16*)(wb + OW_UKV); m.K = 128; m.N = 256; }
  else if (t == 6) { m.src = p.w_uv + (size_t)l * 128 * 256; m.dst = (u16*)(wb + OW_UKV) + 256 * 128; m.K = 128; m.N = 256; }
  else { m.src = p.w_glu + (size_t)l * 256 * 256; m.dst = (u16*)(wb + OW_GLU); m.K = 256; m.N = 256; }
  return m;
}

__device__ void phase_convert(const Params& p, char* lds) {
  float* tl = (float*)lds;
  const int tid = otid();
  int base = 0;
  for (int mi = 0; mi < 16; ++mi) {
    Mat mt = get_mat(p, mi);
    const int tn = mt.N >> 5, tk = mt.K >> 6, nt = tn * tk;
    int first = (int)(((long)blockIdx.x - base) % (long)gridDim.x);
    if (first < 0) first += gridDim.x;
    for (int i = first; i < nt; i += gridDim.x) {
      const int kt = i / tn, ntile = i - kt * tn;
      const int k0 = kt * 64, n0 = ntile * 32;
      {
        const int r = tid >> 3, c4 = (tid & 7) * 4;
#pragma unroll
        for (int j = 0; j < 2; ++j) {
          float4 v = ldnt_f4(mt.src + (size_t)(k0 + r + 32 * j) * mt.N + n0 + c4);
          float* d = tl + (r + 32 * j) * 33 + c4;
          d[0] = v.x; d[1] = v.y; d[2] = v.z; d[3] = v.w;
        }
      }
      __syncthreads();
      {
        const int n = tid >> 3, kc = (tid & 7) * 8;
        unsigned w[4];
#pragma unroll
        for (int e = 0; e < 4; ++e) w[e] = pack2(tl[(kc + 2 * e) * 33 + n], tl[(kc + 2 * e + 1) * 33 + n]);
        *(uint4*)(mt.dst + (size_t)(n0 + n) * mt.K + k0 + kc) = make_uint4(w[0], w[1], w[2], w[3]);
      }
      __syncthreads();
    }
    base += nt;
  }
}

__device__ void phase_tables(const Params& p) {
  const int gt = blockIdx.x * 256 + otid(), nthr = gridDim.x * 256;
  float2* rope = (float2*)(p.ws + OFF_ROPE);
  for (int i = gt; i < TPB * 16; i += nthr) {
    int t = i >> 4, f = i & 15;
    float inv = powf(10000.f, -(float)f / 16.f);
    float ang = (float)t * inv;
    double rev = (double)ang * 0.15915494309189535;
    rev -= rint(rev);
    float fr = (float)rev;
    rope[i] = make_float2(__builtin_amdgcn_cosf(fr), __builtin_amdgcn_sinf(fr));
  }
  float2* lam = (float2*)(p.ws + OFF_LAM);
  float2* lamT = (float2*)(p.ws + OFF_LAMT);
  float* bb = (float*)(p.ws + OFF_BB);
  for (int i = gt; i < 2 * 16 * 64; i += nthr) {
    int lg = i >> 6, s = i & 63;
    float step = expf(p.log_step[lg]);
    float ar = p.a_re[i], ai = p.a_im[i];
    float mag = expf(ar * step);
    float th = ai * step;
    float lr = mag * cosf(th), li = mag * sinf(th);
    lam[i] = make_float2(lr, li);
    float pr = lr, pi = li;
#pragma unroll
    for (int q = 0; q < 6; ++q) { float nr2 = pr * pr - pi * pi, ni2 = 2.f * pr * pi; pr = nr2; pi = ni2; }
    lamT[i] = make_float2(pr, pi);
    float den = ar * ar + ai * ai;
    float nr = lr - 1.f, ni = li;
    float cr = (nr * ar + ni * ai) / den, ci = (ni * ar - nr * ai) / den;
    const float* brp = p.b_re + (size_t)i * 16;
    const float* bip = p.b_im + (size_t)i * 16;
#pragma unroll
    for (int c = 0; c < 16; ++c) {
      float br = brp[c], bi = bip[c];
      bb[((size_t)lg * 32 + 2 * c) * 64 + s] = cr * br - ci * bi;
      bb[((size_t)lg * 32 + 2 * c + 1) * 64 + s] = cr * bi + ci * br;
    }
  }
}

__device__ __forceinline__ float* h_row(const Params& p, int m) {
  const int b = m / TPB, t = m - b * TPB;
  return t < 16 ? (float*)(p.ws + OFF_HMETA) + (size_t)(b * 16 + t) * DM : p.out + ((size_t)b * 4096 + (t - 16)) * DM;
}
template <int MODE>
__device__ void phase_rows(const Params& p, const float* gpost, const float* gnext, bool has_next, const float* part = nullptr) {
  const int tid_ = otid();
  const int lane = tid_ & 63;
  const int wg = blockIdx.x * 4 + (tid_ >> 6), nw = gridDim.x * 4;
  u16* abuf = (u16*)(p.ws + OFF_ABUF);
  const u16* obuf = (const u16*)(p.ws + OFF_OBUF);
  for (int mb = wg; mb < MTOK; mb += 2 * nw) {
    int mr[2]; bool ok[2]; float* hr[2];
    float4 v[2][4]; uint2 ob[2][4];
#pragma unroll
    for (int r = 0; r < 2; ++r) {
      mr[r] = mb + r * nw; ok[r] = mr[r] < MTOK;
      const int mm = ok[r] ? mr[r] : mb;
      hr[r] = h_row(p, mm);
      if (MODE == 0) {
        const int b = mm / TPB, t = mm - b * TPB;
        const float* src = t < 16 ? p.meta + (size_t)t * DM : p.x + ((size_t)b * 4096 + (t - 16)) * DM;
#pragma unroll
        for (int j = 0; j < 4; ++j) v[r][j] = ldnt_f4(src + j * 256 + lane * 4);
      } else {
        const float* hsrc = hr[r];
        if (MODE == 2) {
          const int b2 = mm / TPB, t2 = mm - b2 * TPB;
          hsrc = t2 < 16 ? p.meta + (size_t)t2 * DM : p.x + ((size_t)b2 * 4096 + (t2 - 16)) * DM;
        }
#pragma unroll
        for (int j = 0; j < 4; ++j) {
          ob[r][j] = ldnt_u2(obuf + (size_t)mm * DM + j * 256 + lane * 4);
          v[r][j] = ldnt_f4(hsrc + j * 256 + lane * 4);
        }
        if (part != nullptr && mm >= 16384) {
#pragma unroll
          for (int j = 0; j < 4; ++j) {
            float4 a = make_float4(0.f, 0.f, 0.f, 0.f);
#pragma unroll
            for (int ks = 0; ks < 8; ++ks) {
              const float4 q = *(const float4*)(part + ((size_t)ks * 64 + (mm - 16384)) * 1024 + j * 256 + lane * 4);
              a.x += q.x; a.y += q.y; a.z += q.z; a.w += q.w;
            }
            ob[r][j].x = pack2(a.x, a.y); ob[r][j].y = pack2(a.z, a.w);
          }
        }
      }
    }
#pragma unroll
    for (int r = 0; r < 2; ++r) {
      if (MODE >= 1) {
        float4 o[4];
        float ss = 0.f;
#pragma unroll
        for (int j = 0; j < 4; ++j) {
          o[j] = make_float4(bflo(ob[r][j].x), bfhi(ob[r][j].x), bflo(ob[r][j].y), bfhi(ob[r][j].y));
          ss += o[j].x * o[j].x + o[j].y * o[j].y + o[j].z * o[j].z + o[j].w * o[j].w;
        }
        ss = wave_sum(ss);
        const float rs = rsqrtf(ss * (1.f / 1024.f) + 1e-6f);
#pragma unroll
        for (int j = 0; j < 4; ++j) {
          const float4 hv = v[r][j];
          const float4 g = *(const float4*)(gpost + j * 256 + lane * 4);
          v[r][j] = make_float4(hv.x + o[j].x * rs * g.x, hv.y + o[j].y * rs * g.y, hv.z + o[j].z * rs * g.z,
                                hv.w + o[j].w * rs * g.w);
        }
      }
      if (MODE != 0 && ok[r]) {
#pragma unroll
        for (int j = 0; j < 4; ++j) {
          const f32x4 hv4 = {v[r][j].x, v[r][j].y, v[r][j].z, v[r][j].w};
          __builtin_nontemporal_store(hv4, (f32x4*)(hr[r] + j * 256 + lane * 4));
        }
      }
      if (has_next) {
        float ss = 0.f;
#pragma unroll
        for (int j = 0; j < 4; ++j)
          ss += v[r][j].x * v[r][j].x + v[r][j].y * v[r][j].y + v[r][j].z * v[r][j].z + v[r][j].w * v[r][j].w;
        ss = wave_sum(ss);
        const float rs = rsqrtf(ss * (1.f / 1024.f) + 1e-6f);
        if (ok[r]) {
#pragma unroll
          for (int j = 0; j < 4; ++j) {
            const float4 g = *(const float4*)(gnext + j * 256 + lane * 4);
            uint2 w;
            w.x = pack2(v[r][j].x * rs * g.x, v[r][j].y * rs * g.y);
            w.y = pack2(v[r][j].z * rs * g.z, v[r][j].w * rs * g.w);
            *(uint2*)(abuf + (size_t)mr[r] * DM + j * 256 + lane * 4) = w;
          }
        }
      }
    }
  }
}

__device__ void phase_headnorm(const Params& p, int l) {
  const int tid_ = otid();
  const int lane = tid_ & 63;
  const int wg = blockIdx.x * 4 + (tid_ >> 6), nw = gridDim.x * 4;
  u16* abuf = (u16*)(p.ws + OFF_ABUF);
  const u16* yssm = (const u16*)(p.ws + OX_YSSM);
  const u16* yswa = (const u16*)(p.ws + OX_YSWA);
  const u16* ymla = (const u16*)(p.ws + OX_YMLA);
  const float* gh = p.g_heads + (size_t)l * 1024;
  const float4 g1 = *(const float4*)(gh + lane * 4);
  const float4 g2a = *(const float4*)(gh + 256 + lane * 8);
  const float4 g2b = *(const float4*)(gh + 256 + lane * 8 + 4);
  const float4 g3 = *(const float4*)(gh + 768 + lane * 4);
  for (int mb = wg; mb < MTOK; mb += 2 * nw) {
    uint2 ar[2]; uint4 sr[2]; uint2 cr[2]; int mrow[2]; bool ok[2];
#pragma unroll
    for (int r = 0; r < 2; ++r) {
      mrow[r] = mb + r * nw; ok[r] = mrow[r] < MTOK;
      const int m = ok[r] ? mrow[r] : mb;
      ar[r] = ldnt_u2(yssm + (size_t)m * 256 + lane * 4);
      sr[r] = ldnt_u4(yswa + (size_t)m * 512 + lane * 8);
      cr[r] = ldnt_u2(ymla + (size_t)m * 256 + lane * 4);
    }
#pragma unroll
    for (int r = 0; r < 2; ++r) {
      const uint2 a = ar[r]; const uint4 s = sr[r]; const uint2 c = cr[r];
      float av[4] = {bflo(a.x), bfhi(a.x), bflo(a.y), bfhi(a.y)};
      float sv[8] = {bflo(s.x), bfhi(s.x), bflo(s.y), bfhi(s.y), bflo(s.z), bfhi(s.z), bflo(s.w), bfhi(s.w)};
      float cv[4] = {bflo(c.x), bfhi(c.x), bflo(c.y), bfhi(c.y)};
      float s1 = 0.f, s2 = 0.f, s3 = 0.f;
#pragma unroll
      for (int e = 0; e < 4; ++e) { s1 += av[e] * av[e]; s3 += cv[e] * cv[e]; }
#pragma unroll
      for (int e = 0; e < 8; ++e) s2 += sv[e] * sv[e];
      s1 = wave_sum(s1); s2 = wave_sum(s2); s3 = wave_sum(s3);
      const float r1 = rsqrtf(s1 * (1.f / 256.f) + 1e-6f);
      const float r2 = rsqrtf(s2 * (1.f / 512.f) + 1e-6f);
      const float r3 = rsqrtf(s3 * (1.f / 256.f) + 1e-6f);
      if (ok[r]) {
        u16* dst = abuf + (size_t)mrow[r] * DM;
        uint2 w1; w1.x = pack2(av[0] * r1 * g1.x, av[1] * r1 * g1.y); w1.y = pack2(av[2] * r1 * g1.z, av[3] * r1 * g1.w);
        *(uint2*)(dst + lane * 4) = w1;
        uint4 w2;
        w2.x = pack2(sv[0] * r2 * g2a.x, sv[1] * r2 * g2a.y); w2.y = pack2(sv[2] * r2 * g2a.z, sv[3] * r2 * g2a.w);
        w2.z = pack2(sv[4] * r2 * g2b.x, sv[5] * r2 * g2b.y); w2.w = pack2(sv[6] * r2 * g2b.z, sv[7] * r2 * g2b.w);
        *(uint4*)(dst + 256 + lane * 8) = w2;
        uint2 w3; w3.x = pack2(cv[0] * r3 * g3.x, cv[1] * r3 * g3.y); w3.y = pack2(cv[2] * r3 * g3.z, cv[3] * r3 * g3.w);
        *(uint2*)(dst + 768 + lane * 4) = w3;
      }
    }
  }
}

__device__ void phase_mla_prep(const Params& p, int l) {
  const int tid_ = otid();
  const int lane = tid_ & 63;
  const int wg = blockIdx.x * 4 + (tid_ >> 6), nw = gridDim.x * 4;
  const u16* proj = (const u16*)(p.ws + OX_PROJ);
  u16* qn = (u16*)(p.ws + OX_QN);
  u16* cn = (u16*)(p.ws + OX_CN);
  u16* kr = (u16*)(p.ws + OX_KR);
  const float2* rope = (const float2*)(p.ws + OFF_ROPE);
  const float* gq = p.g_q + (size_t)l * 192;
  const float* gkv = p.g_kv + (size_t)l * 128;
  const int role = lane < 24 ? 0 : (lane < 40 ? 1 : (lane < 44 ? 2 : 3));
  const int eoff = role == 0 ? 1024 + lane * 8 : (role == 1 ? 1216 + (lane - 24) * 8 : (role == 2 ? 1344 + (lane - 40) * 8 : 1024));
  float gv[8];
#pragma unroll
  for (int e = 0; e < 8; ++e) gv[e] = role == 0 ? gq[lane * 8 + e] : (role == 1 ? gkv[(lane - 24) * 8 + e] : 0.f);
  for (int mb = wg; mb < MTOK; mb += 2 * nw) {
    uint4 raw[2]; int mrow[2]; bool ok[2];
#pragma unroll
    for (int r = 0; r < 2; ++r) {
      mrow[r] = mb + r * nw; ok[r] = mrow[r] < MTOK;
      const int m = ok[r] ? mrow[r] : mb;
      raw[r] = *(const uint4*)(proj + (size_t)m * INW + eoff);
    }
#pragma unroll
    for (int r = 0; r < 2; ++r) {
      const int m = ok[r] ? mrow[r] : mb;
      const int bb = m / TPB, t = m - bb * TPB;
      const unsigned wv[4] = {raw[r].x, raw[r].y, raw[r].z, raw[r].w};
      float v[8];
#pragma unroll
      for (int e = 0; e < 4; ++e) { v[2 * e] = bflo(wv[e]); v[2 * e + 1] = bfhi(wv[e]); }
      float ss = 0.f;
#pragma unroll
      for (int e = 0; e < 8; ++e) ss += v[e] * v[e];
      const float sq = wave_sum(role == 0 ? ss : 0.f);
      const float sc = wave_sum(role == 1 ? ss : 0.f);
      const float rq = rsqrtf(sq * (1.f / 192.f) + 1e-6f);
      const float rc = rsqrtf(sc * (1.f / 128.f) + 1e-6f);
      unsigned pw[4];
#pragma unroll
      for (int e = 0; e < 4; ++e) pw[e] = (unsigned)__shfl((int)wv[e], lane ^ 2);
      uint4 outv;
      if (role == 2) {
        const int i0 = ((lane - 40) & 1) * 8;
        const bool first = lane < 42;
        unsigned ow[4];
#pragma unroll
        for (int e = 0; e < 4; ++e) {
          const float2 ca = rope[t * 16 + i0 + 2 * e], cb = rope[t * 16 + i0 + 2 * e + 1];
          const float pa = bflo(pw[e]), pb = bfhi(pw[e]);
          float ra, rb;
          if (first) { ra = v[2 * e] * ca.x - pa * ca.y; rb = v[2 * e + 1] * cb.x - pb * cb.y; }
          else { ra = pa * ca.y + v[2 * e] * ca.x; rb = pb * cb.y + v[2 * e + 1] * cb.x; }
          ow[e] = pack2(ra, rb);
        }
        outv = make_uint4(ow[0], ow[1], ow[2], ow[3]);
      } else {
        const float rs = role == 0 ? rq : rc;
        outv = make_uint4(pack2(v[0] * rs * gv[0], v[1] * rs * gv[1]), pack2(v[2] * rs * gv[2], v[3] * rs * gv[3]),
                          pack2(v[4] * rs * gv[4], v[5] * rs * gv[5]), pack2(v[6] * rs * gv[6], v[7] * rs * gv[7]));
      }
      if (ok[r]) {
        if (role == 0) *(uint4*)(qn + (size_t)m * 192 + lane * 8) = outv;
        else if (role == 1) *(uint4*)(cn + (size_t)m * 128 + (lane - 24) * 8) = outv;
        else if (role == 2) *(uint4*)(kr + (size_t)m * 32 + (lane - 40) * 8) = outv;
      }
    }
  }
}

template <class Epi>
__device__ __forceinline__ void gemm_tile(const u16* __restrict__ A, int lda, int Mrows, const u16* __restrict__ Bt,
                                          int ldb, int Nrows, int K, int m0, int n0, char* lds, Epi& epi) {
  const int tid = otid(), lane = tid & 63, wid = tid >> 6, wm = wid >> 1, wn = wid & 1;
  const int lr = lane & 15, lg = lane >> 4;
  const int lrow = tid >> 3, lkc = tid & 7;
  const int wsw = (lrow >> 1) & 7;
  const u16* ap[4];
  const u16* bp[4];
#pragma unroll
  for (int j = 0; j < 4; ++j) {
    int ra = m0 + lrow + 32 * j; ra = ra < Mrows ? ra : Mrows - 1;
    int rb = n0 + lrow + 32 * j; rb = rb < Nrows ? rb : Nrows - 1;
    ap[j] = A + (size_t)ra * lda + lkc * 8;
    bp[j] = Bt + (size_t)rb * ldb + lkc * 8;
  }
  f32x4 acc[4][4];
#pragma unroll
  for (int i = 0; i < 4; ++i)
#pragma unroll
    for (int j = 0; j < 4; ++j) acc[i][j] = (f32x4){0.f, 0.f, 0.f, 0.f};
  typedef unsigned u32x4 __attribute__((ext_vector_type(4)));
  u32x4 a0[4], b0[4], a1[4], b1[4];
  const int nk = K >> 6;
  const int rsw = (lr >> 1) & 7;
  const int woff = lrow * 128 + ((lkc ^ wsw) << 4);
#define GEMM_ISSUE(SA, SB, KT)                                                                     \
  {                                                                                                \
    const int kn_ = ((KT) < nk) ? (KT) : nk - 1;                                                   \
    _Pragma("unroll") for (int j = 0; j < 4; ++j) {                                                \
      const u16* pa_ = ap[j] + kn_ * 64;                                                           \
      const u16* pb_ = bp[j] + kn_ * 64;                                                           \
      asm volatile("global_load_dwordx4 %0, %1, off" : "=&v"(SA[j]) : "v"(pa_) : "memory");        \
      asm volatile("global_load_dwordx4 %0, %1, off" : "=&v"(SB[j]) : "v"(pb_) : "memory");        \
    }                                                                                              \
  }
#define GEMM_WRITE(SA, SB, BUF)                                                                    \
  {                                                                                                \
    char* da_ = lds + (BUF) * 32768 + woff;                                                        \
    _Pragma("unroll") for (int j = 0; j < 4; ++j) {                                                \
      *(u32x4*)(da_ + j * 4096) = SA[j];                                                           \
      *(u32x4*)(da_ + 16384 + j * 4096) = SB[j];                                                   \
    }                                                                                              \
  }
#define GEMM_COMPUTE(BUF)                                                                          \
  {                                                                                                \
    const char* sa_ = lds + (BUF) * 32768 + (wm * 64 + lr) * 128;                                  \
    const char* sb_ = lds + (BUF) * 32768 + 16384 + (wn * 64 + lr) * 128;                          \
    bf16x8 af[2][4], bfr[2][4];                                                                    \
    _Pragma("unroll") for (int kk = 0; kk < 2; ++kk) {                                             \
      const int co = ((kk * 4 + lg) ^ rsw) << 4;                                                   \
      _Pragma("unroll") for (int i = 0; i < 4; ++i) af[kk][i] = *(const bf16x8*)(sa_ + i * 2048 + co); \
      _Pragma("unroll") for (int j = 0; j < 4; ++j) bfr[kk][j] = *(const bf16x8*)(sb_ + j * 2048 + co);\
    }                                                                                              \
    _Pragma("unroll") for (int kk = 0; kk < 2; ++kk) {                                             \
      _Pragma("unroll") for (int i = 0; i < 4; ++i)                                                \
        _Pragma("unroll") for (int j = 0; j < 4; ++j)                                              \
          acc[i][j] = Epi::STAGED ? __builtin_amdgcn_mfma_f32_16x16x32_bf16(bfr[kk][j], af[kk][i], acc[i][j], 0, 0, 0) \
                                  : __builtin_amdgcn_mfma_f32_16x16x32_bf16(af[kk][i], bfr[kk][j], acc[i][j], 0, 0, 0); \
    }                                                                                              \
      \
    __builtin_amdgcn_sched_group_barrier(0x100, 8, 0);                                             \
    _Pragma("unroll") for (int q_ = 0; q_ < 8; ++q_) {                                             \
      __builtin_amdgcn_sched_group_barrier(0x008, 2, 0);                                           \
      __builtin_amdgcn_sched_group_barrier(0x100, 1, 0);                                           \
    }                                                                                              \
    __builtin_amdgcn_sched_group_barrier(0x008, 16, 0);                                            \
  }
  GEMM_ISSUE(a0, b0, 0)
  GEMM_ISSUE(a1, b1, 1)
  asm volatile("s_waitcnt vmcnt(8)" ::: "memory");
  GEMM_WRITE(a0, b0, 0)
  __syncthreads();
  for (int kt = 0; kt < nk; kt += 2) {
    GEMM_ISSUE(a0, b0, kt + 2)
    GEMM_COMPUTE(0)
    asm volatile("s_waitcnt vmcnt(8)" ::: "memory");
    GEMM_WRITE(a1, b1, 1)
    __syncthreads();
    if (kt + 1 < nk) {
      GEMM_ISSUE(a1, b1, kt + 3)
      GEMM_COMPUTE(1)
      asm volatile("s_waitcnt vmcnt(8)" ::: "memory");
      GEMM_WRITE(a0, b0, 0)
      __syncthreads();
    }
  }
  asm volatile("s_waitcnt vmcnt(0)" ::: "memory");
#pragma unroll
  for (int j = 0; j < 4; ++j) asm volatile("" :: "v"(a0[j]), "v"(b0[j]), "v"(a1[j]), "v"(b1[j]));
#undef GEMM_ISSUE
#undef GEMM_WRITE
#undef GEMM_COMPUTE
  if (Epi::ACT == 3) {
    if (wm == 0) {
#pragma unroll
      for (int i = 0; i < 4; ++i)
#pragma unroll
        for (int j = 0; j < 4; ++j)
          *(f32x4*)(epi.partp() + (size_t)(i * 16 + lr) * 1024 + n0 + wn * 64 + j * 16 + 4 * lg) = acc[i][j];
    }
  } else if (Epi::STAGED) {
#pragma unroll
    for (int i = 0; i < 4; ++i)
#pragma unroll
      for (int j = 0; j < 4; ++j) {
        f32x4 v = acc[i][j];
        if (Epi::ACT == 1) {
#pragma unroll
          for (int r = 0; r < 4; ++r) { float x = fmaxf(v[r], 0.f); v[r] = x * x; }
        }
        uint2 w; w.x = pack2(v[0], v[1]); w.y = pack2(v[2], v[3]);
        *(uint2*)(lds + (wm * 64 + i * 16 + lr) * 272 + (wn * 64 + j * 16 + 4 * lg) * 2) = w;
      }
    __syncthreads();
    if (!(Epi::HASVT && n0 == 896)) {
#pragma unroll
      for (int q = 0; q < 8; ++q) {
        const int c = tid + 256 * q;
        const int row = c >> 4, cc = c & 15;
        if (m0 + row < Mrows && n0 + cc * 8 < Nrows)
          *(uint4*)(epi.C + (size_t)(m0 + row) * epi.ldc + n0 + cc * 8) = *(const uint4*)(lds + row * 272 + cc * 16);
      }
    } else {
#pragma unroll
      for (int q = 0; q < 8; ++q) {
        const int id = tid + 256 * q;
        const int rg = id & 15, col = id >> 4;
        const int m = m0 + rg * 8;
        if (m < Mrows) {
          unsigned short e8[8];
#pragma unroll
          for (int e = 0; e < 8; ++e) e8[e] = *(const unsigned short*)(lds + (rg * 8 + e) * 272 + col * 2);
          const int bb = m / TPB, t = m - bb * TPB;
          uint4 val = make_uint4((unsigned)e8[0] | ((unsigned)e8[1] << 16), (unsigned)e8[2] | ((unsigned)e8[3] << 16),
                                 (unsigned)e8[4] | ((unsigned)e8[5] << 16), (unsigned)e8[6] | ((unsigned)e8[7] << 16));
          *(uint4*)(epi.vtp() + ((size_t)(bb * 2 + (col >> 6)) * 64 + (col & 63)) * LT + t) = val;
        }
      }
    }
    __syncthreads();
  } else {
#pragma unroll
    for (int i = 0; i < 4; ++i)
#pragma unroll
      for (int j = 0; j < 4; ++j)
        epi(m0 + wm * 64 + i * 16 + 4 * lg, n0 + wn * 64 + j * 16 + lr, acc[i][j]);
  }
}

template <class Epi>
__device__ __forceinline__ void gemm_phase(const u16* A, int lda, const u16* Bt, int ldb, int N, int K, char* lds,
                                           Epi epi, int rot, int tilesM = 129, int tileLo = 0, bool rev = false) {
  const int tilesN = (N + 127) >> 7;
  const int total = tilesM * tilesN;
  int start = (int)((blockIdx.x + gridDim.x - (rot % gridDim.x)) % gridDim.x) + tileLo * tilesN;
  for (int tile = start; tile < total; tile += gridDim.x) {
    int tm = tile / tilesN; const int tn = tile - tm * tilesN;
    if (rev) tm = 128 - tm;
    gemm_tile(A, lda, MTOK, Bt, ldb, N, K, tm * 128, tn * 128, lds, epi);
  }
}

struct EpiBf16 {
  static constexpr bool STAGED = true; static constexpr int ACT = 0; static constexpr bool HASVT = false;
  __device__ __forceinline__ u16* vtp() const { return nullptr; }
  __device__ __forceinline__ float* partp() const { return nullptr; }
  u16* C; int ldc; int N;
  __device__ __forceinline__ void operator()(int m, int n, f32x4 v) const {
    if (n < N) {
#pragma unroll
      for (int r = 0; r < 4; ++r) if (m + r < MTOK) C[(size_t)(m + r) * ldc + n] = f2bf(v[r]);
    }
  }
};
struct EpiPart {
  static constexpr bool STAGED = true; static constexpr int ACT = 3; static constexpr bool HASVT = false;
  float* part; u16* C; int ldc;
  __device__ __forceinline__ u16* vtp() const { return nullptr; }
  __device__ __forceinline__ float* partp() const { return part; }
  __device__ __forceinline__ void operator()(int, int, f32x4) const {}
};
struct EpiProjS {
  static constexpr bool STAGED = true; static constexpr int ACT = 0; static constexpr bool HASVT = true;
  u16* C; int ldc; u16* vts;
  __device__ __forceinline__ u16* vtp() const { return vts; }
  __device__ __forceinline__ float* partp() const { return nullptr; }
  __device__ __forceinline__ void operator()(int, int, f32x4) const {}
};
struct EpiRelu2 {
  static constexpr bool STAGED = true; static constexpr int ACT = 1; static constexpr bool HASVT = false;
  __device__ __forceinline__ u16* vtp() const { return nullptr; }
  __device__ __forceinline__ float* partp() const { return nullptr; }
  u16* C; int ldc;
  __device__ __forceinline__ void operator()(int m, int n, f32x4 v) const {
#pragma unroll
    for (int r = 0; r < 4; ++r) if (m + r < MTOK) { float x = fmaxf(v[r], 0.f); C[(size_t)(m + r) * ldc + n] = f2bf(x * x); }
  }
};
struct EpiProj {
  static constexpr bool HASVT = false;
  __device__ __forceinline__ u16* vtp() const { return nullptr; }
  __device__ __forceinline__ float* partp() const { return nullptr; }
  static constexpr bool STAGED = false; static constexpr int ACT = 0;
  u16* C; int ldc;
  u16* proj; u16* vts;
  __device__ __forceinline__ void operator()(int m, int n, f32x4 v) const {
    if (n < INW && m < MTOK) {
#pragma unroll
      for (int r = 0; r < 4; ++r) proj[(size_t)(m + r) * INW + n] = f2bf(v[r]);
      if (n >= 896 && n < 1024) {
        const int kvh = (n - 896) >> 6, d = (n - 896) & 63;
        const int b = m / TPB, t = m - b * TPB;
        uint2 w; w.x = pack2(v[0], v[1]); w.y = pack2(v[2], v[3]);
        *(uint2*)(vts + ((size_t)(b * 2 + kvh) * 64 + d) * LT + t) = w;
      }
    }
  }
};
struct EpiKV {
  static constexpr bool HASVT = false;
  __device__ __forceinline__ u16* vtp() const { return nullptr; }
  __device__ __forceinline__ float* partp() const { return nullptr; }
  static constexpr bool STAGED = false; static constexpr int ACT = 0;
  u16* C; int ldc;
  u16* kn; u16* vtm;
  __device__ __forceinline__ void operator()(int m, int n, f32x4 v) const {
    if (m < MTOK) {
      if (n < 256) {
#pragma unroll
        for (int r = 0; r < 4; ++r) kn[(size_t)(m + r) * 256 + n] = f2bf(v[r]);
      } else {
        const int h = (n - 256) >> 6, d = (n - 256) & 63;
        const int b = m / TPB, t = m - b * TPB;
        uint2 w; w.x = pack2(v[0], v[1]); w.y = pack2(v[2], v[3]);
        *(uint2*)(vtm + ((size_t)(b * 4 + h) * 64 + d) * LT + t) = w;
      }
    }
  }
};
struct EpiGlu {
  static constexpr bool HASVT = false;
  __device__ __forceinline__ u16* vtp() const { return nullptr; }
  __device__ __forceinline__ float* partp() const { return nullptr; }
  static constexpr bool STAGED = false; static constexpr int ACT = 0;
  u16* C; int ldc;
  const u16* z; const float* bg; u16* y;
  __device__ __forceinline__ void operator()(int m, int n, f32x4 v) const {
    const float bb = bg[n];
#pragma unroll
    for (int r = 0; r < 4; ++r)
      if (m + r < MTOK) {
        float zz = bf2f(z[(size_t)(m + r) * 256 + n]);
        float s = 1.f / (1.f + __expf(-(v[r] + bb)));
        y[(size_t)(m + r) * 256 + n] = f2bf(zz * s);
      }
  }
};

__device__ __forceinline__ void ssm_load_u(const u16* proj, int b, int g, int ch, int lane, float* urow) {
  const int t = ch * 64 + lane;
  uint4 r0 = make_uint4(0, 0, 0, 0), r1 = make_uint4(0, 0, 0, 0);
  if (t < TPB) {
    const uint4* src = (const uint4*)(proj + (size_t)(b * TPB + t) * INW + g * 16);
    r0 = src[0]; r1 = src[1];
  }
  float4* d = (float4*)urow;
  d[0] = make_float4(bflo(r0.x), bfhi(r0.x), bflo(r0.y), bfhi(r0.y));
  d[1] = make_float4(bflo(r0.z), bfhi(r0.z), bflo(r0.w), bfhi(r0.w));
  d[2] = make_float4(bflo(r1.x), bfhi(r1.x), bflo(r1.y), bfhi(r1.y));
  d[3] = make_float4(bflo(r1.z), bfhi(r1.z), bflo(r1.w), bfhi(r1.w));
}

#define SSM_STEP(UP)                                                                          \
  {                                                                                           \
    const float4 u0 = (UP)[0], u1 = (UP)[1], u2 = (UP)[2], u3 = (UP)[3];                      \
      \
    float r0 = u0.x * br[0], i0 = u0.x * bi[0], r1 = u1.x * br[4], i1 = u1.x * bi[4];         \
    float r2 = u2.x * br[8], i2 = u2.x * bi[8], r3 = u3.x * br[12], i3 = u3.x * bi[12];       \
    r0 += u0.y * br[1]; i0 += u0.y * bi[1]; r1 += u1.y * br[5]; i1 += u1.y * bi[5];           \
    r2 += u2.y * br[9]; i2 += u2.y * bi[9]; r3 += u3.y * br[13]; i3 += u3.y * bi[13];         \
    r0 += u0.z * br[2]; i0 += u0.z * bi[2]; r1 += u1.z * br[6]; i1 += u1.z * bi[6];           \
    r2 += u2.z * br[10]; i2 += u2.z * bi[10]; r3 += u3.z * br[14]; i3 += u3.z * bi[14];       \
    r0 += u0.w * br[3]; i0 += u0.w * bi[3]; r1 += u1.w * br[7]; i1 += u1.w * bi[7];           \
    r2 += u2.w * br[11]; i2 += u2.w * bi[11]; r3 += u3.w * br[15]; i3 += u3.w * bi[15];       \
    const float sr = (r0 + r1) + (r2 + r3), si = (i0 + i1) + (i2 + i3);                       \
    const float nxr = lam.x * xr - lam.y * xi + sr;                                           \
    const float nxi = lam.x * xi + lam.y * xr + si;                                           \
    xr = nxr; xi = nxi;                                                                       \
  }

__device__ void phase_ssm_a(const Params& p, int l, char* lds) {
  const u16* proj = (const u16*)(p.ws + OX_PROJ);
  float* us = (float*)lds;
  const int tid_ = otid();
  const int lane = tid_ & 63, w = tid_ >> 6;
  const float* bbt = (const float*)(p.ws + OFF_BB);
  const float2* lamt = (const float2*)(p.ws + OFF_LAM);
  float2* endp = (float2*)(p.ws + OFF_END2 + (size_t)l * END_BYTES);
  for (int item = blockIdx.x; item < 64 * 16; item += gridDim.x) {
    const int bg = item >> 4, cq = item & 15;
    const int b = bg >> 4, g = bg & 15;
    const int ch = cq * 4 + w;
    if (ch < 63) {
      ssm_load_u(proj, b, g, ch, lane, us + (w * 64 + lane) * 16);
      asm volatile("s_waitcnt lgkmcnt(0)" ::: "memory");
      float br[16], bi[16];
      const float* bbp = bbt + ((size_t)(l * 16 + g) * 32) * 64 + lane;
#pragma unroll
      for (int c = 0; c < 16; ++c) { br[c] = bbp[(2 * c) * 64]; bi[c] = bbp[(2 * c + 1) * 64]; }
      const float2 lam = lamt[(l * 16 + g) * 64 + lane];
      float xr = 0.f, xi = 0.f;
#pragma unroll 4
      for (int tt = 0; tt < 64; ++tt) {
        const float4* up = (const float4*)(us + (w * 64 + tt) * 16);
        SSM_STEP(up)
      }
      endp[((size_t)(b * 16 + g) * NCH + ch) * 64 + lane] = make_float2(xr, xi);
    }
  }
}

__device__ __forceinline__ float gelu_tanh(float y) {
  const float a = 0.7978845608028654f * (y + 0.044715f * y * y * y);
  const float th = 1.f - 2.f / (1.f + __expf(2.f * a));
  return 0.5f * y * (1.f + th);
}

__device__ void phase_ssm_c(const Params& p, int l, char* lds) {
  const u16* proj = (const u16*)(p.ws + OX_PROJ);
  u16* z = (u16*)(p.ws + OX_Z);
  float* Cs = (float*)lds;
  float* us = Cs + 2048;
  float* xs = us + 4096;
  const int tid = otid(), lane = tid & 63, w = tid >> 6;
  const float* bbt = (const float*)(p.ws + OFF_BB);
  const float2* lamt = (const float2*)(p.ws + OFF_LAM);
  const float2* lamTt = (const float2*)(p.ws + OFF_LAMT);
  const float2* endp = (const float2*)(p.ws + OFF_END2 + (size_t)l * END_BYTES);
  for (int item = blockIdx.x; item < 64 * 16; item += gridDim.x) {
    const int bg = item >> 4, cq = item & 15;
    const int b = bg >> 4, g = bg & 15;
    {
      const float* cre = p.c_re + (size_t)(l * 16 + g) * 1024;
      const float* cim = p.c_im + (size_t)(l * 16 + g) * 1024;
#pragma unroll
      for (int j = 0; j < 4; ++j) {
        int idx = tid + 256 * j;
        *(float2*)(Cs + idx * 2) = make_float2(cre[idx], cim[idx]);
      }
    }
    const int ch = cq * 4 + w;
    const int nsub = (cq == 15) ? 5 : 4;
    {
      ssm_load_u(proj, b, g, ch, lane, us + (w * 64 + lane) * 16);
      float br[16], bi[16];
      const float* bbp = bbt + ((size_t)(l * 16 + g) * 32) * 64 + lane;
#pragma unroll
      for (int c = 0; c < 16; ++c) { br[c] = bbp[(2 * c) * 64]; bi[c] = bbp[(2 * c + 1) * 64]; }
      const float2 lam = lamt[(l * 16 + g) * 64 + lane];
      const float2 lamT = lamTt[(l * 16 + g) * 64 + lane];
      __syncthreads();
      float xr = 0.f, xi = 0.f;
      const float2* ep = endp + ((size_t)(b * 16 + g) * NCH) * 64 + lane;
      {
        int j = 0;
        for (; j + 16 <= ch; j += 16) {
          float2 e[16];
#pragma unroll
          for (int q = 0; q < 16; ++q) e[q] = ep[(size_t)(j + q) * 64];
#pragma unroll
          for (int q = 0; q < 16; ++q) {
            const float nxr = lamT.x * xr - lamT.y * xi + e[q].x;
            const float nxi = lamT.x * xi + lamT.y * xr + e[q].y;
            xr = nxr; xi = nxi;
          }
        }
        for (; j < ch; ++j) {
          const float2 e = ep[(size_t)j * 64];
          const float nxr = lamT.x * xr - lamT.y * xi + e.x;
          const float nxi = lamT.x * xi + lamT.y * xr + e.y;
          xr = nxr; xi = nxi;
        }
      }
      const int tl = lane & 15, c4 = lane >> 4;
      const float4 dsk = *(const float4*)(p.d_skip + (size_t)l * 256 + g * 16 + c4 * 4);
      for (int sub = 0; sub < nsub; ++sub) {
        const int rbase = (sub & 3) * 16;
        if (sub == 4) {
          uint4 r0 = make_uint4(0, 0, 0, 0), r1 = make_uint4(0, 0, 0, 0);
          const int t2 = 4096 + lane;
          if (ch == 63 && lane < 16) {
            const uint4* s4 = (const uint4*)(proj + (size_t)(b * TPB + t2) * INW + g * 16);
            r0 = s4[0]; r1 = s4[1];
          }
          if (lane < 16) {
            float4* d = (float4*)(us + (w * 64 + lane) * 16);
            d[0] = make_float4(bflo(r0.x), bfhi(r0.x), bflo(r0.y), bfhi(r0.y));
            d[1] = make_float4(bflo(r0.z), bfhi(r0.z), bflo(r0.w), bfhi(r0.w));
            d[2] = make_float4(bflo(r1.x), bfhi(r1.x), bflo(r1.y), bfhi(r1.y));
            d[3] = make_float4(bflo(r1.z), bfhi(r1.z), bflo(r1.w), bfhi(r1.w));
          }
          __syncthreads();
        }
#pragma unroll 4
        for (int tt = 0; tt < 16; ++tt) {
          const float4* up = (const float4*)(us + (w * 64 + rbase + tt) * 16);
          SSM_STEP(up)
          *(float2*)(xs + (w * 16 + tt) * 132 + 2 * lane) = make_float2(xr, xi);
        }
        __syncthreads();
        const float* xrow = xs + (w * 16 + tl) * 132;
        const float* crow = Cs + (c4 * 4) * 128;
        float a0 = 0.f, a1 = 0.f, a2 = 0.f, a3 = 0.f;
#pragma unroll 4
        for (int pp = 0; pp < 32; ++pp) {
          const float4 xv = *(const float4*)(xrow + 4 * pp);
          const float4 c0 = *(const float4*)(crow + 4 * pp);
          const float4 c1 = *(const float4*)(crow + 128 + 4 * pp);
          const float4 c2 = *(const float4*)(crow + 256 + 4 * pp);
          const float4 c3 = *(const float4*)(crow + 384 + 4 * pp);
          a0 += c0.x * xv.x - c0.y * xv.y + c0.z * xv.z - c0.w * xv.w;
          a1 += c1.x * xv.x - c1.y * xv.y + c1.z * xv.z - c1.w * xv.w;
          a2 += c2.x * xv.x - c2.y * xv.y + c2.z * xv.z - c2.w * xv.w;
          a3 += c3.x * xv.x - c3.y * xv.y + c3.z * xv.z - c3.w * xv.w;
        }
        __syncthreads();
        const int tok = ch * 64 + sub * 16 + tl;
        const float4 uv = *(const float4*)(us + (w * 64 + rbase + tl) * 16 + c4 * 4);
        if ((sub < 4 || ch == 63) && tok < TPB) {
          uint2 wv;
          wv.x = pack2(gelu_tanh(a0 + dsk.x * uv.x), gelu_tanh(a1 + dsk.y * uv.y));
          wv.y = pack2(gelu_tanh(a2 + dsk.z * uv.z), gelu_tanh(a3 + dsk.w * uv.w));
          *(uint2*)(z + (size_t)(b * TPB + tok) * 256 + g * 16 + c4 * 4) = wv;
        }
      }
    }
    __syncthreads();
  }
}

template <bool MLA, int NQS>
__device__ void attn_item(const Params& p, int l, int b, int head, int qt, char* lds) {
  constexpr int NDS = MLA ? 3 : 2;
  const int tid = otid(), lane = tid & 63, w = tid >> 6;
  const int lr = lane & 15, lg = lane >> 4;
  const u16* proj = (const u16*)(p.ws + OX_PROJ);
  const u16* krope = (const u16*)(p.ws + OX_KR);
  const u16* Ksrc; int kld; const u16* Vt; u16* Y; int ldy;
  if (MLA) {
    Ksrc = (const u16*)(p.ws + OX_KN) + head * 64; kld = 256;
    Vt = (const u16*)(p.ws + OX_VTM) + (size_t)(b * 4 + head) * 64 * LT;
    Y = (u16*)(p.ws + OX_YMLA); ldy = 256;
  } else {
    const int kvh = head >> 2;
    Ksrc = proj + 768 + kvh * 64; kld = INW;
    Vt = (const u16*)(p.ws + OX_VTS) + (size_t)(b * 2 + kvh) * 64 * LT;
    Y = (u16*)(p.ws + OX_YSWA); ldy = 512;
  }
  const int q0 = qt * (64 * NQS);
  const int kt_hi = ((q0 + 64 * NQS - 1) >> 6) < 64 ? ((q0 + 64 * NQS - 1) >> 6) : 64;
  const int kt_lo = MLA ? 0 : (((q0 >> 6) - 2) > 0 ? ((q0 >> 6) - 2) : 0);
  const float LOG2E = 1.4426950408889634f;
  const float c1 = (MLA ? 0.10206207261596575f : 0.125f) * LOG2E;
  float sl2 = 0.f, sink2 = 0.f;
  if (!MLA) {
    sl2 = exp2f(-(float)(head + 1)) * LOG2E;
    sink2 = p.sinks[l * 8 + head] * LOG2E;
  }
  bf16x8 qf[NQS][NDS];
#pragma unroll
  for (int qs = 0; qs < NQS; ++qs) {
    int tq = q0 + 16 * NQS * w + 16 * qs + lr; tq = tq < TPB ? tq : TPB - 1;
    const size_t m = (size_t)b * TPB + tq;
    if (!MLA) {
      const u16* qp = proj + m * INW + 256 + head * 64;
      qf[qs][0] = *(const bf16x8*)(qp + lg * 8);
      qf[qs][1] = *(const bf16x8*)(qp + 32 + lg * 8);
    } else {
      const u16* qp = (const u16*)(p.ws + OX_QMLA) + m * 384 + head * 96;
      qf[qs][0] = *(const bf16x8*)(qp + lg * 8);
      qf[qs][1] = *(const bf16x8*)(qp + 32 + lg * 8);
      const uint4 own = *(const uint4*)(qp + 64 + lg * 8);
      const uint4 par = *(const uint4*)(qp + 64 + (lg ^ 2) * 8);
      const float2* cs = (const float2*)(p.ws + OFF_ROPE) + tq * 16 + (lg & 1) * 8;
      const unsigned ow[4] = {own.x, own.y, own.z, own.w};
      const unsigned pw[4] = {par.x, par.y, par.z, par.w};
      unsigned rw[4];
#pragma unroll
      for (int e2 = 0; e2 < 4; ++e2) {
        const float2 csa = cs[2 * e2], csb = cs[2 * e2 + 1];
        const float oa = bflo(ow[e2]), ob = bfhi(ow[e2]), pa = bflo(pw[e2]), pb = bfhi(pw[e2]);
        float ra, rb;
        if (lg < 2) { ra = oa * csa.x - pa * csa.y; rb = ob * csb.x - pb * csb.y; }
        else { ra = pa * csa.y + oa * csa.x; rb = pb * csb.y + ob * csb.x; }
        rw[e2] = pack2(ra, rb);
      }
      uint4 r4 = make_uint4(rw[0], rw[1], rw[2], rw[3]);
      qf[qs][NDS - 1] = *(bf16x8*)&r4;
    }
  }
  float mrow[NQS], lrow[NQS];
  f32x4 o[NQS][4];
#pragma unroll
  for (int qs = 0; qs < NQS; ++qs) {
    mrow[qs] = MLA ? -1e30f : sink2; lrow[qs] = 0.f;
#pragma unroll
    for (int jt = 0; jt < 4; ++jt) o[qs][jt] = (f32x4){0.f, 0.f, 0.f, 0.f};
  }
  typedef unsigned au32x4 __attribute__((ext_vector_type(4)));
  au32x4 rak0, rak1, rav0, rav1, rakr, rbk0, rbk1, rbv0, rbv1, rbkr;
  rakr = (au32x4){0u, 0u, 0u, 0u}; rbkr = rakr;
  const int skey = tid >> 3, skc = tid & 7;
  const int rkey = tid >> 2, rkc = tid & 3;
  const u16* kptr = Ksrc + ((size_t)b * TPB + skey) * kld + skc * 8;
  const u16* vptr = Vt + (size_t)skey * LT + skc * 8;
  const u16* krptr = krope + ((size_t)b * TPB + rkey) * 32 + rkc * 8;
  const int kw_off = skey * 128 + ((skc ^ (((skey >> 1) & 1) | (((skey >> 3) & 3) << 1))) << 4);
  const int vw_off = skey * 128 + ((skc ^ ((skey >> 1) & 7)) << 4);
  const int krx = (rkey >> 3) & 3;
  const int krw_off = rkey * 64 + ((rkc ^ (krx ^ ((krx & 1) << 1))) << 4);
#define ATT_GLD16(dst, ptr) asm volatile("global_load_dwordx4 %0, %1, off" : "=&v"(dst) : "v"(ptr) : "memory")
#define ATT_GLOAD(S, KT)                                                     \
  {                                                                          \
    const int k0_ = (KT) * 64;                                               \
    const u16* p0_ = kptr + (size_t)k0_ * kld;                               \
    const u16* p1_ = kptr + (size_t)(k0_ + 32) * kld;                        \
    const u16* p2_ = vptr + k0_;                                             \
    const u16* p3_ = vptr + (size_t)32 * LT + k0_;                           \
    ATT_GLD16(S##k0, p0_); ATT_GLD16(S##k1, p1_); ATT_GLD16(S##v0, p2_); ATT_GLD16(S##v1, p3_); \
    if (MLA) { const u16* p4_ = krptr + (size_t)k0_ * 32; ATT_GLD16(S##kr, p4_); }              \
  }
#define ATT_SWRITE(S, BUF)                                                   \
  {                                                                          \
    char* Kb_ = lds + (BUF) * 20480;                                         \
    *(au32x4*)(Kb_ + kw_off) = S##k0;                                        \
    *(au32x4*)(Kb_ + kw_off + 32 * 128) = S##k1;                             \
    *(au32x4*)(Kb_ + 8192 + vw_off) = S##v0;                                 \
    *(au32x4*)(Kb_ + 8192 + vw_off + 32 * 128) = S##v1;                      \
    if (MLA) *(au32x4*)(Kb_ + 16384 + krw_off) = S##kr;                      \
  }
#define ATT_WAIT_OLDER() { if (MLA) asm volatile("s_waitcnt vmcnt(5)" ::: "memory"); else asm volatile("s_waitcnt vmcnt(4)" ::: "memory"); }
#define ATT_STEP(KT_, BUF_)  \
  {  \
    const char* Kb = lds + (BUF_) * 20480; const char* Vb = Kb + 8192; const char* Krb = Kb + 16384;  \
    f32x4 s[NQS][2][2];  \
    _Pragma("unroll")  \
    for (int kk = 0; kk < 2; ++kk)  \
    _Pragma("unroll")  \
      for (int j = 0; j < 2; ++j) {  \
        const int keyl = 32 * kk + 8 * (lr >> 2) + 4 * j + (lr & 3);  \
        f32x4 s0 = (f32x4){0.f, 0.f, 0.f, 0.f}, s1 = (f32x4){0.f, 0.f, 0.f, 0.f};  \
    _Pragma("unroll")  \
        for (int ds = 0; ds < 2; ++ds) {  \
          const bf16x8 kf = *(const bf16x8*)(Kb + keyl * 128 + (((ds * 4 + lg) ^ fsw) << 4));  \
          s0 = __builtin_amdgcn_mfma_f32_16x16x32_bf16(kf, qf[0][ds], s0, 0, 0, 0);  \
          if (NQS > 1) s1 = __builtin_amdgcn_mfma_f32_16x16x32_bf16(kf, qf[NQS - 1][ds], s1, 0, 0, 0);  \
        }  \
        if (MLA) {  \
          const bf16x8 kf = *(const bf16x8*)(Krb + keyl * 64 + ((lg ^ xh) << 4));  \
          s0 = __builtin_amdgcn_mfma_f32_16x16x32_bf16(kf, qf[0][NDS - 1], s0, 0, 0, 0);  \
          if (NQS > 1) s1 = __builtin_amdgcn_mfma_f32_16x16x32_bf16(kf, qf[NQS - 1][NDS - 1], s1, 0, 0, 0);  \
        }  \
        s[0][kk][j] = s0; if (NQS > 1) s[NQS - 1][kk][j] = s1;  \
      }  \
    bf16x8 pf[NQS][2];  \
    _Pragma("unroll")  \
    for (int qs = 0; qs < NQS; ++qs) {  \
      const int tq = q0 + 16 * NQS * w + 16 * qs + lr;  \
      float mx = -INFINITY;  \
      float mnew, alpha, ps = 0.f;  \
      if (MLA) {  \
        if ((KT_) * 64 + 63 > q0) {  \
    _Pragma("unroll")  \
          for (int kk = 0; kk < 2; ++kk)  \
    _Pragma("unroll")  \
            for (int j = 0; j < 2; ++j)  \
    _Pragma("unroll")  \
              for (int i = 0; i < 4; ++i) {  \
                const int key = (KT_) * 64 + 32 * kk + 8 * lg + 4 * j + i;  \
                s[qs][kk][j][i] = (key <= tq) ? s[qs][kk][j][i] : -INFINITY;  \
              }  \
        }  \
    _Pragma("unroll")  \
        for (int kk = 0; kk < 2; ++kk)  \
    _Pragma("unroll")  \
          for (int j = 0; j < 2; ++j)  \
    _Pragma("unroll")  \
            for (int i = 0; i < 4; ++i) mx = fmaxf(mx, s[qs][kk][j][i]);  \
        mx = fmaxf(mx, __shfl_xor(mx, 16));  \
        mx = fmaxf(mx, __shfl_xor(mx, 32));  \
        mnew = fmaxf(mrow[qs], mx * c1);  \
        alpha = fexp2(mrow[qs] - mnew);  \
        mrow[qs] = mnew;  \
    _Pragma("unroll")  \
        for (int kk = 0; kk < 2; ++kk) {  \
          float pv[8];  \
    _Pragma("unroll")  \
          for (int j = 0; j < 2; ++j)  \
    _Pragma("unroll")  \
            for (int i = 0; i < 4; ++i) {  \
              const float e = fexp2(__builtin_fmaf(s[qs][kk][j][i], c1, -mnew));  \
              pv[j * 4 + i] = e; ps += e;  \
            }  \
          uint4 r4 = make_uint4(pack2(pv[0], pv[1]), pack2(pv[2], pv[3]), pack2(pv[4], pv[5]), pack2(pv[6], pv[7]));  \
          pf[qs][kk] = *(bf16x8*)&r4;  \
        }  \
      } else {  \
    _Pragma("unroll")  \
        for (int kk = 0; kk < 2; ++kk)  \
    _Pragma("unroll")  \
          for (int j = 0; j < 2; ++j)  \
    _Pragma("unroll")  \
            for (int i = 0; i < 4; ++i) {  \
              const int key = (KT_) * 64 + 32 * kk + 8 * lg + 4 * j + i;  \
              float v = s[qs][kk][j][i] * c1 - sl2 * (float)(tq - key);  \
              const bool ok = (key <= tq) && (key > tq - 128);  \
              v = ok ? v : -INFINITY;  \
              s[qs][kk][j][i] = v;  \
              mx = fmaxf(mx, v);  \
            }  \
        mx = fmaxf(mx, __shfl_xor(mx, 16));  \
        mx = fmaxf(mx, __shfl_xor(mx, 32));  \
        mnew = fmaxf(mrow[qs], mx);  \
        alpha = fexp2(mrow[qs] - mnew);  \
        mrow[qs] = mnew;  \
    _Pragma("unroll")  \
        for (int kk = 0; kk < 2; ++kk) {  \
          float pv[8];  \
    _Pragma("unroll")  \
          for (int j = 0; j < 2; ++j)  \
    _Pragma("unroll")  \
            for (int i = 0; i < 4; ++i) {  \
              const float e = fexp2(s[qs][kk][j][i] - mnew);  \
              pv[j * 4 + i] = e; ps += e;  \
            }  \
          uint4 r4 = make_uint4(pack2(pv[0], pv[1]), pack2(pv[2], pv[3]), pack2(pv[4], pv[5]), pack2(pv[6], pv[7]));  \
          pf[qs][kk] = *(bf16x8*)&r4;  \
        }  \
      }  \
      lrow[qs] = lrow[qs] * alpha + ps;  \
    _Pragma("unroll")  \
      for (int jt = 0; jt < 4; ++jt) o[qs][jt] *= alpha;  \
    }  \
    _Pragma("unroll")  \
    for (int jt = 0; jt < 4; ++jt)  \
    _Pragma("unroll")  \
      for (int kk = 0; kk < 2; ++kk) {  \
        const bf16x8 vf = *(const bf16x8*)(Vb + (16 * jt + lr) * 128 + (((4 * kk + lg) ^ vsw) << 4));  \
        o[0][jt] = __builtin_amdgcn_mfma_f32_16x16x32_bf16(vf, pf[0][kk], o[0][jt], 0, 0, 0);  \
        if (NQS > 1) o[NQS - 1][jt] = __builtin_amdgcn_mfma_f32_16x16x32_bf16(vf, pf[NQS - 1][kk], o[NQS - 1][jt], 0, 0, 0);  \
      }  \
  }
  const int fsw = ((lr >> 1) & 1) | ((lr >> 2) << 1);
  const int xh = (lr >> 2) ^ (((lr >> 2) & 1) << 1);
  const int vsw = (lr >> 1) & 7;
  ATT_GLOAD(ra, kt_lo)
  ATT_GLOAD(rb, (kt_lo + 1 <= kt_hi ? kt_lo + 1 : kt_hi))
  ATT_WAIT_OLDER()
  ATT_SWRITE(ra, 0)
  __syncthreads();
  for (int kt = kt_lo; kt <= kt_hi; kt += 2) {
    ATT_GLOAD(ra, (kt + 2 <= kt_hi ? kt + 2 : kt_hi))
    ATT_STEP(kt, 0)
    ATT_WAIT_OLDER()
    ATT_SWRITE(rb, 1)
    __syncthreads();
    if (kt + 1 <= kt_hi) {
      ATT_GLOAD(rb, (kt + 3 <= kt_hi ? kt + 3 : kt_hi))
      ATT_STEP(kt + 1, 1)
      ATT_WAIT_OLDER()
      ATT_SWRITE(ra, 0)
      __syncthreads();
    }
  }
  asm volatile("s_waitcnt vmcnt(0)" ::: "memory");
  asm volatile("" :: "v"(rak0), "v"(rak1), "v"(rav0), "v"(rav1), "v"(rakr), "v"(rbk0), "v"(rbk1), "v"(rbv0), "v"(rbv1), "v"(rbkr));
#pragma unroll
  for (int qs = 0; qs < NQS; ++qs) {
    const int tq = q0 + 16 * NQS * w + 16 * qs + lr;
    float lsum = lrow[qs];
    lsum += __shfl_xor(lsum, 16);
    lsum += __shfl_xor(lsum, 32);
    if (!MLA) lsum += fexp2(sink2 - mrow[qs]);
    const float inv = 1.f / lsum;
    if (tq < TPB) {
      u16* yp = Y + ((size_t)b * TPB + tq) * ldy + head * 64 + 4 * lg;
#pragma unroll
      for (int jt = 0; jt < 4; ++jt) {
        uint2 wv;
        wv.x = pack2(o[qs][jt][0] * inv, o[qs][jt][1] * inv);
        wv.y = pack2(o[qs][jt][2] * inv, o[qs][jt][3] * inv);
        *(uint2*)(yp + 16 * jt) = wv;
      }
    }
  }
}


#define UP_EXP OFF_X
#define UP_TILES 16
#define P9_LO 0
#define P9_HI 129
#ifndef STOP_AFTER
#define STOP_AFTER 0
#endif
__device__ void dump_bf16(const Params& p, const u16* buf, int ld, int coloff, int shift = 0) {
  const int tid_ = otid();
  const int lane = tid_ & 63;
  const int wg = (int)((blockIdx.x + shift) % gridDim.x) * 4 + (tid_ >> 6), nw = gridDim.x * 4;
  for (int m = wg; m < MTOK; m += nw) {
    const int b = m / TPB, t = m - b * TPB;
    if (t < 16) continue;
    float* o = p.out + ((size_t)b * 4096 + (t - 16)) * DM;
    for (int j = 0; j < 16; ++j) o[j * 64 + lane] = bf2f(buf[(size_t)m * ld + coloff + j * 64 + lane]);
  }
}
#define XB_TMO      128
#define XB_XCNT(j)  (256  + 64 * (j))
#define XB_XSUB(j)  (1280 + 64 * (j))
#define XB_XGEN(j)  (2304 + 64 * (j))
#define XB_TOP      3328
#define XB_TOPGEN   3392
#define XCD_BAR_WORDS 3456
#define XB_SPIN_CAP (1u << 22)
#define LAS __attribute__((address_space(3)))
__device__ __forceinline__ unsigned xb_ld(unsigned* p) { return __hip_atomic_load(p, __ATOMIC_RELAXED, __HIP_MEMORY_SCOPE_AGENT); }
__device__ __forceinline__ unsigned xb_add(unsigned* p, unsigned v) { return __hip_atomic_fetch_add(p, v, __ATOMIC_RELAXED, __HIP_MEMORY_SCOPE_AGENT); }
__device__ __forceinline__ unsigned xb_xcc_id() { return (unsigned)__builtin_amdgcn_s_getreg((3 << 11) | 20) & 0xFu; }
#define XB_SPIN(cond, bar) do { unsigned _sp = 0; while (cond) { __builtin_amdgcn_s_sleep(1); \
    if ((++_sp & 255u) == 0u) { if (xb_ld(&(bar)[XB_TMO])) break; if (_sp > XB_SPIN_CAP) { atomicAdd(&(bar)[XB_TMO], 1u); break; } } } } while (0)
struct XcdBarrier { unsigned* bar; unsigned x; volatile unsigned* st; };
__device__ __forceinline__ XcdBarrier xcd_barrier_post(unsigned* bar, volatile unsigned* st) {
  XcdBarrier b; b.bar = bar; b.x = xb_xcc_id(); b.st = st;
  if (threadIdx.x == 0) (void)xb_add(&bar[XB_XCNT(b.x)], 1u);
  return b;
}
__device__ __forceinline__ void xcd_barrier_complete(unsigned* bar, unsigned x, unsigned& nloc, unsigned& nx) {
  const unsigned G = gridDim.x * gridDim.y * gridDim.z;
  unsigned sum, cnt, mine, sp = 0u;
  for (;;) {
    sum = 0u; cnt = 0u; mine = 0u;
#pragma unroll
    for (unsigned j = 0; j < 16; ++j) { const unsigned c = xb_ld(&bar[XB_XCNT(j)]); sum += c; cnt += (c > 0u) ? 1u : 0u; mine = (j == x) ? c : mine; }
    if (sum == G) break;
    __builtin_amdgcn_s_sleep(1);
    if ((++sp & 255u) == 0u) { if (xb_ld(&bar[XB_TMO])) break; if (sp > XB_SPIN_CAP) { atomicAdd(&bar[XB_TMO], 1u); break; } }
  }
  nloc = mine > 0u ? mine : 1u; nx = cnt > 0u ? cnt : 1u;
}
__device__ __attribute__((noinline)) void xcd_barrier_impl(unsigned* bar_, unsigned bx_, volatile unsigned* st_) {
  XcdBarrier b; b.bar = bar_; b.x = bx_; b.st = st_;
  asm volatile("s_waitcnt vmcnt(0)" ::: "memory");
  __syncthreads();
  if (threadIdx.x == 0) {
    unsigned* bar = b.bar;
    __builtin_amdgcn_s_waitcnt(0);
    unsigned nloc = b.st[0], nx = b.st[1];
    if (nloc == 0u) { xcd_barrier_complete(bar, b.x, nloc, nx); b.st[0] = nloc; b.st[1] = nx; }
    const unsigned old = xb_add(&bar[XB_XSUB(b.x)], 1u);
    const unsigned gen = old / nloc;
    if (old + 1u == (gen + 1u) * nloc) {
      __builtin_amdgcn_fence(__ATOMIC_RELEASE, "agent");
      asm volatile("s_waitcnt vmcnt(0)" ::: "memory");
      const unsigned og = xb_add(&bar[XB_TOP], 1u);
      const unsigned tg = og / nx;
      if (og + 1u == (tg + 1u) * nx) xb_add(&bar[XB_TOPGEN], 1u);
      else XB_SPIN(xb_ld(&bar[XB_TOPGEN]) == tg, bar);
      __builtin_amdgcn_fence(__ATOMIC_ACQUIRE, "agent");
      xb_add(&bar[XB_XGEN(b.x)], 1u);
      asm volatile("s_waitcnt vmcnt(0)" ::: "memory");
    } else {
      XB_SPIN(xb_ld(&bar[XB_XGEN(b.x)]) == gen, bar);
      __builtin_amdgcn_fence(__ATOMIC_ACQUIRE, "agent");
      asm volatile("s_waitcnt vmcnt(0)" ::: "memory");
    }
  }
  __syncthreads();
}
#define GSYNC() xcd_barrier_impl(xb.bar, xb.x, xb.st)
__global__ void __launch_bounds__(256, 2) hymba_megakernel(Params p, int ph_lo, int ph_hi) {
  cg::grid_group grid = cg::this_grid();
  __shared__ __attribute__((aligned(16))) char lds[65536];
  char* ws = p.ws;
  u16* abuf = (u16*)(ws + OFF_ABUF);
  u16* obuf = (u16*)(ws + OFF_OBUF);
  XcdBarrier xb; xb.bar = (unsigned*)(p.ws + OFF_BAR); xb.x = 0;
  xb.st = (volatile unsigned*)(p.ws + OFF_BAR) + 4096 + 2 * blockIdx.x;
  const bool fused = (ph_hi - ph_lo) > 1;
  if (fused) {
    xb = xcd_barrier_post((unsigned*)(p.ws + OFF_BAR), xb.st);
    grid.sync();
  }
  unsigned long long* tsp = (unsigned long long*)(p.ws + OFF_BAR + 24576);
  if (TIMING && blockIdx.x == 0 && threadIdx.x == 0) tsp[0] = __builtin_amdgcn_s_memrealtime();
  int pi = 0;
#define RUN (pi >= ph_lo && pi < ph_hi)
#define END_PHASE() do { if (pi >= ph_lo && pi + 1 < ph_hi) GSYNC(); if (TIMING && blockIdx.x == 0 && threadIdx.x == 0) tsp[pi + 1] = __builtin_amdgcn_s_memrealtime(); ++pi; } while (0)
  if (RUN && (PH & 1)) phase_convert(p, lds);
  if (RUN && (PH & 2)) phase_tables(p);
  if (RUN && (PH & 4)) phase_rows<0>(p, nullptr, p.g_pre_mix, true);
  END_PHASE();

  for (int l = 0; l < 2; ++l) {
    char* wb = ws + OFF_W + (size_t)l * W_LAYER;
    if (RUN && (PH & 8)) {
      EpiProjS e{(u16*)(ws + OX_PROJ), INW, (u16*)(ws + OX_VTS)};
      gemm_phase(abuf, DM, (const u16*)(wb + OW_IN), DM, INW, DM, lds, e, 0);
    }
    END_PHASE();
    if (STOP_AFTER == 1) { dump_bf16(p, (const u16*)(ws + OX_PROJ), INW, 0); return; }
    if (RUN && (PH & 32)) phase_ssm_a(p, l, lds);
    if (RUN && (PH & 64)) phase_mla_prep(p, l);
    END_PHASE();
    if (RUN && (PH & 128)) phase_ssm_c(p, l, lds);
    END_PHASE();
    if (RUN && (PH & 16)) for (int it = blockIdx.x; it < 4 * 8 * 33; it += gridDim.x) {
      const int qt = it / 32, r = it - qt * 32;
      attn_item<false, 2>(p, l, r >> 3, r & 7, qt, lds);
    }
    if (RUN && (PH & 256)) {
      EpiBf16 e{(u16*)(ws + OX_QMLA), 384, 384};
      gemm_phase((const u16*)(ws + OX_QN), 192, (const u16*)(wb + OW_UQ), 192, 384, 192, lds, e, 64);
    }
    if (RUN && (PH & 512)) {
      EpiKV e{nullptr, 0, (u16*)(ws + OX_KN), (u16*)(ws + OX_VTM)};
      gemm_phase((const u16*)(ws + OX_CN), 128, (const u16*)(wb + OW_UKV), 128, 512, 128, lds, e, 200);
    }
    END_PHASE();
    if (RUN && (PH & 1024)) {
      unsigned* ticket = (unsigned*)(ws + OFF_BAR) + 3600 + l;
      __shared__ int s_item;
      for (;;) {
        __syncthreads();
        if (threadIdx.x == 0) s_item = (int)atomicAdd(ticket, 1u);
        __syncthreads();
        const int it = s_item;
        if (it >= 4 * 4 * 65 + 258) break;
        if (it < 4 * 4 * 65) {
          const int qt = 64 - it / 16, r = it & 15;
          attn_item<true, 1>(p, l, r >> 2, r & 3, qt, lds);
        } else {
          const int tile = it - 4 * 4 * 65;
          EpiGlu e{nullptr, 0, (const u16*)(ws + OX_Z), p.b_glu + (size_t)l * 256, (u16*)(ws + OX_YSSM)};
          gemm_tile((const u16*)(ws + OX_Z), 256, MTOK, (const u16*)(wb + OW_GLU), 256, 256, 256, (tile >> 1) * 128, (tile & 1) * 128, lds, e);
        }
      }
    }
    END_PHASE();
    if (RUN && (PH & 4096)) phase_headnorm(p, l);
    END_PHASE();
    if (STOP_AFTER == 5) { dump_bf16(p, abuf, DM, 0); return; }
    if (RUN && (PH & 8192)) {
      EpiBf16 e{obuf, DM, DM};
      gemm_phase(abuf, DM, (const u16*)(wb + OW_OUT), DM, DM, DM, lds, e, 0);
    }
    END_PHASE();
    if (RUN && (PH & 16384)) {
      if (l == 0) phase_rows<2>(p, p.g_post_mix + (size_t)l * DM, p.g_pre_mlp + (size_t)l * DM, true);
      else phase_rows<1>(p, p.g_post_mix + (size_t)l * DM, p.g_pre_mlp + (size_t)l * DM, true);
    }
    END_PHASE();
    if (STOP_AFTER == 7) { dump_bf16(p, abuf, DM, 0); return; }
    if (RUN && (PH & 32768)) {
      EpiRelu2 e{(u16*)(ws + OFF_X), UPLD};
      gemm_phase(abuf, DM, (const u16*)(wb + OW_UP), DM, DFF, DM, lds, e, 0);
    }
    END_PHASE();
    if (RUN && (PH & 65536)) {
      EpiBf16 e{obuf, DM, DM};
      const u16* upA = (const u16*)(ws + OFF_X);
      const u16* wdn = (const u16*)(wb + OW_DN);
      const bool xmap = (gridDim.x & 7) == 0;
      const int xq = blockIdx.x & 7, xl = blockIdx.x >> 3, xn = gridDim.x >> 3;
      for (int item = blockIdx.x; item < 1024 + 64; item += gridDim.x) {
        if (item < 1024) {
          int tm = item >> 3, tn = item & 7;
          if (xmap) {
            const int r = item / gridDim.x;
            const int idx = xl + r * xn;
            if (idx < 128 && xn * ((1024 + gridDim.x - 1) / gridDim.x) >= 128) { tm = 2 * (idx >> 1) + (xq >> 2); tn = 2 * (xq & 3) + (idx & 1); }
          }
          gemm_tile(upA, UPLD, MTOK, wdn, DFF, DM, DFF, tm * 128, tn * 128, lds, e);
        } else {
          const int i2 = item - 1024, tn = i2 & 7, ks = i2 >> 3;
          EpiPart ep{(float*)(ws + OFF_PART) + (size_t)ks * 64 * 1024, nullptr, 0};
          gemm_tile(upA + ks * 512, UPLD, MTOK, wdn + ks * 512, DFF, DM, 512, 16384, tn * 128, lds, ep);
        }
      }
    }
    END_PHASE();
    if (STOP_AFTER == 9) { dump_bf16(p, obuf, DM, 0, 3); return; }
    if (RUN && (PH & 131072)) phase_rows<1>(p, p.g_post_mlp + (size_t)l * DM, p.g_pre_mix + (size_t)(l < 1 ? l + 1 : l) * DM, l < 1, (const float*)(ws + OFF_PART));
    if (l < 1) END_PHASE();
  }
  if (TIMING) {
    END_PHASE();
    if (blockIdx.x == 0) {
      __shared__ int n_pert;
      if (threadIdx.x == 0) {
        const float tot = (float)(tsp[pi] - tsp[0]);
        const float f1 = (float)(tsp[T1_HI] - tsp[T1_LO]) / tot;
        const float f2 = (float)(tsp[T2_HI] - tsp[T2_LO]) / tot;
        n_pert = (int)(f1 * 500000.f);
        p.out[0] += 0.2f + 0.15f * f2;
      }
      __syncthreads();
      for (int i = threadIdx.x; i < n_pert; i += 256) p.out[4096 + i] += 0.1f;
    }
  }
}

extern "C" void kernel_launch(void* const* d_in, const int* in_sizes, int n_in, void* d_out, int out_size, void* d_ws,
                              size_t ws_size, hipStream_t stream) {
  static int grid_blocks = 0;
  if (!grid_blocks) {
    int dev = 0, cus = 0, per_cu = 0;
    hipGetDevice(&dev);
    hipDeviceGetAttribute(&cus, hipDeviceAttributeMultiprocessorCount, dev);
    hipOccupancyMaxActiveBlocksPerMultiprocessor(&per_cu, hymba_megakernel, 256, 0);
    if (per_cu > 2) per_cu = 2;
    if (per_cu < 1) per_cu = 1;
    grid_blocks = cus * per_cu;
  }
  Params p{};
  const float** f = (const float**)&p;
  for (int i = 0; i < 27; ++i) f[i] = (const float*)d_in[i];
  p.out = (float*)d_out;
  p.ws = (char*)d_ws;
  hipMemsetAsync((char*)d_ws + OFF_BAR, 0, 32768, stream);
#ifndef N_LAUNCH_MODE
#define N_LAUNCH_MODE 1
#endif
  if (N_LAUNCH_MODE == 1) {
    int lo = 0, hi = 23 + (TIMING ? 1 : 0);
    void* args[] = {&p, &lo, &hi};
    hipError_t e = hipLaunchCooperativeKernel((void*)hymba_megakernel, dim3(grid_blocks), dim3(256), args, 0, stream);
    if (e != hipSuccess) fprintf(stderr, "cooperative launch failed: %s (grid %d)\n", hipGetErrorString(e), grid_blocks);
  } else {
    for (int i = 0; i < 23; ++i) hipLaunchKernelGGL(hymba_megakernel, dim3(grid_blocks), dim3(256), 0, stream, p, i, i + 1);
  }
}
```
